# Optimizing an MI355X kernel written in HIP

```python
import math
import jax, jax.numpy as jnp
from jax import lax
import numpy as np

D_MODEL = 2048
BATCH = 4
SEQ = 2048
DEPTH = 2

D_MIX = D_MODEL
D_GROUP = D_MIX // 4
D_FF = 4 * D_MODEL
ROPE_THETA = 10000.0
EPS = 1e-6
Q_BLOCK = 128
NEG_INF = -1e30

S5_CH = D_GROUP
S5_GROUP = 16
S5_G = S5_CH // S5_GROUP
S5_P = 64
S5_DT_MIN = 0.001
S5_DT_MAX = 0.1

RET_HEADS = 4
RET_DK = D_GROUP // RET_HEADS
RET_CHUNK = 128

NSA_HEADS = 4
NSA_DH = D_GROUP // NSA_HEADS
NSA_CMP_LEN = 32
NSA_CMP_STRIDE = 16
NSA_SEL_LEN = 64
NSA_TOPK = 8
NSA_WINDOW = 256
NSA_FORCE_BONUS = 1e4

DIFF_HEADS = 4
DIFF_DV = D_GROUP // DIFF_HEADS
DIFF_DH = DIFF_DV // 2

SPLIT_WIDTHS = (
    S5_CH,
    D_GROUP, D_GROUP, D_GROUP, D_GROUP,
    D_GROUP,
    NSA_DH, NSA_DH, NSA_DH, NSA_DH, NSA_DH, NSA_DH,
    NSA_HEADS * 3,
    D_GROUP, D_GROUP, D_GROUP,
)
N_IN = sum(SPLIT_WIDTHS)

kernel_name = "hybrid_s5_retnet_nsa_diffattn_block"


def _rms(x, gain=None):
    xf = x.astype(jnp.float32)
    y = xf * lax.rsqrt(jnp.mean(xf * xf, axis=-1, keepdims=True) + EPS)
    if gain is not None:
        y = y * gain.astype(jnp.float32)
    return y.astype(x.dtype)


def _rope(x, pos):
    d = x.shape[-1]
    inv = ROPE_THETA ** (-jnp.arange(0, d, 2, dtype=jnp.float32) / d)
    ang = pos.astype(jnp.float32)[..., None] * inv
    cos = jnp.cos(ang)[:, :, None, :]
    sin = jnp.sin(ang)[:, :, None, :]
    xf = x.astype(jnp.float32)
    x1, x2 = xf[..., : d // 2], xf[..., d // 2:]
    return jnp.concatenate([x1 * cos - x2 * sin, x2 * cos + x1 * sin], axis=-1).astype(x.dtype)


def _masked_softmax(s, mask):
    p = jax.nn.softmax(jnp.where(mask, s, NEG_INF), axis=-1)
    return jnp.where(mask, p, 0.0)


def _s5_combine(e1, e2):
    a1r, a1i, b1r, b1i = e1
    a2r, a2i, b2r, b2i = e2
    return (a2r * a1r - a2i * a1i,
            a2r * a1i + a2i * a1r,
            a2r * b1r - a2i * b1i + b2r,
            a2r * b1i + a2i * b1r + b2i)


def _s5_mixer(u, lam_re, lam_im, log_dt, b_re, b_im, c_re, c_im, d_skip, w_glu):
    bsz, seq, _ = u.shape
    f32 = jnp.float32
    ug = u.astype(f32).reshape(bsz, seq, S5_G, S5_GROUP)
    lam_re = lam_re.astype(f32)
    lam_im = lam_im.astype(f32)
    dt = jnp.exp(log_dt.astype(f32))[:, None]
    mag = jnp.exp(lam_re * dt)
    lb_re = mag * jnp.cos(lam_im * dt)
    lb_im = mag * jnp.sin(lam_im * dt)
    den = lam_re * lam_re + lam_im * lam_im
    f_re = ((lb_re - 1.0) * lam_re + lb_im * lam_im) / den
    f_im = (lb_im * lam_re - (lb_re - 1.0) * lam_im) / den
    b_re = b_re.astype(f32)
    b_im = b_im.astype(f32)
    bb_re = f_re[..., None] * b_re - f_im[..., None] * b_im
    bb_im = f_re[..., None] * b_im + f_im[..., None] * b_re
    bu_re = jnp.einsum('blgh,gph->blgp', ug, bb_re)
    bu_im = jnp.einsum('blgh,gph->blgp', ug, bb_im)
    a_re = jnp.broadcast_to(lb_re, bu_re.shape)
    a_im = jnp.broadcast_to(lb_im, bu_im.shape)
    _, _, s_re, s_im = lax.associative_scan(_s5_combine, (a_re, a_im, bu_re, bu_im), axis=1)
    y = (jnp.einsum('gnp,blgp->blgn', c_re.astype(f32), s_re)
         - jnp.einsum('gnp,blgp->blgn', c_im.astype(f32), s_im)
         + d_skip.astype(f32) * ug)
    y = jax.nn.gelu(y.reshape(bsz, seq, S5_CH)).astype(u.dtype)
    return y * jax.nn.sigmoid(y @ w_glu)


def _retention(q, k, v, g, pos):
    bsz, seq, _ = q.shape
    H, dk, C = RET_HEADS, RET_DK, RET_CHUNK
    n_chunk = seq // C
    q = _rope(q.reshape(bsz, seq, H, dk), pos)
    k = _rope(k.reshape(bsz, seq, H, dk), pos) * (dk ** -0.5)
    v = v.reshape(bsz, seq, H, dk)
    log_g = jnp.log(1.0 - 2.0 ** (-5.0 - jnp.arange(H, dtype=jnp.float32)))
    qc = q.reshape(bsz, n_chunk, C, H, dk)
    kc = k.reshape(bsz, n_chunk, C, H, dk)
    vc = v.reshape(bsz, n_chunk, C, H, dk)
    idx = jnp.arange(C, dtype=jnp.float32)
    diff = idx[:, None] - idx[None, :]
    dmat = jnp.where(diff >= 0, jnp.exp(jnp.maximum(diff, 0.0)[None] * log_g[:, None, None]), 0.0)
    inner = jnp.einsum('bnqhd,bnkhd->bnhqk', qc, kc) * dmat[None, None]
    o_inner = jnp.einsum('bnhqk,bnkhe->bnqhe', inner, vc)
    zeta = jnp.exp((C - 1.0 - idx)[None, :] * log_g[:, None])
    kv = jnp.einsum('bnkhd,hk,bnkhe->nbhde', kc, zeta, vc)
    g_chunk = jnp.exp(C * log_g)[None, :, None, None]

    def step(r, kv_i):
        return r * g_chunk + kv_i, r

    _, r_prev = lax.scan(step, jnp.zeros((bsz, H, dk, dk), kv.dtype), kv)
    xi = jnp.exp((idx + 1.0)[None, :] * log_g[:, None])
    o_cross = jnp.einsum('bnqhd,nbhde,hq->bnqhe', qc, r_prev, xi)
    o = (o_inner + o_cross).reshape(bsz, seq, H, dk).astype(jnp.float32)
    mu = jnp.mean(o, axis=-1, keepdims=True)
    var = jnp.mean(jnp.square(o - mu), axis=-1, keepdims=True)
    o = ((o - mu) * lax.rsqrt(var + EPS)).reshape(bsz, seq, H * dk).astype(g.dtype)
    return jax.nn.silu(g) * o


def _nsa(q, kc, vc, ks, vs, kw, vw, gate, pos, pe_k, pe_v, w_cmp_k, w_cmp_v):
    bsz, seq, _ = q.shape
    H, dh, QB = NSA_HEADS, NSA_DH, Q_BLOCK
    scale = dh ** -0.5
    nb = seq // QB
    t = jnp.arange(seq)
    q = _rope(_rms(q.reshape(bsz, seq, H, dh)), pos)

    n_cmp = (seq - NSA_CMP_LEN) // NSA_CMP_STRIDE + 1
    blk_idx = np.arange(n_cmp)[:, None] * NSA_CMP_STRIDE + np.arange(NSA_CMP_LEN)[None, :]
    kc_r = _rope(kc[:, :, None, :], pos)[:, :, 0]
    k_cmp = _rms((kc_r[:, blk_idx] + pe_k).reshape(bsz, n_cmp, NSA_CMP_LEN * dh) @ w_cmp_k)
    v_cmp = (vc[:, blk_idx] + pe_v).reshape(bsz, n_cmp, NSA_CMP_LEN * dh) @ w_cmp_v
    mask_c = jnp.asarray(blk_idx[:, -1])[None, :] <= t[:, None]
    s_c = jnp.einsum('bqhd,bjd->bhqj', q, k_cmp).astype(jnp.float32) * scale
    p_cmp = _masked_softmax(s_c, mask_c[None, None])
    o_cmp = jnp.einsum('bhqj,bjd->bqhd', p_cmp.astype(v_cmp.dtype), v_cmp)

    n_sel = seq // NSA_SEL_LEN
    topk = min(NSA_TOPK, n_sel)
    cmp_start = np.arange(n_cmp) * NSA_CMP_STRIDE
    sel_start = np.arange(n_sel) * NSA_SEL_LEN
    overlap = ((cmp_start[None, :] < sel_start[:, None] + NSA_SEL_LEN)
               & (cmp_start[None, :] + NSA_CMP_LEN > sel_start[:, None])).astype(np.float32)
    imp = jnp.einsum('bhqi,ji->bqj', p_cmp, jnp.asarray(overlap))
    cur = t // NSA_SEL_LEN
    jj = jnp.arange(n_sel)
    valid = jj[None, :] <= cur[:, None]
    forced = (jj[None, :] == 0) | (jj[None, :] == cur[:, None]) | (jj[None, :] == cur[:, None] - 1)
    score = jnp.where(valid, imp + jnp.where(forced, NSA_FORCE_BONUS, 0.0), NEG_INF)
    _, sel = lax.top_k(score, topk)
    ks_blk = _rope(_rms(ks)[:, :, None, :], pos)[:, :, 0].reshape(bsz, n_sel, NSA_SEL_LEN, dh)
    vs_blk = vs.reshape(bsz, n_sel, NSA_SEL_LEN, dh)
    b_idx = jnp.arange(bsz)[:, None, None]
    l_idx = jnp.arange(NSA_SEL_LEN)

    def sel_block(args):
        q_b, sel_b, t_b = args
        kg = ks_blk[b_idx, sel_b]
        vg = vs_blk[b_idx, sel_b]
        s = jnp.einsum('bqhd,bqkld->bhqkl', q_b, kg).astype(jnp.float32) * scale
        kpos = sel_b[..., None] * NSA_SEL_LEN + l_idx
        m = (kpos <= t_b[None, :, None, None]).reshape(bsz, 1, QB, topk * NSA_SEL_LEN)
        p = _masked_softmax(s.reshape(bsz, H, QB, topk * NSA_SEL_LEN), m).reshape(s.shape)
        return jnp.einsum('bhqkl,bqkld->bqhd', p.astype(vg.dtype), vg)

    q_blocks = q.reshape(bsz, nb, QB, H, dh).transpose(1, 0, 2, 3, 4)
    sel_blocks = sel.reshape(bsz, nb, QB, topk).transpose(1, 0, 2, 3)
    o_sel = lax.map(sel_block, (q_blocks, sel_blocks, t.reshape(nb, QB)))
    o_sel = o_sel.transpose(1, 0, 2, 3, 4).reshape(bsz, seq, H, dh)

    n_prev = NSA_WINDOW // QB
    kw_r = _rope(_rms(kw)[:, :, None, :], pos)[:, :, 0]
    kw_pad = jnp.pad(kw_r, ((0, 0), (n_prev * QB, 0), (0, 0))).reshape(bsz, nb + n_prev, QB, dh)
    vw_pad = jnp.pad(vw, ((0, 0), (n_prev * QB, 0), (0, 0))).reshape(bsz, nb + n_prev, QB, dh)
    k_band = jnp.concatenate([kw_pad[:, i:i + nb] for i in range(n_prev + 1)], axis=2)
    v_band = jnp.concatenate([vw_pad[:, i:i + nb] for i in range(n_prev + 1)], axis=2)
    qb = q.reshape(bsz, nb, QB, H, dh)
    s_w = jnp.einsum('bnqhd,bnkd->bnhqk', qb, k_band).astype(jnp.float32) * scale
    qpos = t.reshape(nb, QB)
    kpos = (jnp.arange(nb)[:, None] - n_prev) * QB + jnp.arange((n_prev + 1) * QB)[None, :]
    dist = qpos[:, :, None] - kpos[:, None, :]
    m_w = (dist >= 0) & (dist < NSA_WINDOW) & (kpos[:, None, :] >= 0)
    p_w = _masked_softmax(s_w, m_w[None, :, None])
    o_win = jnp.einsum('bnhqk,bnkd->bnqhd', p_w.astype(v_band.dtype), v_band).reshape(bsz, seq, H, dh)

    gts = jax.nn.sigmoid(gate.reshape(bsz, seq, H, 3))
    o = gts[..., 0:1] * o_cmp + gts[..., 1:2] * o_sel + gts[..., 2:3] * o_win
    return o.reshape(bsz, seq, H * dh)


def _diff_attn(q, k, v, pos, lq1, lk1, lq2, lk2, lam_init):
    bsz, seq, _ = q.shape
    H, dh, dv, QB = DIFF_HEADS, DIFF_DH, DIFF_DV, Q_BLOCK
    nb = seq // QB
    scale = dh ** -0.5
    q = _rope(_rms(q.reshape(bsz, seq, 2 * H, dh)), pos).reshape(bsz, seq, H, 2, dh)
    k = _rope(_rms(k.reshape(bsz, seq, 2 * H, dh)), pos).reshape(bsz, seq, H, 2, dh)
    v = v.reshape(bsz, seq, H, dv)
    lam = (jnp.exp(jnp.sum(lq1.astype(jnp.float32) * lk1.astype(jnp.float32)))
           - jnp.exp(jnp.sum(lq2.astype(jnp.float32) * lk2.astype(jnp.float32))) + lam_init)
    kpos = jnp.arange(seq)

    def block(args):
        q_b, t_b = args
        s = jnp.einsum('bqhcd,bkhcd->bhcqk', q_b, k).astype(jnp.float32) * scale
        p = _masked_softmax(s, kpos[None, :] <= t_b[:, None])
        a = p[:, :, 0] - lam * p[:, :, 1]
        return jnp.einsum('bhqk,bkhe->bqhe', a.astype(v.dtype), v)

    q_blocks = q.reshape(bsz, nb, QB, H, 2, dh).transpose(1, 0, 2, 3, 4, 5)
    o = lax.map(block, (q_blocks, kpos.reshape(nb, QB)))
    o = o.transpose(1, 0, 2, 3, 4).reshape(bsz, seq, H, dv)
    o = _rms(o) * (1.0 - lam_init)
    return o.reshape(bsz, seq, H * dv)


def setup_inputs(seed: int = 0) -> dict:
    key = jax.random.key(seed)
    ks = jax.random.split(key, 32)
    f32 = jnp.float32
    nrm = lambda k, shape, s: jax.random.normal(k, shape, f32) * s
    x = jax.random.normal(ks[0], (BATCH, SEQ, D_MODEL), f32)
    positions = (jnp.arange(SEQ, dtype=jnp.int32)[None, :]
                 + jax.random.randint(ks[1], (BATCH, 1), 0, 1024, dtype=jnp.int32))
    norm1_g = 1.0 + nrm(ks[2], (DEPTH, D_MODEL), 0.02)
    w_in = nrm(ks[3], (DEPTH, D_MODEL, N_IN), D_MODEL ** -0.5)
    s5_lambda_re = -0.5 + nrm(ks[4], (DEPTH, S5_G, S5_P), 0.01)
    s5_lambda_im = math.pi * jnp.arange(S5_P, dtype=f32)[None, None, :] + nrm(ks[5], (DEPTH, S5_G, S5_P), 0.01)
    s5_log_dt = jax.random.uniform(ks[6], (DEPTH, S5_G), f32, math.log(S5_DT_MIN), math.log(S5_DT_MAX))
    s5_b_re = nrm(ks[7], (DEPTH, S5_G, S5_P, S5_GROUP), (2 * S5_GROUP) ** -0.5)
    s5_b_im = nrm(ks[8], (DEPTH, S5_G, S5_P, S5_GROUP), (2 * S5_GROUP) ** -0.5)
    s5_c_re = nrm(ks[9], (DEPTH, S5_G, S5_GROUP, S5_P), (2 * S5_P) ** -0.5)
    s5_c_im = nrm(ks[10], (DEPTH, S5_G, S5_GROUP, S5_P), (2 * S5_P) ** -0.5)
    s5_d = nrm(ks[11], (DEPTH, S5_G, S5_GROUP), 1.0)
    s5_w_glu = nrm(ks[12], (DEPTH, S5_CH, S5_CH), S5_CH ** -0.5)
    nsa_pe_k = nrm(ks[13], (DEPTH, NSA_CMP_LEN, NSA_DH), 0.1)
    nsa_pe_v = nrm(ks[14], (DEPTH, NSA_CMP_LEN, NSA_DH), 0.1)
    nsa_w_cmp_k = nrm(ks[15], (DEPTH, NSA_CMP_LEN * NSA_DH, NSA_DH), (NSA_CMP_LEN * NSA_DH) ** -0.5)
    nsa_w_cmp_v = nrm(ks[16], (DEPTH, NSA_CMP_LEN * NSA_DH, NSA_DH), (NSA_CMP_LEN * NSA_DH) ** -0.5)
    diff_lq1 = nrm(ks[17], (DEPTH, DIFF_DH), 0.1)
    diff_lk1 = nrm(ks[18], (DEPTH, DIFF_DH), 0.1)
    diff_lq2 = nrm(ks[19], (DEPTH, DIFF_DH), 0.1)
    diff_lk2 = nrm(ks[20], (DEPTH, DIFF_DH), 0.1)
    w_out = nrm(ks[21], (DEPTH, D_MIX, D_MODEL), D_MIX ** -0.5)
    norm2_g = 1.0 + nrm(ks[22], (DEPTH, D_MODEL), 0.02)
    mlp_w1 = nrm(ks[23], (DEPTH, D_MODEL, D_FF), D_MODEL ** -0.5)
    mlp_w2 = nrm(ks[24], (DEPTH, D_FF, D_MODEL), D_FF ** -0.5)
    return {"x": x, "positions": positions, "norm1_g": norm1_g, "w_in": w_in,
            "s5_lambda_re": s5_lambda_re, "s5_lambda_im": s5_lambda_im, "s5_log_dt": s5_log_dt,
            "s5_b_re": s5_b_re, "s5_b_im": s5_b_im, "s5_c_re": s5_c_re, "s5_c_im": s5_c_im,
            "s5_d": s5_d, "s5_w_glu": s5_w_glu, "nsa_pe_k": nsa_pe_k, "nsa_pe_v": nsa_pe_v,
            "nsa_w_cmp_k": nsa_w_cmp_k, "nsa_w_cmp_v": nsa_w_cmp_v,
            "diff_lq1": diff_lq1, "diff_lk1": diff_lk1, "diff_lq2": diff_lq2, "diff_lk2": diff_lk2,
            "w_out": w_out, "norm2_g": norm2_g, "mlp_w1": mlp_w1, "mlp_w2": mlp_w2}


def reference(x, positions, norm1_g, w_in, s5_lambda_re, s5_lambda_im, s5_log_dt,
              s5_b_re, s5_b_im, s5_c_re, s5_c_im, s5_d, s5_w_glu, nsa_pe_k, nsa_pe_v,
              nsa_w_cmp_k, nsa_w_cmp_v, diff_lq1, diff_lk1, diff_lq2, diff_lk2,
              w_out, norm2_g, mlp_w1, mlp_w2):
    split_points = []
    acc = 0
    for w in SPLIT_WIDTHS[:-1]:
        acc += w
        split_points.append(acc)
    for layer in range(DEPTH):
        h = _rms(x, norm1_g[layer])
        (u, rq, rk, rv, rg, nq, nkc, nvc, nks, nvs, nkw, nvw, ngate,
         dq, dk, dv) = jnp.split(h @ w_in[layer], split_points, axis=-1)
        y_a = _s5_mixer(u, s5_lambda_re[layer], s5_lambda_im[layer], s5_log_dt[layer],
                        s5_b_re[layer], s5_b_im[layer], s5_c_re[layer], s5_c_im[layer],
                        s5_d[layer], s5_w_glu[layer])
        y_b = _retention(rq, rk, rv, rg, positions)
        y_c = _nsa(nq, nkc, nvc, nks, nvs, nkw, nvw, ngate, positions,
                   nsa_pe_k[layer], nsa_pe_v[layer], nsa_w_cmp_k[layer], nsa_w_cmp_v[layer])
        lam_init = 0.8 - 0.6 * math.exp(-0.3 * layer)
        y_d = _diff_attn(dq, dk, dv, positions, diff_lq1[layer], diff_lk1[layer],
                         diff_lq2[layer], diff_lk2[layer], lam_init)
        mixed = jnp.concatenate([y_a.astype(x.dtype), y_b.astype(x.dtype),
                                 y_c.astype(x.dtype), y_d.astype(x.dtype)], axis=-1)
        x = x + mixed @ w_out[layer]
        h2 = _rms(x, norm2_g[layer])
        x = x + jnp.square(jax.nn.relu(h2 @ mlp_w1[layer])) @ mlp_w2[layer]
    return x
```

```cpp
#include <hip/hip_runtime.h>
#include <hip/hip_cooperative_groups.h>
#include <cstdio>
#include <cstdint>
#include <cmath>
namespace cg = cooperative_groups;

typedef unsigned short bf16_t;
typedef short bf16x8 __attribute__((ext_vector_type(8)));
typedef float f32x4 __attribute__((ext_vector_type(4)));
typedef unsigned u32x2 __attribute__((ext_vector_type(2)));
typedef unsigned u32x4 __attribute__((ext_vector_type(4)));

constexpr int DM = 2048, NB = 4, SEQ = 2048, DEPTH = 2, MTOK = NB * SEQ;
constexpr int DFF = 8192, NIN = 5388, NP = 5632;
constexpr float EPS = 1e-6f;
constexpr int C_U = 0, C_RQ = 512, C_RK = 1024, C_RV = 1536, C_RG = 2048, C_NQ = 2560, C_NKC = 3072, C_NVC = 3200, C_NKS = 3328, C_NVS = 3456,
              C_NKW = 3584, C_NVW = 3712, C_DQ = 3840, C_DK = 4352, C_DV = 4864, C_GATE = 5376;
__host__ __device__ inline int orig_col(int c) { if (c < 3840) return c; if (c < 5376) return c + 12; if (c < 5388) return 3840 + (c - 5376); return -1; }

constexpr size_t MiB = 1u << 20;
constexpr size_t WS_CTL = 0, CTL_BYTES = 1 * MiB;
constexpr size_t WS_QUEUE = 8 * 1024;
constexpr size_t WS_CMPCNT = 10 * 1024;
constexpr size_t WS_LAM = 12 * 1024;
constexpr size_t WS_BAR = 16 * 1024;
constexpr size_t WS_SUMSQ = 64 * 1024;
constexpr size_t WS_ROPE128 = 1 * MiB;
constexpr size_t WS_ROPE64 = 5 * MiB;
constexpr size_t WS_S5PRE = 7 * MiB;
constexpr size_t S5PRE_LAYER = 32 * 64 * 8 + 32 * 64 * 16 * 8;
constexpr size_t WS_KVCMP = 8 * MiB;
constexpr size_t WS_KVCMPB = 9 * MiB;
constexpr size_t WS_WGLU = 10 * MiB;
constexpr size_t WS_WIN = 12 * MiB, WIN_LAYER = (size_t)NP * DM * 2;
constexpr size_t WS_WOUT = 56 * MiB, WOUT_LAYER = (size_t)DM * DM * 2;
constexpr size_t WS_W1 = 72 * MiB, W1_LAYER = (size_t)DFF * DM * 2;
constexpr size_t WS_W2 = 136 * MiB, W2_LAYER = (size_t)DM * DFF * 2;
constexpr size_t WS_XB = 200 * MiB;
constexpr size_t WS_MIXED = 232 * MiB;
constexpr size_t WS_S5Y = 264 * MiB;
constexpr size_t WS_HID = 272 * MiB;
constexpr size_t WS_PROJ = 272 * MiB;
constexpr size_t WS_WCMP = 400 * MiB;
constexpr size_t WS_KPART = 404 * MiB;
constexpr size_t WS_END = 406 * MiB;

constexpr int NTHREADS = 512, NWAVES = 8;
constexpr int LDS_BYTES = 147456;

struct Params {
    const float* in[25];
    float* out;
    unsigned char* ws;
    float inv128[64];
    float inv64[32];
};

__device__ __forceinline__ float bf2f(bf16_t v) { return __uint_as_float((unsigned)v << 16); }
__device__ __forceinline__ unsigned f2bf(float f) { unsigned u = __float_as_uint(f); return (u + 0x7fffu + ((u >> 16) & 1u)) >> 16; }
__device__ __forceinline__ unsigned pk2(float lo, float hi) { return f2bf(lo) | (f2bf(hi) << 16); }
__device__ __forceinline__ float shx(float v, int o, int lane) { return __int_as_float(__builtin_amdgcn_ds_bpermute((lane ^ o) << 2, __float_as_int(v))); }
__device__ __forceinline__ float shl(float v, int src, int lane) { (void)lane; return __int_as_float(__builtin_amdgcn_ds_bpermute(src << 2, __float_as_int(v))); }
__device__ __forceinline__ float wave_sum(float v, int lane) {
#pragma unroll
    for (int o = 1; o < 64; o <<= 1) v += shx(v, o, lane);
    return v;
}
__device__ __forceinline__ float wave_max(float v, int lane) {
#pragma unroll
    for (int o = 1; o < 64; o <<= 1) v = fmaxf(v, shx(v, o, lane));
    return v;
}
__device__ __forceinline__ float half_sum(float v) { auto r = __builtin_amdgcn_permlane32_swap(__float_as_uint(v), __float_as_uint(v), false, false); return __uint_as_float(r[0]) + __uint_as_float(r[1]); }
__device__ __forceinline__ float half_max(float v) { auto r = __builtin_amdgcn_permlane32_swap(__float_as_uint(v), __float_as_uint(v), false, false); return fmaxf(__uint_as_float(r[0]), __uint_as_float(r[1])); }
#define LDS_WAIT() asm volatile("s_waitcnt lgkmcnt(0)" ::: "memory")
__device__ __forceinline__ int opaque_tid() { int t = (int)threadIdx.x; asm volatile("" : "+v"(t)); return t; }

__device__ __forceinline__ void transpose_item(const float* W, int K, int N, const float* gk, bf16_t* WT, bool winmap, float* scr, int item, int nblk, int lane) {
    const int kb = item / nblk, nb = item % nblk, k0 = 64 * kb, n0 = 32 * nb;
    const int c4 = (lane & 7) * 4, rr = lane >> 3;
    const int oc = winmap ? orig_col(n0 + c4) : n0 + c4;
    f32x4 v[8];
#pragma unroll
    for (int i = 0; i < 8; ++i) v[i] = (oc >= 0) ? *(const f32x4*)(W + (size_t)(k0 + 8 * i + rr) * N + oc) : (f32x4){0.f, 0.f, 0.f, 0.f};
#pragma unroll
    for (int i = 0; i < 8; ++i) {
        const int kk = 8 * i + rr;
        f32x4 t = v[i];
        if (gk) t = t * gk[k0 + kk];
        float* d = scr + kk * 33 + c4;
        d[0] = t.x; d[1] = t.y; d[2] = t.z; d[3] = t.w;
    }
    LDS_WAIT();
    const int c = lane & 7;
#pragma unroll
    for (int j = 0; j < 4; ++j) {
        const int nn = (lane >> 3) + 8 * j;
        const float* s = scr + (8 * c) * 33 + nn;
        u32x4 o;
        o.x = pk2(s[0 * 33], s[1 * 33]); o.y = pk2(s[2 * 33], s[3 * 33]); o.z = pk2(s[4 * 33], s[5 * 33]); o.w = pk2(s[6 * 33], s[7 * 33]);
        *(u32x4*)(WT + (size_t)(n0 + nn) * K + k0 + 8 * c) = o;
    }
    LDS_WAIT();
}

constexpr int I_IN = (DM / 64) * (NP / 32), I_OUT = (DM / 64) * (DM / 32), I_1 = (DM / 64) * (DFF / 32), I_2 = (DFF / 64) * (DM / 32), I_G = (512 / 64) * (512 / 32), I_C = (4096 / 64) * (128 / 32);
constexpr int I_LAYER = I_IN + I_OUT + I_1 + I_2 + I_G + 2 * I_C;
__device__ __forceinline__ void conv_wave_item(const Params& p, float* scr, int L, int r, int lane) {
    unsigned char* ws = p.ws;
    if (r < I_IN) { transpose_item(p.in[3] + (size_t)L * DM * NIN, DM, NIN, p.in[2] + L * DM, (bf16_t*)(ws + WS_WIN + L * WIN_LAYER), true, scr, r, NP / 32, lane); return; } r -= I_IN;
    if (r < I_OUT) { transpose_item(p.in[21] + (size_t)L * DM * DM, DM, DM, nullptr, (bf16_t*)(ws + WS_WOUT + L * WOUT_LAYER), false, scr, r, DM / 32, lane); return; } r -= I_OUT;
    if (r < I_1) { transpose_item(p.in[23] + (size_t)L * DM * DFF, DM, DFF, p.in[22] + L * DM, (bf16_t*)(ws + WS_W1 + L * W1_LAYER), false, scr, r, DFF / 32, lane); return; } r -= I_1;
    if (r < I_2) { transpose_item(p.in[24] + (size_t)L * DFF * DM, DFF, DM, nullptr, (bf16_t*)(ws + WS_W2 + L * W2_LAYER), false, scr, r, DM / 32, lane); return; } r -= I_2;
    if (r < I_G) { transpose_item(p.in[12] + (size_t)L * 512 * 512, 512, 512, nullptr, (bf16_t*)(ws + WS_WGLU + (size_t)L * 512 * 512 * 2), false, scr, r, 512 / 32, lane); return; } r -= I_G;
    { const int kv = r / I_C; r -= kv * I_C;
      transpose_item(p.in[15 + kv] + (size_t)L * 4096 * 128, 4096, 128, nullptr, (bf16_t*)(ws + WS_WCMP) + ((size_t)(L * 2 + kv)) * 128 * 4096, false, scr, r, 128 / 32, lane); }
}
constexpr int CONV_A = I_IN + I_G + 2 * I_C, CONV_B0 = I_OUT + I_1 + I_2, CONV_B = CONV_B0 + I_LAYER;
constexpr int CONV_A_BLK = CONV_A / 32, CONV_B_BLK = CONV_B / 32;
static_assert(CONV_A % 32 == 0 && CONV_B % 32 == 0, "conversion block-items");
__device__ __forceinline__ void conv_block_item(const Params& p, unsigned char* lds, int blk, int tid) {
    const int lane = tid & 63, wave = tid >> 6;
    float* scr = (float*)(lds + wave * 8448);
#pragma unroll 1
    for (int i = 0; i < 4; ++i) {
        int L = 0, r;
        if (blk < CONV_A_BLK) {
            const int a = blk * 32 + i * 8 + wave;
            r = a < I_IN ? a : (a < I_IN + I_G ? I_IN + I_OUT + I_1 + I_2 + (a - I_IN) : I_IN + I_OUT + I_1 + I_2 + I_G + (a - I_IN - I_G));
        } else {
            const int bidx = (blk - CONV_A_BLK) * 32 + i * 8 + wave;
            if (bidx < CONV_B0) r = I_IN + bidx; else { L = 1; r = bidx - CONV_B0; }
        }
        conv_wave_item(p, scr, L, r, lane);
    }
}
__device__ __forceinline__ void conv_fill(const Params& p, unsigned char* lds, int max_items) {
    const int tid = opaque_tid();
    volatile int* slot = (volatile int*)(lds + 131072 + 60);
    unsigned* qc = (unsigned*)(p.ws + WS_QUEUE) + 2 * 64;
    for (int n = 0; n < max_items; ++n) {
        if (tid == 0) *slot = (int)atomicAdd(qc, 1u);
        __syncthreads();
        const int q = *slot;
        __syncthreads();
        if (q >= CONV_B_BLK) break;
        conv_block_item(p, lds, CONV_A_BLK + q, tid);
    }
    __syncthreads();
}

__device__ void phase_prologue(const Params& p, unsigned char* lds) {
    const int tid = opaque_tid(), lane = tid & 63, wave = tid >> 6;
    const int gw = blockIdx.x * NWAVES + wave, NGW = gridDim.x * NWAVES;
    unsigned char* ws = p.ws;
    for (int blk = blockIdx.x; blk < CONV_A_BLK; blk += gridDim.x) conv_block_item(p, lds, blk, tid);
    if (blockIdx.x == gridDim.x - 1 && wave == 0) {
        for (int L = 0; L < DEPTH; ++L) {
            const float lam_init = 0.8f - 0.6f * expf(-0.3f * (float)L);
            const float a = p.in[17][L * 64 + lane] * p.in[18][L * 64 + lane];
            const float c = p.in[19][L * 64 + lane] * p.in[20][L * 64 + lane];
            const float lamv = expf(wave_sum(a, lane)) - expf(wave_sum(c, lane)) + lam_init;
            if (lane == 0) { float* lw = (float*)(ws + WS_LAM) + 2 * L; lw[0] = lamv; lw[1] = lam_init; }
        }
    }
    const float* x = p.in[0];
    bf16_t* xb = (bf16_t*)(ws + WS_XB);
    float* sumsq = (float*)(ws + WS_SUMSQ);
    const int* pos = (const int*)p.in[1];
    float2* r128 = (float2*)(ws + WS_ROPE128);
    float2* r64 = (float2*)(ws + WS_ROPE64);
    for (int m = gw; m < MTOK; m += NGW) {
        const f32x4* xr = (const f32x4*)(x + (size_t)m * DM);
        float ss = 0.f;
#pragma unroll
        for (int j = 0; j < 8; ++j) {
            const f32x4 v = xr[64 * j + lane];
            ss += v.x * v.x + v.y * v.y + v.z * v.z + v.w * v.w;
            u32x2 o; o.x = pk2(v.x, v.y); o.y = pk2(v.z, v.w);
            *(u32x2*)(xb + (size_t)m * DM + 4 * (64 * j + lane)) = o;
        }
        ss = wave_sum(ss, lane);
        if (lane == 0) sumsq[m] = ss;
        const float fp = (float)pos[m];
        { const float ang = fp * p.inv128[lane]; float s, c; sincosf(ang, &s, &c); r128[(size_t)m * 64 + lane] = make_float2(c, s); }
        if (lane < 32) { const float ang = fp * p.inv64[lane]; float s, c; sincosf(ang, &s, &c); r64[(size_t)m * 32 + lane] = make_float2(c, s); }
    }
    for (int it = blockIdx.x * NTHREADS + tid; it < DEPTH * 32 * 64; it += gridDim.x * NTHREADS) {
        const int L = it / (32 * 64), gp = it % (32 * 64), g = gp / 64;
        const float lr = p.in[4][(size_t)L * 2048 + gp], li = p.in[5][(size_t)L * 2048 + gp];
        const float dt = expf(p.in[6][L * 32 + g]);
        const float mag = expf(lr * dt);
        float sn, cs; sincosf(li * dt, &sn, &cs);
        const float lbr = mag * cs, lbi = mag * sn;
        const float den = lr * lr + li * li;
        const float fr = ((lbr - 1.0f) * lr + lbi * li) / den;
        const float fi = (lbi * lr - (lbr - 1.0f) * li) / den;
        unsigned char* pre = ws + WS_S5PRE + L * S5PRE_LAYER;
        float2* lb = (float2*)pre;
        bf16_t* bb16 = (bf16_t*)(pre + 16384);
        bf16_t* cm16 = (bf16_t*)(pre + 16384 + 131072);
        lb[gp] = make_float2(lbr, lbi);
        const int pst = gp & 63;
        const float* bre = p.in[7] + ((size_t)L * 2048 + gp) * 16;
        const float* bim = p.in[8] + ((size_t)L * 2048 + gp) * 16;
#pragma unroll
        for (int h = 0; h < 16; ++h) {
            bb16[((size_t)(g * 128 + 2 * pst)) * 16 + h] = (bf16_t)f2bf(fr * bre[h] - fi * bim[h]);
            bb16[((size_t)(g * 128 + 2 * pst + 1)) * 16 + h] = (bf16_t)f2bf(fr * bim[h] + fi * bre[h]);
        }
#pragma unroll
        for (int n = 0; n < 16; ++n) {
            const float cr = p.in[9][(((size_t)L * 32 + g) * 16 + n) * 64 + pst], ci = p.in[10][(((size_t)L * 32 + g) * 16 + n) * 64 + pst];
            *(unsigned*)(cm16 + ((size_t)(g * 16 + n)) * 128 + 2 * pst) = pk2(cr, -ci);
        }
    }
}

namespace pg8 {
#define PG8_LAS __attribute__((address_space(3)))
typedef unsigned short bf16_t;
typedef short bf16x8 __attribute__((ext_vector_type(8)));
typedef float f32x4 __attribute__((ext_vector_type(4)));
typedef unsigned u32x4 __attribute__((ext_vector_type(4)));
constexpr int BM = 256, BK = 64, HALF = 128, HTB = HALF * BK * 2  , STAGE_BYTES = 8 * HTB, NXCD = 8, WGM = 8;

__host__ __device__ __forceinline__ int lds_byte(int r, int c) { const int st = (r >> 4) * 2 + (c >> 5), rr = r & 15, cc = c & 31, ob = rr * 64 + cc * 2; return st * 1024 + (ob ^ (((ob >> 9) & 1) << 5)); }
__host__ __device__ __forceinline__ void stage_rc(int b, int& R, int& C) { const int st = b / 1024, sb = b % 1024, swz = sb ^ (((sb >> 9) & 1) << 5); R = (st >> 1) * 16 + swz / 64; C = (st & 1) * 32 + (swz % 64) / 2; }
__host__ __device__ __forceinline__ int perm32(int rho) { const int n = rho >> 4, i = rho & 15; return 8 * (i >> 2) + 4 * n + (i & 3); }

struct Unit { int pm, pn; };
struct Gemm { const bf16_t* A; const bf16_t* Bt; int M, N, K; };

struct StaticOrder {
    int nM, nN, nwg, G, c;
    __host__ __device__ void init(int M, int N, int G_, int c_) { nM = M / BM; nN = N / BM; nwg = nM * nN; G = G_; c = c_; }
    __host__ __device__ bool next(int i, Unit& u) const {
        const long L = (long)i * G + c; if (L >= nwg) return false;
        int wgid = (int)L; { const int q = nwg / NXCD, r = nwg % NXCD, xcd = wgid % NXCD, off = wgid / NXCD; wgid = (xcd < r ? xcd * (q + 1) : r * (q + 1) + (xcd - r) * q) + off; }
        const int nig = WGM * nN, gid = wgid / nig, fm = gid * WGM, gsz = (nM - fm) < WGM ? (nM - fm) : WGM;
        u.pm = fm + ((wgid % nig) % gsz); u.pn = (wgid % nig) / gsz; return true;
    }
    __device__ __forceinline__ void a_ready(const Unit&) const {}
    __device__ __forceinline__ void done(const Unit&) const {}
};

__device__ __forceinline__ unsigned cvt_pk_bf16(float lo, float hi) { unsigned r; asm volatile("v_cvt_pk_bf16_f32 %0, %1, %2" : "=v"(r) : "v"(lo), "v"(hi)); return r; }
template <class Epi, class Sched, bool ALIGN_EPI = false, bool SP2 = false>
__device__ __forceinline__ void gemm_phase(PG8_LAS unsigned char* lds, const Gemm g, const Sched& S, const Epi& E) {
    const int tid = opaque_tid(), wid = __builtin_amdgcn_readfirstlane(tid >> 6), lane = tid & 63, wr = wid >> 2, wc = wid & 3, fr = lane & 15, fq = lane >> 4;
    const int K = g.K, nt = K / BK;
    unsigned voffA[2], voffB[2];
#pragma unroll
    for (int i = 0; i < 2; ++i) { int R, C; stage_rc(tid * 16 + i * 8192, R, C); const int Rb = Epi::PERM ? ((R & ~31) + perm32(R & 31)) : R;
        voffA[i] = (unsigned)(R * K + C) * 2u; voffB[i] = (unsigned)(Rb * K + C) * 2u; }
    const size_t kstep = (size_t)(BK * 2);
    const size_t hstep = (size_t)HALF * K * 2;
    const size_t tstep = 2 * hstep;
    const unsigned ldsw = (unsigned)wid * 1024u;
    const int aoff = lds_byte(wr * 64 + fr, fq * 8), boff = lds_byte(wc * 32 + fr, fq * 8);
#define PG8_SA(b, h) (((b) * 2 + (h)) * HTB)
#define PG8_SB(b, h) ((4 + (b) * 2 + (h)) * HTB)
#define PG8_STAGE(bufoff, gbase, voff) do { _Pragma("unroll") for (int _i = 0; _i < 2; ++_i) \
        __builtin_amdgcn_global_load_lds((const unsigned*)((const char*)(gbase) + (voff)[_i]), (PG8_LAS unsigned*)(lds + (bufoff) + ldsw + _i * 8192), 16, 0, 0); } while (0)
#define PG8_LDA(dst, b, h) do { _Pragma("unroll") for (int m = 0; m < 4; ++m) _Pragma("unroll") for (int k = 0; k < 2; ++k) dst[m][k] = *(const PG8_LAS bf16x8*)(lds + PG8_SA(b, h) + aoff + m * 2048 + k * 1024); } while (0)
#define PG8_LDB(dst, b, h) do { _Pragma("unroll") for (int n = 0; n < 2; ++n) _Pragma("unroll") for (int k = 0; k < 2; ++k) dst[n][k] = *(const PG8_LAS bf16x8*)(lds + PG8_SB(b, h) + boff + n * 2048 + k * 1024); } while (0)
#define PG8_MMA(ai, bj, At, Bt) do { __builtin_amdgcn_s_setprio(1); _Pragma("unroll") for (int m = 0; m < 4; ++m) _Pragma("unroll") for (int n = 0; n < 2; ++n) _Pragma("unroll") for (int k = 0; k < 2; ++k) \
        acc[ai][bj][m][n] = __builtin_amdgcn_mfma_f32_16x16x32_bf16(Bt[n][k], At[m][k], acc[ai][bj][m][n], 0, 0, 0); __builtin_amdgcn_s_setprio(0); } while (0)
#define PG8_WAIT_V(n) asm volatile("s_waitcnt vmcnt(" #n ")" ::: "memory")
#define PG8_WAIT_L(n) asm volatile("s_waitcnt lgkmcnt(" #n ")" ::: "memory")
#define PG8_BAR __builtin_amdgcn_s_barrier()
#define PG8_SCHED __builtin_amdgcn_sched_barrier(0)
    Unit cur, nxt; int ui = 0;
    if (!S.next(0, cur)) return;
    f32x4 acc[2][2][4][2];
#pragma unroll
    for (int a = 0; a < 2; ++a)
#pragma unroll
        for (int b = 0; b < 2; ++b)
#pragma unroll
            for (int m = 0; m < 4; ++m)
#pragma unroll
                for (int n = 0; n < 2; ++n) acc[a][b][m][n] = (f32x4){0.f, 0.f, 0.f, 0.f};
    bf16x8 At[4][2], B0[2][2], B1[2][2];
    const char* cA = (const char*)g.A + (size_t)cur.pm * tstep; const char* cB = (const char*)g.Bt + (size_t)cur.pn * tstep;
    S.a_ready(cur);
    if constexpr (SP2) {
        PG8_STAGE(PG8_SB(0, 0), cB, voffB); PG8_STAGE(PG8_SB(0, 1), cB + hstep, voffB); PG8_STAGE(PG8_SA(0, 0), cA, voffA); PG8_STAGE(PG8_SA(0, 1), cA + hstep, voffA);
        if (wr == 1) PG8_BAR;
        PG8_WAIT_V(2); PG8_BAR;
        PG8_STAGE(PG8_SB(1, 0), cB + kstep, voffB); PG8_STAGE(PG8_SA(1, 0), cA + kstep, voffA); PG8_STAGE(PG8_SB(1, 1), cB + hstep + kstep, voffB);
        PG8_WAIT_V(6); PG8_BAR;
    } else {
        PG8_STAGE(PG8_SB(0, 0), cB, voffB); PG8_STAGE(PG8_SA(0, 0), cA, voffA); PG8_STAGE(PG8_SB(0, 1), cB + hstep, voffB); PG8_STAGE(PG8_SA(0, 1), cA + hstep, voffA);
        if (wr == 1) PG8_BAR;
        PG8_WAIT_V(4); PG8_BAR;
        PG8_STAGE(PG8_SB(1, 0), cB + kstep, voffB); PG8_STAGE(PG8_SA(1, 0), cA + kstep, voffA); PG8_STAGE(PG8_SB(1, 1), cB + hstep + kstep, voffB);
        PG8_WAIT_V(6); PG8_BAR;
    }
    for (;;) {
        const bool has_next = S.next(ui + 1, nxt);
        const char* nA = has_next ? (const char*)g.A + (size_t)nxt.pm * tstep : cA; const char* nB = has_next ? (const char*)g.Bt + (size_t)nxt.pn * tstep : cB;
        for (int t = 0; t < nt; t += 2) {
            const bool last = (t == nt - 2);
            const char* a1 = cA + (size_t)(t + 1) * kstep;
            const char* a2 = last ? nA : cA + (size_t)(t + 2) * kstep; const char* b2 = last ? nB : cB + (size_t)(t + 2) * kstep;
            const char* a3 = a2 + kstep; const char* b3 = b2 + kstep;
            if (last && has_next) S.a_ready(nxt);
            if constexpr (SP2) {
            PG8_LDB(B0, 0, 0); PG8_LDB(B1, 0, 1); PG8_SCHED; PG8_LDA(At, 0, 0); PG8_STAGE(PG8_SA(1, 1), a1 + hstep, voffA);
            PG8_WAIT_V(8); PG8_WAIT_L(0); PG8_BAR; PG8_MMA(0, 0, At, B0); PG8_MMA(0, 1, At, B1); PG8_BAR; PG8_SCHED;
            PG8_LDA(At, 0, 1); PG8_STAGE(PG8_SB(0, 0), b2, voffB); PG8_STAGE(PG8_SB(0, 1), b2 + hstep, voffB); PG8_STAGE(PG8_SA(0, 0), a2, voffA);
            PG8_WAIT_V(8); PG8_WAIT_L(0); PG8_BAR; PG8_MMA(1, 0, At, B0); PG8_MMA(1, 1, At, B1); PG8_BAR; PG8_SCHED;
            PG8_LDB(B0, 1, 0); PG8_LDB(B1, 1, 1); PG8_SCHED; PG8_LDA(At, 1, 0); PG8_STAGE(PG8_SA(0, 1), a2 + hstep, voffA);
            PG8_WAIT_V(8); PG8_WAIT_L(0); PG8_BAR; PG8_MMA(0, 0, At, B0); PG8_MMA(0, 1, At, B1); PG8_BAR; PG8_SCHED;
            PG8_LDA(At, 1, 1); PG8_STAGE(PG8_SB(1, 0), b3, voffB); PG8_STAGE(PG8_SB(1, 1), b3 + hstep, voffB); PG8_STAGE(PG8_SA(1, 0), a3, voffA);
            PG8_WAIT_V(8); PG8_WAIT_L(0); PG8_BAR; PG8_MMA(1, 0, At, B0); PG8_MMA(1, 1, At, B1); PG8_BAR; PG8_SCHED;
            } else {
            PG8_LDB(B0, 0, 0); PG8_SCHED; PG8_LDA(At, 0, 0); PG8_STAGE(PG8_SA(1, 1), a1 + hstep, voffA);
            PG8_WAIT_L(8); PG8_BAR; PG8_WAIT_L(0); PG8_MMA(0, 0, At, B0); PG8_BAR; PG8_SCHED;
            PG8_LDB(B1, 0, 1); PG8_STAGE(PG8_SB(0, 0), b2, voffB);
            PG8_BAR; PG8_WAIT_L(0); PG8_MMA(0, 1, At, B1); PG8_BAR;
            PG8_LDA(At, 0, 1); PG8_STAGE(PG8_SA(0, 0), a2, voffA);
            PG8_BAR; PG8_WAIT_L(0); PG8_MMA(1, 0, At, B0); PG8_BAR; PG8_SCHED;
            PG8_STAGE(PG8_SB(0, 1), b2 + hstep, voffB);
            PG8_WAIT_V(6); PG8_BAR; PG8_MMA(1, 1, At, B1); PG8_BAR;
            PG8_LDB(B0, 1, 0); PG8_SCHED; PG8_LDA(At, 1, 0); PG8_STAGE(PG8_SA(0, 1), a2 + hstep, voffA);
            PG8_WAIT_L(8); PG8_BAR; PG8_WAIT_L(0); PG8_MMA(0, 0, At, B0); PG8_BAR; PG8_SCHED;
            PG8_LDB(B1, 1, 1); PG8_STAGE(PG8_SB(1, 0), b3, voffB);
            PG8_BAR; PG8_WAIT_L(0); PG8_MMA(0, 1, At, B1); PG8_BAR;
            PG8_LDA(At, 1, 1); PG8_STAGE(PG8_SA(1, 0), a3, voffA);
            PG8_BAR; PG8_WAIT_L(0); PG8_MMA(1, 0, At, B0); PG8_BAR; PG8_SCHED;
            PG8_STAGE(PG8_SB(1, 1), b3 + hstep, voffB);
            PG8_WAIT_V(6); PG8_BAR; PG8_MMA(1, 1, At, B1); PG8_BAR;
            }
        }
        if constexpr (ALIGN_EPI) { if (wr == 0) PG8_BAR; }
        if constexpr (!Epi::AFTER_DRAIN) { E(acc, cur, wr, wc, fr, fq); S.done(cur); }
        if (!has_next) break;
#pragma unroll
        for (int a = 0; a < 2; ++a)
#pragma unroll
            for (int b = 0; b < 2; ++b)
#pragma unroll
                for (int m = 0; m < 4; ++m)
#pragma unroll
                    for (int n = 0; n < 2; ++n) acc[a][b][m][n] = (f32x4){0.f, 0.f, 0.f, 0.f};
        cur = nxt; cA = nA; cB = nB; ++ui;
        if constexpr (ALIGN_EPI) { if (wr == 1) PG8_BAR; }
    }
    PG8_WAIT_V(0);
    if constexpr (!ALIGN_EPI) { if (wr == 0) PG8_BAR; }
    PG8_BAR;
    if constexpr (Epi::AFTER_DRAIN) { E.fused(acc, cur, wr, wc, fr, fq, lds, wid, lane); S.done(cur); }
#undef PG8_SA
#undef PG8_SB
#undef PG8_STAGE
#undef PG8_LDA
#undef PG8_LDB
#undef PG8_MMA
#undef PG8_WAIT_V
#undef PG8_WAIT_L
#undef PG8_BAR
#undef PG8_SCHED
}
}

struct EpiScale {
    static constexpr bool PERM = true, AFTER_DRAIN = false;
    bf16_t* O; int ldc; const float* sumsq; int relu2;
    __device__ __forceinline__ void operator()(const f32x4 (&acc)[2][2][4][2], const pg8::Unit& u, int wr, int wc, int fr, int fq) const {
        const int row0 = u.pm * 256 + wr * 64 + fr, col0 = u.pn * 256 + wc * 32 + 8 * fq;
        float rs[2][4];
#pragma unroll
        for (int ai = 0; ai < 2; ++ai)
#pragma unroll
            for (int m = 0; m < 4; ++m) rs[ai][m] = sumsq[row0 + ai * 128 + m * 16];
#pragma unroll
        for (int ai = 0; ai < 2; ++ai)
#pragma unroll
            for (int m = 0; m < 4; ++m) {
                const int row = row0 + ai * 128 + m * 16;
                const float rstd = rsqrtf(rs[ai][m] * (1.0f / DM) + EPS);
                bf16_t* rowp = O + (size_t)row * ldc + col0;
#pragma unroll
                for (int bj = 0; bj < 2; ++bj) {
                    f32x4 v0 = acc[ai][bj][m][0] * rstd, v1 = acc[ai][bj][m][1] * rstd;
                    if (relu2) {
                        v0.x = fmaxf(v0.x, 0.f); v0.y = fmaxf(v0.y, 0.f); v0.z = fmaxf(v0.z, 0.f); v0.w = fmaxf(v0.w, 0.f);
                        v1.x = fmaxf(v1.x, 0.f); v1.y = fmaxf(v1.y, 0.f); v1.z = fmaxf(v1.z, 0.f); v1.w = fmaxf(v1.w, 0.f);
                        v0 = v0 * v0; v1 = v1 * v1;
                    }
                    u32x4 w; w.x = pg8::cvt_pk_bf16(v0[0], v0[1]); w.y = pg8::cvt_pk_bf16(v0[2], v0[3]); w.z = pg8::cvt_pk_bf16(v1[0], v1[1]); w.w = pg8::cvt_pk_bf16(v1[2], v1[3]);
                    *(u32x4*)(rowp + bj * 128) = w;
                }
                asm volatile("" ::: "memory");
            }
    }
};
struct EpiResid {
    static constexpr bool PERM = false, AFTER_DRAIN = false;
    const float* xold; float* xnew; bf16_t* xb; float* sumsq_next;
    __device__ __forceinline__ void operator()(const f32x4 (&acc)[2][2][4][2], const pg8::Unit& u, int wr, int wc, int fr, int fq) const {
        const int row0 = u.pm * 256 + wr * 64 + fr, col0 = u.pn * 256 + wc * 32 + 4 * fq;
        f32x4 res[2][2][2];
#define EPR_LOAD(slot, g) do { const int row_ = row0 + ((g) >> 2) * 128 + ((g) & 3) * 16; _Pragma("unroll") for (int bj = 0; bj < 2; ++bj) _Pragma("unroll") for (int n = 0; n < 2; ++n) \
        res[slot][bj][n] = *(const f32x4*)(xold + (size_t)row_ * DM + col0 + bj * 128 + n * 16); } while (0)
        EPR_LOAD(0, 0);
#pragma unroll
        for (int g = 0; g < 8; ++g) {
            const int ai = g >> 2, m = g & 3, row = row0 + ai * 128 + m * 16;
            if (g + 1 < 8) { if (g & 1) EPR_LOAD(0, g + 1); else EPR_LOAD(1, g + 1); }
            float ss = 0.f;
#pragma unroll
            for (int bj = 0; bj < 2; ++bj)
#pragma unroll
                for (int n = 0; n < 2; ++n) {
                    const size_t off = (size_t)row * DM + col0 + bj * 128 + n * 16;
                    const f32x4 v = res[g & 1][bj][n] + acc[ai][bj][m][n];
                    *(f32x4*)(xnew + off) = v;
                    if (xb) { u32x2 o; o.x = pg8::cvt_pk_bf16(v[0], v[1]); o.y = pg8::cvt_pk_bf16(v[2], v[3]); *(u32x2*)(xb + off) = o; }
                    ss += (v[0] * v[0] + v[1] * v[1]) + (v[2] * v[2] + v[3] * v[3]);
                }
            if (sumsq_next) {
                ss += shx(ss, 16, fq * 16 + fr); ss += shx(ss, 32, fq * 16 + fr);
                if (fq == 0) atomicAdd(sumsq_next + row, ss);
            }
            asm volatile("" ::: "memory");
        }
#undef EPR_LOAD
    }
};
struct EpiGlu {
    static constexpr bool PERM = true, AFTER_DRAIN = false;
    const bf16_t* y; bf16_t* mixed;
    __device__ __forceinline__ void operator()(const f32x4 (&acc)[2][2][4][2], const pg8::Unit& u, int wr, int wc, int fr, int fq) const {
        const int row0 = u.pm * 256 + wr * 64 + fr, col0 = u.pn * 256 + wc * 32 + 8 * fq;
#pragma unroll
        for (int ai = 0; ai < 2; ++ai)
#pragma unroll
            for (int m = 0; m < 4; ++m) {
                const int row = row0 + ai * 128 + m * 16;
#pragma unroll
                for (int bj = 0; bj < 2; ++bj) {
                    const int col = col0 + bj * 128;
                    const u32x4 yv = *(const u32x4*)(y + (size_t)row * 512 + col);
                    const f32x4 a0 = acc[ai][bj][m][0], a1 = acc[ai][bj][m][1];
                    float r[8];
#pragma unroll
                    for (int e = 0; e < 4; ++e) {
                        const unsigned w = yv[e];
                        const float ylo = __uint_as_float(w << 16), yhi = __uint_as_float(w & 0xffff0000u);
                        const float alo = e < 2 ? a0[2 * e] : a1[2 * (e - 2)], ahi = e < 2 ? a0[2 * e + 1] : a1[2 * (e - 2) + 1];
                        r[2 * e] = ylo / (1.f + __expf(-alo)); r[2 * e + 1] = yhi / (1.f + __expf(-ahi));
                    }
                    u32x4 w; w.x = pg8::cvt_pk_bf16(r[0], r[1]); w.y = pg8::cvt_pk_bf16(r[2], r[3]); w.z = pg8::cvt_pk_bf16(r[4], r[5]); w.w = pg8::cvt_pk_bf16(r[6], r[7]);
                    *(u32x4*)(mixed + (size_t)row * DM + col) = w;
                }
                asm volatile("" ::: "memory");
            }
    }
};
template <class Epi>
__device__ __forceinline__ void run_gemm(unsigned char* lds, const bf16_t* A, const bf16_t* Bt, int M, int N, int K, const Epi& E) {
    pg8::Gemm g{A, Bt, M, N, K};
    pg8::StaticOrder S; S.init(M, N, (int)gridDim.x, (int)blockIdx.x);
    pg8::gemm_phase<Epi, pg8::StaticOrder, true, true>((PG8_LAS unsigned char*)lds, g, S, E);
}

namespace att {
#define ATT_LAS __attribute__((address_space(3)))
typedef float f32x16 __attribute__((ext_vector_type(16)));
typedef short s16x4 __attribute__((ext_vector_type(4)));
typedef ATT_LAS const unsigned char* ldscp;
typedef ATT_LAS unsigned char* ldsp;
constexpr int TILE = 16384, BUFB = 32768;
constexpr float NEG = -1e30f;
__device__ __forceinline__ unsigned off_b(unsigned row, unsigned ch) { return 256u * row + 16u * (ch ^ (((row & 3u) << 2) | ((row >> 2) & 3u))); }
__device__ __forceinline__ int crow(int r, int hi) { return (r & 3) + 8 * (r >> 2) + 4 * hi; }

struct Stage { int dummy; };
__device__ __forceinline__ void stage_dma(const bf16_t* K, int kpitch, const bf16_t* V, int vpitch, int key0, int kmax, ldsp buf, int tid) {
    const int lane = tid & 63, wv = __builtin_amdgcn_readfirstlane(tid >> 6);
#pragma unroll
    for (int h = 0; h < 2; ++h) {
        const int i = wv + 8 * h;
        const int r = 4 * i + (lane >> 4), s = lane & 15;
        const int ch = s ^ (((r & 3) << 2) | ((r >> 2) & 3));
        int kr = key0 + r; kr = kr < 0 ? 0 : (kr > kmax ? kmax : kr);
        __builtin_amdgcn_global_load_lds((const unsigned*)(K + (size_t)kr * kpitch + 8 * ch), (ATT_LAS unsigned*)(buf + i * 1024), 16, 0, 0);
        __builtin_amdgcn_global_load_lds((const unsigned*)(V + (size_t)kr * vpitch + 8 * ch), (ATT_LAS unsigned*)(buf + TILE + i * 1024), 16, 0, 0);
    }
}
#define ATT_DMA_WAIT() asm volatile("s_waitcnt vmcnt(0)" ::: "memory")
constexpr int NRING = 4;
__device__ __forceinline__ void ring_wait(int rem) {
    if (rem >= 2) asm volatile("s_waitcnt vmcnt(8)" ::: "memory");
    else if (rem == 1) asm volatile("s_waitcnt vmcnt(4)" ::: "memory");
    else asm volatile("s_waitcnt vmcnt(0)" ::: "memory");
}
struct WaveCtx { int lane, r32, hi, kch0; };
__device__ __forceinline__ void ctx_init(WaveCtx& w, int lane, int kch0) { w.lane = lane; w.r32 = lane & 31; w.hi = lane >> 5; w.kch0 = kch0; }
#define ATT_SB() __builtin_amdgcn_sched_barrier(0)
template <int NKS>
__device__ __forceinline__ void qk(ldscp Kt, const WaveCtx& w, const bf16x8 (&qf)[NKS], f32x16& p0, f32x16& p1) {
#pragma unroll
    for (int r = 0; r < 16; ++r) { p0[r] = 0.f; p1[r] = 0.f; }
    int ln = w.lane; asm volatile("" : "+v"(ln));
    const unsigned r32 = ln & 31, hi = ln >> 5;
    bf16x8 ka[3][2];
#define ATT_KLOAD(buf, b) do { const unsigned ko = off_b(r32, (w.kch0 + 2 * (b) + hi) & 15); \
        ka[buf][0] = *(const ATT_LAS bf16x8*)(Kt + ko); ka[buf][1] = *(const ATT_LAS bf16x8*)(Kt + ko + 8192); } while (0)
#define ATT_KMMA(buf, b) do { \
        p0 = __builtin_amdgcn_mfma_f32_32x32x16_bf16(ka[buf][0], qf[b], p0, 0, 0, 0); \
        p1 = __builtin_amdgcn_mfma_f32_32x32x16_bf16(ka[buf][1], qf[b], p1, 0, 0, 0); } while (0)
    ATT_KLOAD(0, 0); ATT_KLOAD(1, 1); ATT_SB();
#pragma unroll
    for (int b = 0; b < NKS; ++b) {
        if (b + 2 < NKS) { if (b % 3 == 0) ATT_KLOAD(2, b + 2); else if (b % 3 == 1) ATT_KLOAD(0, b + 2); else ATT_KLOAD(1, b + 2); }
        if (b % 3 == 0) ATT_KMMA(0, b); else if (b % 3 == 1) ATT_KMMA(1, b); else ATT_KMMA(2, b);
        if (b + 2 < NKS) __builtin_amdgcn_sched_group_barrier(0x100, 2, 0);
        __builtin_amdgcn_sched_group_barrier(0x008, 2, 0);
        ATT_SB();
    }
#undef ATT_KLOAD
#undef ATT_KMMA
}
__device__ __forceinline__ s16x4 trd(unsigned addr, int off) { s16x4 r; asm volatile("ds_read_b64_tr_b16 %0, %1 offset:%c2" : "=v"(r) : "v"(addr), "i"(off)); return r; }
__device__ __forceinline__ void pv(ldscp Vt, const WaveCtx& w, const bf16x8 (&pf)[2][2], f32x16 (&o)[4]) {
    int ln = w.lane; asm volatile("" : "+v"(ln));
    const unsigned hh = ln >> 5, blk = (ln >> 4) & 1, q = (ln & 15) >> 2, pp = ln & 3;
    const unsigned vbase = (unsigned)(uintptr_t)Vt;
    s16x4 vl[2][4], vh[2][4];
#define ATT_VLOAD(buf, c) do { const unsigned vo0 = vbase + off_b(4 * hh + q, 4 * (c) + 2 * blk + (pp >> 1)) + 8 * (pp & 1), vo1 = vbase + off_b(8 + 4 * hh + q, 4 * (c) + 2 * blk + (pp >> 1)) + 8 * (pp & 1); \
        vl[buf][0] = trd(vo0, 0); vh[buf][0] = trd(vo1, 0); vl[buf][1] = trd(vo0, 4096); vh[buf][1] = trd(vo1, 4096); \
        vl[buf][2] = trd(vo0, 8192); vh[buf][2] = trd(vo1, 8192); vl[buf][3] = trd(vo0, 12288); vh[buf][3] = trd(vo1, 12288); } while (0)
#define ATT_VMMA(buf, c) do { _Pragma("unroll") for (int kb = 0; kb < 2; ++kb) _Pragma("unroll") for (int s = 0; s < 2; ++s) { \
            const s16x4 lo = vl[buf][2 * kb + s], hi4 = vh[buf][2 * kb + s]; \
            const bf16x8 vf = (bf16x8){lo[0], lo[1], lo[2], lo[3], hi4[0], hi4[1], hi4[2], hi4[3]}; \
            o[c] = __builtin_amdgcn_mfma_f32_32x32x16_bf16(vf, pf[kb][s], o[c], 0, 0, 0); } } while (0)
#define ATT_LWAIT(n) do { asm volatile("s_waitcnt lgkmcnt(" #n ")" ::: "memory"); ATT_SB(); } while (0)
    asm volatile("s_waitcnt lgkmcnt(0)" ::: "memory"); ATT_SB();
    ATT_VLOAD(0, 0); ATT_SB();
    ATT_VLOAD(1, 1); ATT_LWAIT(8); ATT_VMMA(0, 0); ATT_SB();
    ATT_VLOAD(0, 2); ATT_LWAIT(8); ATT_VMMA(1, 1); ATT_SB();
    ATT_VLOAD(1, 3); ATT_LWAIT(8); ATT_VMMA(0, 2); ATT_SB();
    ATT_LWAIT(0); ATT_VMMA(1, 3); ATT_SB();
#undef ATT_VLOAD
#undef ATT_VMMA
#undef ATT_LWAIT
}
__device__ __forceinline__ void pack_p(const f32x16& p0, const f32x16& p1, bf16x8 (&pf)[2][2]) {
#pragma unroll
    for (int s = 0; s < 2; ++s) {
        u32x4 a, b;
#pragma unroll
        for (int i = 0; i < 4; ++i) { a[i] = pg8::cvt_pk_bf16(p0[8 * s + 2 * i], p0[8 * s + 2 * i + 1]); b[i] = pg8::cvt_pk_bf16(p1[8 * s + 2 * i], p1[8 * s + 2 * i + 1]); }
        pf[0][s] = __builtin_bit_cast(bf16x8, a); pf[1][s] = __builtin_bit_cast(bf16x8, b);
    }
}
__device__ __forceinline__ void apply_bounds(f32x16& p0, f32x16& p1, int klo, int khi, int hi) {
#pragma unroll
    for (int r = 0; r < 16; ++r) {
        const int k = crow(r, hi);
        if (k < klo || k > khi) p0[r] = NEG;
        if (k + 32 < klo || k + 32 > khi) p1[r] = NEG;
    }
}
__device__ __forceinline__ float ex2(float x) { return __builtin_amdgcn_exp2f(x); }
constexpr float SM_THR = 6.0f;
template <int NKS>
__device__ __forceinline__ void tile_softmax(ldscp Kt, ldscp Vt, const WaveCtx& w, const bf16x8 (&qf)[NKS], f32x16 (&o)[4], float& m, float& l, float c, bool need_mask, int klo, int khi, bool live = true) {
    f32x16 p0, p1;
    qk<NKS>(Kt, w, qf, p0, p1);
    if (need_mask) apply_bounds(p0, p1, klo, khi, w.hi);
    float mx = fmaxf(p0[0], p1[0]);
#pragma unroll
    for (int r = 1; r < 16; ++r) mx = fmaxf(mx, fmaxf(p0[r], p1[r]));
    mx = live ? mx : NEG;
    mx = half_max(mx);
    const float grow = mx * c - m;
    if (__any(grow > SM_THR)) {
        const float mnew = fmaxf(m, mx * c);
        const float alpha = ex2(m - mnew);
        m = mnew;
        l *= alpha;
#pragma unroll
        for (int cc = 0; cc < 4; ++cc)
#pragma unroll
            for (int r = 0; r < 16; ++r) o[cc][r] *= alpha;
    }
    const float cl = live ? c : 0.f, bl = live ? -m : NEG;
    float ls = 0.f;
#pragma unroll
    for (int r = 0; r < 16; ++r) { p0[r] = ex2(fmaf(p0[r], cl, bl)); p1[r] = ex2(fmaf(p1[r], cl, bl)); ls += p0[r] + p1[r]; }
    l += ls;
    bf16x8 pf[2][2];
    pack_p(p0, p1, pf);
    pv(Vt, w, pf, o);
}
}

__device__ void phase_prep(const Params& p) {
    const int tid = opaque_tid(), lane = tid & 63, wave = tid >> 6;
    const int gw = blockIdx.x * NWAVES + wave, NGW = gridDim.x * NWAVES;
    bf16_t* proj = (bf16_t*)(p.ws + WS_PROJ);
    const float2* r128 = (const float2*)(p.ws + WS_ROPE128);
    const float2* r64 = (const float2*)(p.ws + WS_ROPE64);
    for (int m = gw; m < MTOK; m += NGW) {
        bf16_t* row = proj + (size_t)m * NP;
        const float2 cs = r128[(size_t)m * 64 + lane];
#pragma unroll 1
        for (int hh = 0; hh < 15; ++hh) {
            if (hh == 12) continue;
            int col; bool rms; float mul = 1.f;
            if (hh < 4) { col = C_RQ + hh * 128; rms = false; }
            else if (hh < 8) { col = C_RK + (hh - 4) * 128; rms = false; mul = 0.08838834764831845f; }
            else if (hh < 12) { col = C_NQ + (hh - 8) * 128; rms = true; }
            else if (hh == 12) { col = C_NKC; rms = false; }
            else if (hh == 13) { col = C_NKS; rms = true; }
            else { col = C_NKW; rms = true; }
            float x1 = bf2f(row[col + lane]), x2 = bf2f(row[col + 64 + lane]);
            if (rms) { const float ss = wave_sum(x1 * x1 + x2 * x2, lane); mul = rsqrtf(ss * (1.f / 128.f) + EPS); }
            x1 *= mul; x2 *= mul;
            row[col + lane] = (bf16_t)f2bf(x1 * cs.x - x2 * cs.y);
            row[col + 64 + lane] = (bf16_t)f2bf(x2 * cs.x + x1 * cs.y);
        }
        const float2 cs2 = r64[(size_t)m * 32 + (lane & 31)];
#pragma unroll 1
        for (int hp = 0; hp < 8; ++hp) {
            const int col = (hp < 4 ? C_DQ + hp * 128 : C_DK + (hp - 4) * 128) + (lane >> 5) * 64 + (lane & 31);
            float x1 = bf2f(row[col]), x2 = bf2f(row[col + 32]);
            float ss = x1 * x1 + x2 * x2;
#pragma unroll
            for (int o = 1; o < 32; o <<= 1) ss += shx(ss, o, lane);
            const float mul = rsqrtf(ss * (1.f / 64.f) + EPS);
            x1 *= mul; x2 *= mul;
            row[col] = (bf16_t)f2bf(x1 * cs2.x - x2 * cs2.y);
            row[col + 32] = (bf16_t)f2bf(x2 * cs2.x + x1 * cs2.y);
        }
    }
}

__device__ __forceinline__ void diff_unit(const Params& p, unsigned char* lds, int unit, float lam, float lam_init) {
    const int tid = opaque_tid(), lane = tid & 63, wave = __builtin_amdgcn_readfirstlane(tid >> 6);
    const int qb = 15 - (unit & 15), bh = unit >> 4, h = bh & 3, b = bh >> 2;
    const int comp = wave >> 2, qsub = wave & 3, q0 = qb * 128 + qsub * 32;
    att::WaveCtx w; att::ctx_init(w, lane, 8 * comp);
    const int tq = q0 + w.r32;
    const bf16_t* base = (const bf16_t*)(p.ws + WS_PROJ) + (size_t)b * SEQ * NP;
    bf16x8 qf[4];
#pragma unroll
    for (int ks = 0; ks < 4; ++ks) qf[ks] = *(const bf16x8*)(base + (size_t)tq * NP + C_DQ + h * 128 + comp * 64 + 16 * ks + 8 * w.hi);
    att::f32x16 o[4];
#pragma unroll
    for (int c = 0; c < 4; ++c)
#pragma unroll
        for (int r = 0; r < 16; ++r) o[c][r] = 0.f;
    float m = att::NEG, l = 0.f;
    const float csc = 0.125f * 1.4426950408889634f;
    const bf16_t* Kg = base + C_DK + h * 128; const bf16_t* Vg = base + C_DV + h * 128;
    const int nt = 2 * qb + 2;
    att::ldsp L3 = (att::ldsp)lds;
    ATT_DMA_WAIT();
#pragma unroll
    for (int ks = 0; ks < 4; ++ks) asm volatile("" : "+v"(qf[ks]));
    int issued = 0;
    for (; issued < nt && issued < att::NRING - 1; ++issued) att::stage_dma(Kg, NP, Vg, NP, issued * 64, SEQ - 1, L3 + issued * att::BUFB, tid);
    for (int kt = 0; kt < nt; ++kt) {
        att::ring_wait(issued - 1 - kt);
        __syncthreads();
        if (issued < nt) { att::stage_dma(Kg, NP, Vg, NP, issued * 64, SEQ - 1, L3 + (issued & (att::NRING - 1)) * att::BUFB, tid); ++issued; }
        const int cur = kt & (att::NRING - 1);
        const int key0 = kt * 64;
        if (key0 <= q0 + 31)
            att::tile_softmax<4>((att::ldscp)(L3 + cur * att::BUFB), (att::ldscp)(L3 + cur * att::BUFB + att::TILE), w, qf, o, m, l, csc, key0 + 63 > q0, 0, tq - key0);
    }
    __syncthreads();
    const float linv = 1.f / half_sum(l);
    float* cb = (float*)lds;
    if (comp == 1) {
#pragma unroll
        for (int c = 0; c < 4; ++c)
#pragma unroll
            for (int r = 0; r < 16; ++r) cb[(qsub * 128 + 32 * c + att::crow(r, w.hi)) * 32 + w.r32] = o[c][r] * linv * lam;
    }
    __syncthreads();
    if (comp == 0) {
        float ss = 0.f;
#pragma unroll
        for (int c = 0; c < 4; ++c)
#pragma unroll
            for (int r = 0; r < 16; ++r) { const float v = o[c][r] * linv - cb[(qsub * 128 + 32 * c + att::crow(r, w.hi)) * 32 + w.r32]; o[c][r] = v; ss += v * v; }
        ss = half_sum(ss);
        const float sc = rsqrtf(ss * (1.f / 128.f) + EPS) * (1.f - lam_init);
        bf16_t* orow = (bf16_t*)(p.ws + WS_MIXED) + ((size_t)b * SEQ + tq) * DM + 1536 + h * 128;
#pragma unroll
        for (int c = 0; c < 4; ++c)
#pragma unroll
            for (int g = 0; g < 4; ++g) {
                u32x2 v; v.x = pg8::cvt_pk_bf16(o[c][4 * g] * sc, o[c][4 * g + 1] * sc); v.y = pg8::cvt_pk_bf16(o[c][4 * g + 2] * sc, o[c][4 * g + 3] * sc);
                *(u32x2*)(orow + 32 * c + 8 * g + 4 * w.hi) = v;
            }
    }
    __syncthreads();
}
__device__ void phase_diff_mfma(const Params& p, unsigned char* lds, int L) {
    const int lane = opaque_tid() & 63;
    const float lam_init = 0.8f - 0.6f * expf(-0.3f * (float)L);
    const float a = p.in[17][L * 64 + lane] * p.in[18][L * 64 + lane];
    const float c = p.in[19][L * 64 + lane] * p.in[20][L * 64 + lane];
    const float lam = expf(wave_sum(a, lane)) - expf(wave_sum(c, lane)) + lam_init;
    for (int unit = blockIdx.x; unit < NB * 4 * 16; unit += gridDim.x) diff_unit(p, lds, unit, lam, lam_init);
}

template <int NKS>
__device__ __forceinline__ void tile_decay(att::ldscp Kt, att::ldscp Vt, const att::WaveCtx& w, const bf16x8 (&qf)[NKS], att::f32x16 (&o)[4], float log2g, int dq, bool need_mask) {
    att::f32x16 p0, p1;
    att::qk<NKS>(Kt, w, qf, p0, p1);
#pragma unroll
    for (int r = 0; r < 16; ++r) {
        const int d0 = dq - att::crow(r, w.hi), d1 = d0 - 32;
        const float f0 = att::ex2(log2g * (float)d0), f1 = att::ex2(log2g * (float)d1);
        p0[r] = (need_mask && d0 < 0) ? 0.f : p0[r] * f0;
        p1[r] = (need_mask && d1 < 0) ? 0.f : p1[r] * f1;
    }
    bf16x8 pf[2][2];
    att::pack_p(p0, p1, pf);
    att::pv(Vt, w, pf, o);
}
__device__ __forceinline__ void ret_unit(const Params& p, unsigned char* lds, int unit) {
    const int tid = opaque_tid(), lane = tid & 63, wave = __builtin_amdgcn_readfirstlane(tid >> 6);
    const int qb = 7 - (unit & 7), bh = unit >> 3, h = bh & 3, b = bh >> 2;
    const int q0 = qb * 256 + wave * 32;
    att::WaveCtx w; att::ctx_init(w, lane, 0);
    const int tq = q0 + w.r32;
    const bf16_t* base = (const bf16_t*)(p.ws + WS_PROJ) + (size_t)b * SEQ * NP;
    bf16x8 qf[8];
#pragma unroll
    for (int ks = 0; ks < 8; ++ks) qf[ks] = *(const bf16x8*)(base + (size_t)tq * NP + C_RQ + h * 128 + 16 * ks + 8 * w.hi);
    att::f32x16 o[4];
#pragma unroll
    for (int c = 0; c < 4; ++c)
#pragma unroll
        for (int r = 0; r < 16; ++r) o[c][r] = 0.f;
    const float log2g = log2f(1.0f - exp2f(-5.0f - (float)h));
    const bf16_t* Kg = base + C_RK + h * 128; const bf16_t* Vg = base + C_RV + h * 128;
    const int nt = 4 * qb + 4;
    att::ldsp L3 = (att::ldsp)lds;
    ATT_DMA_WAIT();
#pragma unroll
    for (int ks = 0; ks < 8; ++ks) asm volatile("" : "+v"(qf[ks]));
    int issued = 0;
    for (; issued < nt && issued < att::NRING - 1; ++issued) att::stage_dma(Kg, NP, Vg, NP, issued * 64, SEQ - 1, L3 + issued * att::BUFB, tid);
    for (int kt = 0; kt < nt; ++kt) {
        att::ring_wait(issued - 1 - kt);
        __syncthreads();
        if (issued < nt) { att::stage_dma(Kg, NP, Vg, NP, issued * 64, SEQ - 1, L3 + (issued & (att::NRING - 1)) * att::BUFB, tid); ++issued; }
        const int cur = kt & (att::NRING - 1);
        const int key0 = kt * 64;
        if (key0 <= q0 + 31)
            tile_decay<8>((att::ldscp)(L3 + cur * att::BUFB), (att::ldscp)(L3 + cur * att::BUFB + att::TILE), w, qf, o, log2g, tq - key0, key0 + 63 > q0);
    }
    __syncthreads();
    float s1 = 0.f;
#pragma unroll
    for (int c = 0; c < 4; ++c)
#pragma unroll
        for (int r = 0; r < 16; ++r) s1 += o[c][r];
    s1 = half_sum(s1);
    const float mu = s1 * (1.f / 128.f);
    float s2 = 0.f;
#pragma unroll
    for (int c = 0; c < 4; ++c)
#pragma unroll
        for (int r = 0; r < 16; ++r) { const float d = o[c][r] - mu; o[c][r] = d; s2 += d * d; }
    s2 = half_sum(s2);
    const float rs = rsqrtf(s2 * (1.f / 128.f) + EPS);
    const size_t mrow = (size_t)b * SEQ + tq;
    const bf16_t* grow = (const bf16_t*)(p.ws + WS_PROJ) + mrow * NP + C_RG + h * 128;
    bf16_t* orow = (bf16_t*)(p.ws + WS_MIXED) + mrow * DM + 512 + h * 128;
#pragma unroll
    for (int c = 0; c < 4; ++c)
#pragma unroll
        for (int g = 0; g < 4; ++g) {
            const int e0 = 32 * c + 8 * g + 4 * w.hi;
            const u32x2 gv = *(const u32x2*)(grow + e0);
            const float g0 = __uint_as_float(gv.x << 16), g1 = __uint_as_float(gv.x & 0xffff0000u), g2 = __uint_as_float(gv.y << 16), g3 = __uint_as_float(gv.y & 0xffff0000u);
            u32x2 v;
            v.x = pg8::cvt_pk_bf16(g0 / (1.f + __expf(-g0)) * o[c][4 * g] * rs, g1 / (1.f + __expf(-g1)) * o[c][4 * g + 1] * rs);
            v.y = pg8::cvt_pk_bf16(g2 / (1.f + __expf(-g2)) * o[c][4 * g + 2] * rs, g3 / (1.f + __expf(-g3)) * o[c][4 * g + 3] * rs);
            *(u32x2*)(orow + e0) = v;
        }
    __syncthreads();
}
__device__ void phase_ret_mfma(const Params& p, unsigned char* lds) {
    for (int unit = (blockIdx.x + gridDim.x / 2) % gridDim.x; unit < NB * 4 * 8; unit += gridDim.x) ret_unit(p, lds, unit);
}

__device__ __forceinline__ void nsa_unit(const Params& p, unsigned char* lds, int unit) {
    const int tid = opaque_tid(), lane = tid & 63, wave = __builtin_amdgcn_readfirstlane(tid >> 6);
    const int tb = 31 - (unit & 31), b = unit >> 5;
    const int head = wave >> 1, thalf = wave & 1, t0w = tb * 64 + thalf * 32;
    att::WaveCtx w; att::ctx_init(w, lane, 0);
    const int tq = t0w + w.r32, tloc = thalf * 32 + w.r32;
    const bf16_t* base = (const bf16_t*)(p.ws + WS_PROJ) + (size_t)b * SEQ * NP;
    bf16x8 qf[8];
#pragma unroll
    for (int ks = 0; ks < 8; ++ks) qf[ks] = *(const bf16x8*)(base + (size_t)tq * NP + C_NQ + head * 128 + 16 * ks + 8 * w.hi);
#define NSA_GATE(br) (1.f / (1.f + __expf(-bf2f(base[(size_t)tq * NP + C_GATE + head * 3 + (br)]))))
    const float csc = 0.08838834764831845f * 1.4426950408889634f;
    float* impQ = (float*)(lds + 65536);
    float* impE = (float*)(lds + 65536 + 32768);
    float* scb = (float*)lds;
    unsigned* selm = (unsigned*)(lds + 8192);
    att::ldsp L3 = (att::ldsp)lds;
    att::f32x16 o[4];
#pragma unroll
    for (int c = 0; c < 4; ++c)
#pragma unroll
        for (int r = 0; r < 16; ++r) o[c][r] = 0.f;
    {
        const bf16_t* Kc = (const bf16_t*)(p.ws + WS_KVCMPB) + (size_t)b * 128 * 128; const bf16_t* Vc = Kc + 4 * 128 * 128;
        att::stage_dma(Kc, 128, Vc, 128, 0, 127, L3, tid);
        att::stage_dma(Kc, 128, Vc, 128, 64, 127, L3 + att::BUFB, tid);
        ATT_DMA_WAIT();
        __syncthreads();
        const int jmax = tq >= 31 ? ((tq - 31) >> 4) : -1;
        float m = att::NEG, l = 0.f;
#pragma unroll 1
        for (int kt = 0; kt < 2; ++kt) {
            att::f32x16 p0, p1;
            att::qk<8>((att::ldscp)(L3 + kt * att::BUFB), w, qf, p0, p1);
            att::apply_bounds(p0, p1, 0, jmax - 64 * kt, w.hi);
            float mx = fmaxf(p0[0], p1[0]);
#pragma unroll
            for (int r = 1; r < 16; ++r) mx = fmaxf(mx, fmaxf(p0[r], p1[r]));
            mx = half_max(mx);
            const float mnew = fmaxf(m, mx * csc);
            float ls = 0.f;
#pragma unroll
            for (int r = 0; r < 16; ++r) ls += att::ex2(fmaf(p0[r], csc, -mnew)) + att::ex2(fmaf(p1[r], csc, -mnew));
            l = l * att::ex2(m - mnew) + ls; m = mnew;
        }
        l = half_sum(l);
        const float inv = (jmax >= 0) ? 1.f / l : 0.f;
#pragma unroll 1
        for (int kt = 0; kt < 2; ++kt) {
            att::f32x16 p0, p1;
            att::qk<8>((att::ldscp)(L3 + kt * att::BUFB), w, qf, p0, p1);
            att::apply_bounds(p0, p1, 0, jmax - 64 * kt, w.hi);
#pragma unroll
            for (int r = 0; r < 16; ++r) { p0[r] = att::ex2(fmaf(p0[r], csc, -m)) * inv; p1[r] = att::ex2(fmaf(p1[r], csc, -m)) * inv; }
#pragma unroll
            for (int g = 0; g < 4; ++g) {
                const int ia = ((head * 32 + 16 * kt + 2 * g + w.hi) * 64) + tloc, ib = ia + 8 * 64;
                impQ[ia] = (p0[4 * g] + p0[4 * g + 1]) + (p0[4 * g + 2] + p0[4 * g + 3]); impE[ia] = p0[4 * g + 3];
                impQ[ib] = (p1[4 * g] + p1[4 * g + 1]) + (p1[4 * g + 2] + p1[4 * g + 3]); impE[ib] = p1[4 * g + 3];
            }
            bf16x8 pf[2][2];
            att::pack_p(p0, p1, pf);
            att::pv((att::ldscp)(L3 + kt * att::BUFB + att::TILE), w, pf, o);
        }
    }
    __syncthreads();
    unsigned mymask, tmask;
    {
        const int token = tid >> 3, js0 = (tid & 7) * 4;
        if (tid < 65) selm[tid] = 0u;
#pragma unroll
        for (int i = 0; i < 4; ++i) {
            const int js = js0 + i;
            float s = 0.f;
#pragma unroll
            for (int h = 0; h < 4; ++h) { s += impQ[(h * 32 + js) * 64 + token]; if (js > 0) s += impE[(h * 32 + js - 1) * 64 + token]; }
            const bool valid = js <= tb, forced = (js == 0) || (js == tb) || (js == tb - 1);
            scb[token * 32 + js] = valid ? s + (forced ? 1e4f : 0.f) : -1e30f;
        }
        __syncthreads();
        unsigned mine = 0u;
#pragma unroll
        for (int i = 0; i < 4; ++i) {
            const int js = js0 + i;
            const float my = scb[token * 32 + js];
            int rank = 0;
            for (int jj = 0; jj < 32; ++jj) { const float sj = scb[token * 32 + jj]; rank += (sj > my || (sj == my && jj < js)) ? 1 : 0; }
            if (js <= tb && rank < 8) mine |= 1u << js;
        }
        if (mine) { atomicOr(&selm[token], mine); atomicOr(&selm[64], mine); }
        __syncthreads();
        mymask = selm[tloc]; tmask = selm[64];
        __syncthreads();
    }
    bf16_t* orow = (bf16_t*)(p.ws + WS_MIXED) + ((size_t)b * SEQ + tq) * DM + 1024 + head * 128 + 4 * w.hi;
    {
        const float g0 = NSA_GATE(0);
#pragma unroll
        for (int c = 0; c < 4; ++c)
#pragma unroll
            for (int g = 0; g < 4; ++g) {
                u32x2 v; v.x = pg8::cvt_pk_bf16(g0 * o[c][4 * g], g0 * o[c][4 * g + 1]); v.y = pg8::cvt_pk_bf16(g0 * o[c][4 * g + 2], g0 * o[c][4 * g + 3]);
                *(u32x2*)(orow + 32 * c + 8 * g) = v;
                o[c][4 * g] = 0.f; o[c][4 * g + 1] = 0.f; o[c][4 * g + 2] = 0.f; o[c][4 * g + 3] = 0.f;
            }
    }
#define NSA_ACCUM(f) do { _Pragma("unroll") for (int c = 0; c < 4; ++c) _Pragma("unroll") for (int g = 0; g < 4; ++g) { \
        const u32x2 u = *(const u32x2*)(orow + 32 * c + 8 * g); u32x2 v; \
        v.x = pg8::cvt_pk_bf16(__uint_as_float(u.x << 16) + (f) * o[c][4 * g], __uint_as_float(u.x & 0xffff0000u) + (f) * o[c][4 * g + 1]); \
        v.y = pg8::cvt_pk_bf16(__uint_as_float(u.y << 16) + (f) * o[c][4 * g + 2], __uint_as_float(u.y & 0xffff0000u) + (f) * o[c][4 * g + 3]); \
        *(u32x2*)(orow + 32 * c + 8 * g) = v; \
        o[c][4 * g] = 0.f; o[c][4 * g + 1] = 0.f; o[c][4 * g + 2] = 0.f; o[c][4 * g + 3] = 0.f; } } while (0)
    {
        const bf16_t* Kg = base + C_NKS; const bf16_t* Vg = base + C_NVS;
        float m = att::NEG, l = 0.f;
        const unsigned tm = (unsigned)__builtin_amdgcn_readfirstlane((int)tmask);
        const int nt = __builtin_popcount(tm);
        unsigned mi = tm, mc = tm;
        ATT_DMA_WAIT();
#pragma unroll
        for (int ks = 0; ks < 8; ++ks) asm volatile("" : "+v"(qf[ks]));
        int issued = 0;
        for (; issued < nt && issued < att::NRING - 1; ++issued) { const int j = __builtin_ctz(mi); mi &= mi - 1; att::stage_dma(Kg, NP, Vg, NP, j * 64, SEQ - 1, L3 + issued * att::BUFB, tid); }
        for (int i = 0; i < nt; ++i) {
            att::ring_wait(issued - 1 - i);
            __syncthreads();
            if (issued < nt) { const int j = __builtin_ctz(mi); mi &= mi - 1; att::stage_dma(Kg, NP, Vg, NP, j * 64, SEQ - 1, L3 + (issued & (att::NRING - 1)) * att::BUFB, tid); ++issued; }
            const int cur = i & (att::NRING - 1);
            const int curj = __builtin_ctz(mc); mc &= mc - 1;
            const bool allowed = (mymask >> curj) & 1u;
            if (__any(allowed))
                att::tile_softmax<8>((att::ldscp)(L3 + cur * att::BUFB), (att::ldscp)(L3 + cur * att::BUFB + att::TILE), w, qf, o, m, l, csc, curj == tb, 0, tq - curj * 64, allowed);
        }
        __syncthreads();
        l = half_sum(l);
        const float f = NSA_GATE(1) / l;
        NSA_ACCUM(f);
    }
    {
        const bf16_t* Kg = base + C_NKW; const bf16_t* Vg = base + C_NVW;
        float m = att::NEG, l = 0.f;
        const int kt0 = tb >= 4 ? tb - 4 : 0, nt = tb - kt0 + 1;
        ATT_DMA_WAIT();
        int issued = 0;
        for (; issued < nt && issued < att::NRING - 1; ++issued) att::stage_dma(Kg, NP, Vg, NP, (kt0 + issued) * 64, SEQ - 1, L3 + issued * att::BUFB, tid);
        for (int i = 0; i < nt; ++i) {
            att::ring_wait(issued - 1 - i);
            __syncthreads();
            if (issued < nt) { att::stage_dma(Kg, NP, Vg, NP, (kt0 + issued) * 64, SEQ - 1, L3 + (issued & (att::NRING - 1)) * att::BUFB, tid); ++issued; }
            const int kt = kt0 + i, cur = i & (att::NRING - 1);
            const int key0 = kt * 64;
            att::tile_softmax<8>((att::ldscp)(L3 + cur * att::BUFB), (att::ldscp)(L3 + cur * att::BUFB + att::TILE), w, qf, o, m, l, csc, (kt == tb) || (kt == tb - 4), tq - 255 - key0, tq - key0);
        }
        l = half_sum(l);
        const float f = NSA_GATE(2) / l;
        NSA_ACCUM(f);
    }
    __syncthreads();
#undef NSA_ACCUM
#undef NSA_GATE
}
__device__ void phase_nsa_mfma(const Params& p, unsigned char* lds) {
    for (int unit = blockIdx.x; unit < NB * 32; unit += gridDim.x) nsa_unit(p, lds, unit);
}

__device__ void phase_cmp_mfma(const Params& p, unsigned char* lds, int L) {
    const int tid = opaque_tid(), lane = tid & 63, wave = __builtin_amdgcn_readfirstlane(tid >> 6);
    const int r32 = lane & 31, hi = lane >> 5;
    const bf16_t* proj = (const bf16_t*)(p.ws + WS_PROJ);
    const float2* r128 = (const float2*)(p.ws + WS_ROPE128);
    float* part = (float*)lds;
    float* slabs = (float*)(p.ws + WS_KPART);
    unsigned* cnt = (unsigned*)(p.ws + WS_CMPCNT) + L * 32;
    volatile int* slot = (volatile int*)(lds + 131072 + 56);
    for (int item = (blockIdx.x + gridDim.x / 2) % gridDim.x; item < NB * 2 * 4 * 4; item += gridDim.x) {
        const int lq = item & 3, jb = (item >> 2) & 3, kv = (item >> 4) & 1, b = item >> 5;
        const bf16_t* Wt = (const bf16_t*)(p.ws + WS_WCMP) + ((size_t)(L * 2 + kv)) * 128 * 4096;
        const float* pe = p.in[kv ? 14 : 13] + (size_t)L * 32 * 128;
        const int col = kv ? C_NVC : C_NKC;
        int j = jb * 32 + r32; if (j > 126) j = 126;
        att::f32x16 acc[4];
#pragma unroll
        for (int nb = 0; nb < 4; ++nb)
#pragma unroll
            for (int r = 0; r < 16; ++r) acc[nb][r] = 0.f;
        {
            const int l = lq * 8 + wave;
            const size_t m = (size_t)b * SEQ + 16 * j + l;
            const bf16_t* xrow = proj + m * NP + col;
#pragma unroll 4
            for (int ks = 0; ks < 8; ++ks) {
                const int d0 = 16 * ks + 8 * hi;
                const bf16x8 xv = *(const bf16x8*)(xrow + d0);
                float xf[8];
#pragma unroll
                for (int e = 0; e < 8; ++e) xf[e] = bf2f((bf16_t)xv[e]);
                if (!kv) {
                    const bf16x8 xp = *(const bf16x8*)(xrow + (d0 ^ 64));
                    const f32x4* cs4 = (const f32x4*)(r128 + m * 64 + (d0 & 63));
#pragma unroll
                    for (int e2 = 0; e2 < 4; ++e2) {
                        const f32x4 t = cs4[e2];
                        const float o0 = bf2f((bf16_t)xp[2 * e2]), o1 = bf2f((bf16_t)xp[2 * e2 + 1]);
                        xf[2 * e2] = (d0 < 64) ? xf[2 * e2] * t.x - o0 * t.y : xf[2 * e2] * t.x + o0 * t.y;
                        xf[2 * e2 + 1] = (d0 < 64) ? xf[2 * e2 + 1] * t.z - o1 * t.w : xf[2 * e2 + 1] * t.z + o1 * t.w;
                    }
                }
                const f32x4 pe0 = *(const f32x4*)(pe + l * 128 + d0), pe1 = *(const f32x4*)(pe + l * 128 + d0 + 4);
                u32x4 xa;
                xa.x = pg8::cvt_pk_bf16(xf[0] + pe0.x, xf[1] + pe0.y); xa.y = pg8::cvt_pk_bf16(xf[2] + pe0.z, xf[3] + pe0.w);
                xa.z = pg8::cvt_pk_bf16(xf[4] + pe1.x, xf[5] + pe1.y); xa.w = pg8::cvt_pk_bf16(xf[6] + pe1.z, xf[7] + pe1.w);
                const bf16x8 xfr = __builtin_bit_cast(bf16x8, xa);
#pragma unroll
                for (int nb = 0; nb < 4; ++nb) {
                    const bf16x8 wf = *(const bf16x8*)(Wt + (size_t)(nb * 32 + r32) * 4096 + l * 128 + d0);
                    acc[nb] = __builtin_amdgcn_mfma_f32_32x32x16_bf16(wf, xfr, acc[nb], 0, 0, 0);
                }
            }
        }
        __syncthreads();
#pragma unroll
        for (int nb = 0; nb < 4; ++nb)
#pragma unroll
            for (int r = 0; r < 16; ++r) part[(wave * 128 + nb * 32 + att::crow(r, hi)) * 32 + r32] = acc[nb][r];
        __syncthreads();
        const int jj = tid & 31, ng = tid >> 5;
        const int jrow = jb * 32 + jj;
        float v[8];
#pragma unroll
        for (int i = 0; i < 8; ++i) {
            float s = 0.f;
#pragma unroll
            for (int w8 = 0; w8 < 8; ++w8) s += part[(w8 * 128 + ng * 8 + i) * 32 + jj];
            v[i] = s;
        }
        {
            float* my = slabs + ((size_t)((lq * 2 + kv) * 4 + b) * 128 + jrow) * 128 + ng * 8;
            *(f32x4*)my = (f32x4){v[0], v[1], v[2], v[3]}; *(f32x4*)(my + 4) = (f32x4){v[4], v[5], v[6], v[7]};
        }
        asm volatile("s_waitcnt vmcnt(0)" ::: "memory");
        __syncthreads();
        if (tid == 0) {
            __builtin_amdgcn_fence(__ATOMIC_RELEASE, "agent");
            asm volatile("s_waitcnt vmcnt(0)" ::: "memory");
            *slot = (int)__hip_atomic_fetch_add(cnt + (item >> 2), 1u, __ATOMIC_RELAXED, __HIP_MEMORY_SCOPE_AGENT);
        }
        __syncthreads();
        const int ticket = *slot;
        if (ticket == 3) {
            if (tid == 0) { __builtin_amdgcn_fence(__ATOMIC_ACQUIRE, "agent"); asm volatile("s_waitcnt vmcnt(0)" ::: "memory"); }
            __syncthreads();
            float ss = 0.f;
#pragma unroll
            for (int i = 0; i < 8; ++i) v[i] = 0.f;
#pragma unroll
            for (int q4 = 0; q4 < 4; ++q4) {
                const float* sp = slabs + ((size_t)((q4 * 2 + kv) * 4 + b) * 128 + jrow) * 128 + ng * 8;
                const f32x4 a0 = *(const f32x4*)sp, a1 = *(const f32x4*)(sp + 4);
                v[0] += a0.x; v[1] += a0.y; v[2] += a0.z; v[3] += a0.w; v[4] += a1.x; v[5] += a1.y; v[6] += a1.z; v[7] += a1.w;
            }
#pragma unroll
            for (int i = 0; i < 8; ++i) ss += v[i] * v[i];
            float sc = 1.f;
            if (!kv) {
                part[ng * 32 + jj] = ss;
                __syncthreads();
                float tot = 0.f;
#pragma unroll
                for (int g2 = 0; g2 < 16; ++g2) tot += part[g2 * 32 + jj];
                sc = rsqrtf(tot * (1.f / 128.f) + EPS);
            }
            if (jrow > 126) sc = 0.f;
            u32x4 ov;
            ov.x = pg8::cvt_pk_bf16(v[0] * sc, v[1] * sc); ov.y = pg8::cvt_pk_bf16(v[2] * sc, v[3] * sc); ov.z = pg8::cvt_pk_bf16(v[4] * sc, v[5] * sc); ov.w = pg8::cvt_pk_bf16(v[6] * sc, v[7] * sc);
            *(u32x4*)((bf16_t*)(p.ws + WS_KVCMPB) + (size_t)kv * 4 * 128 * 128 + ((size_t)b * 128 + jrow) * 128 + ng * 8) = ov;
        }
        __syncthreads();
    }
    __syncthreads();
}

__device__ __forceinline__ float gelu_tanh(float x) {
    const float u = 0.7978845608028654f * (x + 0.044715f * x * x * x);
    const float e = __expf(2.f * u);
    const float th = 1.f - 2.f / (e + 1.f);
    return 0.5f * x * (1.f + th);
}
__device__ void phase_s5v2(const Params& p, unsigned char* lds, int L) {
    const int tid = opaque_tid(), lane = tid & 63, wave = __builtin_amdgcn_readfirstlane(tid >> 6);
    const int r32 = lane & 31, hi = lane >> 5, l15 = lane & 15, q4 = lane >> 4;
    float* bub = (float*)lds;
    unsigned char* s16 = lds + 65536;
    const bf16_t* proj = (const bf16_t*)(p.ws + WS_PROJ);
    bf16_t* s5y = (bf16_t*)(p.ws + WS_S5Y);
    const unsigned char* pre = p.ws + WS_S5PRE + L * S5PRE_LAYER;
    const float2* lbp = (const float2*)pre;
    const bf16_t* bb16 = (const bf16_t*)(pre + 16384);
    const bf16_t* cm16 = (const bf16_t*)(pre + 16384 + 131072);
    for (int it = blockIdx.x; it < NB * 32; it += gridDim.x) {
        const int b = it >> 5, g = it & 31;
        const size_t m0 = (size_t)b * SEQ;
        float2 lb = make_float2(0.f, 0.f); float sr = 0.f, si = 0.f;
        bf16x8 bfa, bfa7, cm[4]; float dsk = 0.f;
        const int a_tb = wave & 1, a_pb = wave >> 1;
        float l2r = 0.f, l2i = 0.f, l3r = 0.f, l3i = 0.f, l4r = 0.f, l4i = 0.f;
        if (wave == 7) {
            lb = lbp[g * 64 + lane];
            l2r = lb.x * lb.x - lb.y * lb.y; l2i = 2.f * lb.x * lb.y;
            l3r = l2r * lb.x - l2i * lb.y; l3i = l2r * lb.y + l2i * lb.x;
            l4r = l2r * l2r - l2i * l2i; l4i = 2.f * l2r * l2i;
        }
        else {
            bfa = *(const bf16x8*)(bb16 + ((size_t)(g * 128 + 32 * a_pb + r32)) * 16 + 8 * hi);
            if (wave == 0) bfa7 = *(const bf16x8*)(bb16 + ((size_t)(g * 128 + 32 * 3 + r32)) * 16 + 8 * hi);
            if (wave < 4) {
#pragma unroll
                for (int ks = 0; ks < 4; ++ks) cm[ks] = *(const bf16x8*)(cm16 + ((size_t)(g * 16 + l15)) * 128 + 32 * ks + 8 * q4);
                dsk = p.in[11][((size_t)L * 32 + g) * 16 + l15];
            }
        }
        const bf16_t* urow = proj + (m0 + 32 * a_tb + r32) * NP + C_U + g * 16 + 8 * hi;
        const bf16_t* urow7 = proj + (m0 + 32 + r32) * NP + C_U + g * 16 + 8 * hi;
        const bf16_t* yrow = proj + (m0 + 16 * wave + 4 * q4) * NP + C_U + g * 16 + l15;
        bf16x8 af0, af1, af70, af71; bf16_t uy0[4], uy1[4];
        af0 = af1 = af70 = af71 = (bf16x8){0, 0, 0, 0, 0, 0, 0, 0};
#pragma unroll
        for (int r = 0; r < 4; ++r) { uy0[r] = 0; uy1[r] = 0; }
        if (wave != 7) {
            af0 = *(const bf16x8*)(urow); af1 = *(const bf16x8*)(urow + (size_t)64 * NP);
            if (wave == 0) { af70 = *(const bf16x8*)(urow7); af71 = *(const bf16x8*)(urow7 + (size_t)64 * NP); }
            if (wave < 4) {
#pragma unroll
                for (int r = 0; r < 4; ++r) { uy0[r] = yrow[(size_t)r * NP]; uy1[r] = yrow[(size_t)(64 + r) * NP]; }
            }
        }
        __syncthreads();
#pragma unroll 1
        for (int c = -1; c <= SEQ / 64; ++c) {
            if (wave == 7) {
                if (c >= 0 && c < SEQ / 64) {
                    const float2* bc = (const float2*)(bub + (c & 1) * 8192);
                    unsigned* sc = (unsigned*)(s16 + (c & 1) * 17408);
#define S5_CFMA(ar, ai, xr, xi, yr, yi, outr, outi) do { outr = fmaf(ar, xr, fmaf(-(ai), xi, yr)); outi = fmaf(ar, xi, fmaf(ai, xr, yi)); } while (0)
#pragma unroll 1
                    for (int tb = 0; tb < 4; ++tb) {
                        float2 bu[16];
#pragma unroll
                        for (int i = 0; i < 16; ++i) bu[i] = bc[(tb * 16 + i) * 64 + lane];
#pragma unroll
                        for (int q = 0; q < 4; ++q) {
                            float c2r, c2i, c3r, c3i, c4r, c4i, s1r, s1i, s2r, s2i, s3r, s3i, s4r, s4i;
                            S5_CFMA(lb.x, lb.y, bu[4 * q].x, bu[4 * q].y, bu[4 * q + 1].x, bu[4 * q + 1].y, c2r, c2i);
                            S5_CFMA(lb.x, lb.y, c2r, c2i, bu[4 * q + 2].x, bu[4 * q + 2].y, c3r, c3i);
                            S5_CFMA(lb.x, lb.y, c3r, c3i, bu[4 * q + 3].x, bu[4 * q + 3].y, c4r, c4i);
                            S5_CFMA(lb.x, lb.y, sr, si, bu[4 * q].x, bu[4 * q].y, s1r, s1i);
                            S5_CFMA(l2r, l2i, sr, si, c2r, c2i, s2r, s2i);
                            S5_CFMA(l3r, l3i, sr, si, c3r, c3i, s3r, s3i);
                            S5_CFMA(l4r, l4i, sr, si, c4r, c4i, s4r, s4i);
                            sc[(tb * 16 + 4 * q) * 68 + lane] = pg8::cvt_pk_bf16(s1r, s1i);
                            sc[(tb * 16 + 4 * q + 1) * 68 + lane] = pg8::cvt_pk_bf16(s2r, s2i);
                            sc[(tb * 16 + 4 * q + 2) * 68 + lane] = pg8::cvt_pk_bf16(s3r, s3i);
                            sc[(tb * 16 + 4 * q + 3) * 68 + lane] = pg8::cvt_pk_bf16(s4r, s4i);
                            sr = s4r; si = s4i;
                        }
                    }
#undef S5_CFMA
                }
            } else {
                if (c + 1 < SEQ / 64) {
                    const int cc = c + 1;
                    float* bw = bub + (cc & 1) * 8192;
                    {
                        att::f32x16 d;
#pragma unroll
                        for (int r = 0; r < 16; ++r) d[r] = 0.f;
                        d = __builtin_amdgcn_mfma_f32_32x32x16_bf16(af0, bfa, d, 0, 0, 0);
#pragma unroll
                        for (int r = 0; r < 16; ++r) bw[(32 * a_tb + att::crow(r, hi)) * 128 + 32 * a_pb + r32] = d[r];
                    }
                    if (wave == 0) {
                        att::f32x16 d;
#pragma unroll
                        for (int r = 0; r < 16; ++r) d[r] = 0.f;
                        d = __builtin_amdgcn_mfma_f32_32x32x16_bf16(af70, bfa7, d, 0, 0, 0);
#pragma unroll
                        for (int r = 0; r < 16; ++r) bw[(32 + att::crow(r, hi)) * 128 + 96 + r32] = d[r];
                    }
                    af0 = af1; af70 = af71;
                    if (cc + 2 < SEQ / 64) {
                        af1 = *(const bf16x8*)(urow + (size_t)(64 * (cc + 2)) * NP);
                        if (wave == 0) af71 = *(const bf16x8*)(urow7 + (size_t)(64 * (cc + 2)) * NP);
                    }
                }
                if (c >= 1 && wave < 4) {
                    const int cc = c - 1;
                    const unsigned char* sb = s16 + (cc & 1) * 17408;
                    f32x4 acc = (f32x4){0.f, 0.f, 0.f, 0.f};
#pragma unroll
                    for (int ks = 0; ks < 4; ++ks) {
                        const bf16x8 af = *(const bf16x8*)(sb + (16 * wave + l15) * 272 + 64 * ks + 16 * q4);
                        acc = __builtin_amdgcn_mfma_f32_16x16x32_bf16(af, cm[ks], acc, 0, 0, 0);
                    }
#pragma unroll
                    for (int r = 0; r < 4; ++r) {
                        const size_t m = m0 + 64 * cc + 16 * wave + 4 * q4 + r;
                        s5y[m * 512 + g * 16 + l15] = (bf16_t)f2bf(gelu_tanh(acc[r] + dsk * bf2f(uy0[r])));
                    }
#pragma unroll
                    for (int r = 0; r < 4; ++r) { uy0[r] = uy1[r]; if (cc + 2 < SEQ / 64) uy1[r] = yrow[(size_t)(64 * (cc + 2) + r) * NP]; }
                }
            }
            __syncthreads();
        }
    }
}

struct OneUnit {
    pg8::Unit u;
    __device__ __forceinline__ bool next(int i, pg8::Unit& o) const { if (i) return false; o = u; return true; }
    __device__ __forceinline__ void a_ready(const pg8::Unit&) const {}
    __device__ __forceinline__ void done(const pg8::Unit&) const {}
};
constexpr int P3_NSA = NB * 32, P3_DIFF = NB * 4 * 16, P3_RET = NB * 4 * 8, P3_GLU = (MTOK / 256) * 2, P3_ITEMS = P3_NSA + P3_DIFF + P3_RET + P3_GLU;
__device__ __forceinline__ int p3_key(int e) {
    int c;
    if (e < P3_NSA) c = 4 * ((31 - (e & 31)) + 9);
    else if (e < P3_NSA + P3_DIFF) c = 3 * (2 * (15 - ((e - P3_NSA) & 15)) + 2);
    else if (e < P3_NSA + P3_DIFF + P3_RET) c = 4 * (4 * (7 - ((e - P3_NSA - P3_DIFF) & 7)) + 4);
    else c = 8;
    return c * 1024 + e;
}
__device__ void phase_p3(const Params& p, unsigned char* lds, int L) {
    const int tid = opaque_tid(), lane = tid & 63;
    unsigned short* order = (unsigned short*)(lds + 131072 + 64);
    volatile int* slot = (volatile int*)(lds + 131072 + 48);
    int* keys = (int*)lds;
    for (int e = tid; e < P3_ITEMS; e += NTHREADS) keys[e] = p3_key(e);
    __syncthreads();
    for (int e = tid; e < P3_ITEMS; e += NTHREADS) {
        const int ke = keys[e]; int rank = 0;
#pragma unroll 8
        for (int f = 0; f < P3_ITEMS; ++f) rank += keys[f] > ke ? 1 : 0;
        order[rank] = (unsigned short)e;
    }
    const float* lamw = (const float*)(p.ws + WS_LAM) + 2 * L;
    unsigned* qctr = (unsigned*)(p.ws + WS_QUEUE) + L * 64;
    __syncthreads();
    for (;;) {
        if (tid == 0) *slot = (int)atomicAdd(qctr, 1u);
        __syncthreads();
        const int q = *slot;
        __syncthreads();
        if (q >= P3_ITEMS) break;
        const int e = order[q];
        if (e < P3_NSA) nsa_unit(p, lds, e);
        else if (e < P3_NSA + P3_DIFF) diff_unit(p, lds, e - P3_NSA, lamw[0], lamw[1]);
        else if (e < P3_NSA + P3_DIFF + P3_RET) ret_unit(p, lds, e - P3_NSA - P3_DIFF);
        else {
            const int g = e - P3_NSA - P3_DIFF - P3_RET;
            pg8::Gemm gm{(const bf16_t*)(p.ws + WS_S5Y), (const bf16_t*)(p.ws + WS_WGLU + (size_t)L * 512 * 512 * 2), MTOK, 512, 512};
            OneUnit S{pg8::Unit{g >> 1, g & 1}};
            EpiGlu E{(const bf16_t*)(p.ws + WS_S5Y), (bf16_t*)(p.ws + WS_MIXED)};
            pg8::gemm_phase<EpiGlu, OneUnit, true, true>((PG8_LAS unsigned char*)lds, gm, S, E);
            __syncthreads();
        }
    }
    if (L == 0) conv_fill(p, lds, CONV_B_BLK);
}

#define LAS __attribute__((address_space(3)))
#define XB_TMO      128
#define XB_XCNT(j)  (256  + 64 * (j))
#define XB_XSUB(j)  (1280 + 64 * (j))
#define XB_XGEN(j)  (2304 + 64 * (j))
#define XB_TOP      3328
#define XB_TOPGEN   3392
#define XCD_BAR_WORDS 3456
#define XB_SPIN_CAP (1u << 18)

__device__ __forceinline__ unsigned xb_ld(unsigned* p)              { return __hip_atomic_load(p, __ATOMIC_RELAXED, __HIP_MEMORY_SCOPE_AGENT); }
__device__ __forceinline__ unsigned xb_add(unsigned* p, unsigned v) { return __hip_atomic_fetch_add(p, v, __ATOMIC_RELAXED, __HIP_MEMORY_SCOPE_AGENT); }
__device__ __forceinline__ unsigned xb_xcc_id() { return (unsigned)__builtin_amdgcn_s_getreg((3 << 11) | 20) & 0xFu; }
#define XB_SPIN(cond, bar) do { unsigned _sp = 0; while (cond) { __builtin_amdgcn_s_sleep(1); \
    if ((++_sp & 255u) == 0u) { if (xb_ld(&(bar)[XB_TMO])) break; if (_sp > XB_SPIN_CAP) { atomicAdd(&(bar)[XB_TMO], 1u); break; } } } } while (0)

struct XcdBarrier {
    unsigned* bar; unsigned x;
    volatile LAS unsigned* st;
};

__device__ __forceinline__ XcdBarrier xcd_barrier_post(unsigned* bar, volatile LAS unsigned* st) {
    XcdBarrier b; b.bar = bar; b.x = xb_xcc_id(); b.st = st;
    if (threadIdx.x == 0) (void)xb_add(&bar[XB_XCNT(b.x)], 1u);
    return b;
}
__device__ __forceinline__ void xcd_barrier_complete(unsigned* bar, unsigned x, unsigned& nloc, unsigned& nx) {
    const unsigned G = gridDim.x * gridDim.y * gridDim.z;
    unsigned sum, cnt, mine, sp = 0u;
    for (;;) {
        sum = 0u; cnt = 0u; mine = 0u;
#pragma unroll
        for (unsigned j = 0; j < 16; ++j) { const unsigned c = xb_ld(&bar[XB_XCNT(j)]); sum += c; cnt += (c > 0u) ? 1u : 0u; mine = (j == x) ? c : mine; }
        if (sum == G) break;
        __builtin_amdgcn_s_sleep(1);
        if ((++sp & 255u) == 0u) { if (xb_ld(&bar[XB_TMO])) break; if (sp > XB_SPIN_CAP) { atomicAdd(&bar[XB_TMO], 1u); break; } }
    }
    nloc = mine > 0u ? mine : 1u; nx = cnt > 0u ? cnt : 1u;
}

__device__ __forceinline__ void xcd_barrier(const XcdBarrier& b) {
    asm volatile("s_waitcnt vmcnt(0)" ::: "memory");
    __syncthreads();
    if (threadIdx.x == 0) {
        unsigned* bar = b.bar;
        __builtin_amdgcn_s_waitcnt(0);
        unsigned nloc = b.st[0], nx = b.st[1];
        if (nloc == 0u) { xcd_barrier_complete(bar, b.x, nloc, nx); b.st[0] = nloc; b.st[1] = nx; }
        const unsigned old = xb_add(&bar[XB_XSUB(b.x)], 1u);
        const unsigned gen = old / nloc;
        if (old + 1u == (gen + 1u) * nloc) {
            __builtin_amdgcn_fence(__ATOMIC_RELEASE, "agent");
            asm volatile("s_waitcnt vmcnt(0)" ::: "memory");
            const unsigned og = xb_add(&bar[XB_TOP], 1u);
            const unsigned tg = og / nx;
            if (og + 1u == (tg + 1u) * nx) xb_add(&bar[XB_TOPGEN], 1u);
            else XB_SPIN(xb_ld(&bar[XB_TOPGEN]) == tg, bar);
            __builtin_amdgcn_fence(__ATOMIC_ACQUIRE, "agent");
            xb_add(&bar[XB_XGEN(b.x)], 1u);
            asm volatile("s_waitcnt vmcnt(0)" ::: "memory");
        } else {
            XB_SPIN(xb_ld(&bar[XB_XGEN(b.x)]) == gen, bar);
            __builtin_amdgcn_fence(__ATOMIC_ACQUIRE, "agent");
            asm volatile("s_waitcnt vmcnt(0)" ::: "memory");
        }
    }
    __syncthreads();
}

__global__ void __launch_bounds__(NTHREADS, 2) fwd_megakernel(Params p) {
    extern __shared__ __attribute__((aligned(16))) unsigned char lds[];
    cg::grid_group grid = cg::this_grid();
    unsigned char* ws = p.ws;
    bf16_t* xb = (bf16_t*)(ws + WS_XB);
    bf16_t* proj = (bf16_t*)(ws + WS_PROJ);
    bf16_t* mixed = (bf16_t*)(ws + WS_MIXED);
    bf16_t* hid = (bf16_t*)(ws + WS_HID);
    float* sumsq = (float*)(ws + WS_SUMSQ);

    volatile LAS unsigned* misc = (volatile LAS unsigned*)((LAS unsigned char*)lds + 131072);
    if (threadIdx.x < 16) misc[threadIdx.x] = 0u;
    __syncthreads();
    XcdBarrier bar = xcd_barrier_post((unsigned*)(ws + WS_BAR), misc + 8);
    phase_prologue(p, lds);
    grid.sync();
#pragma unroll 1
    for (int L = 0; L < DEPTH; ++L) {
        const float* xin = (L == 0) ? p.in[0] : p.out;
        float* ss1 = sumsq + (2 * L) * MTOK;
        float* ss2 = sumsq + (2 * L + 1) * MTOK;
        float* ss3 = (L + 1 < DEPTH) ? sumsq + (2 * L + 2) * MTOK : nullptr;
        run_gemm(lds, xb, (const bf16_t*)(ws + WS_WIN + L * WIN_LAYER), MTOK, NP, DM, EpiScale{proj, NP, ss1, 0});
        xcd_barrier(bar);
        phase_prep(p);
        phase_cmp_mfma(p, lds, L);
        phase_s5v2(p, lds, L);
        if (L == 0 && blockIdx.x >= NB * 32) conv_fill(p, lds, 3);
        xcd_barrier(bar);
        phase_p3(p, lds, L);
        xcd_barrier(bar);
        run_gemm(lds, mixed, (const bf16_t*)(ws + WS_WOUT + L * WOUT_LAYER), MTOK, DM, DM, EpiResid{xin, p.out, xb, ss2});
        xcd_barrier(bar);
        run_gemm(lds, xb, (const bf16_t*)(ws + WS_W1 + L * W1_LAYER), MTOK, DFF, DM, EpiScale{hid, DFF, ss2, 1});
        xcd_barrier(bar);
        run_gemm(lds, hid, (const bf16_t*)(ws + WS_W2 + L * W2_LAYER), MTOK, DM, DFF, EpiResid{p.out, p.out, (L + 1 < DEPTH) ? xb : nullptr, ss3});
        if (L + 1 < DEPTH) xcd_barrier(bar);
    }
}

extern "C" void kernel_launch(void* const* d_in, const int* in_sizes, int n_in, void* d_out, int out_size, void* d_ws, size_t ws_size, hipStream_t stream) {
    static int grid = 0;
    if (grid == 0) {
        if (n_in != 25 || out_size != MTOK * DM || ws_size < WS_END) { fprintf(stderr, "kernel_launch: unexpected problem (n_in %d out %d ws %zu)\n", n_in, out_size, ws_size); grid = -1; return; }
        int dev = 0, cus = 0, per_cu = 0;
        (void)hipGetDevice(&dev);
        (void)hipDeviceGetAttribute(&cus, hipDeviceAttributeMultiprocessorCount, dev);
        (void)hipFuncSetAttribute((const void*)fwd_megakernel, hipFuncAttributeMaxDynamicSharedMemorySize, LDS_BYTES);
        (void)hipOccupancyMaxActiveBlocksPerMultiprocessor(&per_cu, (const void*)fwd_megakernel, NTHREADS, LDS_BYTES);
        if (per_cu < 1) { fprintf(stderr, "kernel_launch: occupancy query says %d blocks/CU\n", per_cu); grid = -1; return; }
        grid = cus;
    }
    if (grid < 0) return;
    (void)hipMemsetAsync((char*)d_ws + WS_CTL, 0, CTL_BYTES, stream);
    Params p{};
    for (int i = 0; i < 25; ++i) p.in[i] = (const float*)d_in[i];
    p.out = (float*)d_out; p.ws = (unsigned char*)d_ws;
    for (int j = 0; j < 64; ++j) p.inv128[j] = (float)pow(10000.0, -(double)(2 * j) / 128.0);
    for (int j = 0; j < 32; ++j) p.inv64[j] = (float)pow(10000.0, -(double)(2 * j) / 64.0);
    void* args[] = {&p};
    hipError_t e = hipLaunchCooperativeKernel((const void*)fwd_megakernel, dim3(grid), dim3(NTHREADS), args, LDS_BYTES, stream);
    if (e != hipSuccess) fprintf(stderr, "cooperative launch failed: %s (grid %d)\n", hipGetErrorString(e), grid);
}
```

```cpp
#include <hip/hip_runtime.h>
#include <hip/hip_cooperative_groups.h>
#include <cstdio>
#include <cstdint>
#include <cmath>
namespace cg = cooperative_groups;

typedef unsigned short bf16_t;
typedef short bf16x8 __attribute__((ext_vector_type(8)));
typedef float f32x4 __attribute__((ext_vector_type(4)));
typedef unsigned u32x2 __attribute__((ext_vector_type(2)));
typedef unsigned u32x4 __attribute__((ext_vector_type(4)));

constexpr int DM = 2048, NB = 4, SEQ = 2048, DEPTH = 2, MTOK = NB * SEQ;
constexpr int DFF = 8192, NIN = 5388, NP = 5632;
constexpr float EPS = 1e-6f;
constexpr int C_U = 0, C_RQ = 512, C_RK = 1024, C_RV = 1536, C_RG = 2048, C_NQ = 2560, C_NKC = 3072, C_NVC = 3200, C_NKS = 3328, C_NVS = 3456,
              C_NKW = 3584, C_NVW = 3712, C_DQ = 3840, C_DK = 4352, C_DV = 4864, C_GATE = 5376;
__host__ __device__ inline int orig_col(int c) { if (c < 3840) return c; if (c < 5376) return c + 12; if (c < 5388) return 3840 + (c - 5376); return -1; }

constexpr size_t MiB = 1u << 20;
constexpr size_t WS_CTL = 0, CTL_BYTES = 1 * MiB;
constexpr size_t WS_QUEUE = 8 * 1024;
constexpr size_t WS_CMPCNT = 10 * 1024;
constexpr size_t WS_LAM = 12 * 1024;
constexpr size_t WS_BAR = 16 * 1024;
constexpr size_t WS_SUMSQ = 64 * 1024;
constexpr size_t WS_ROPE128 = 1 * MiB;
constexpr size_t WS_ROPE64 = 5 * MiB;
constexpr size_t WS_S5PRE = 7 * MiB;
constexpr size_t S5PRE_LAYER = 32 * 64 * 8 + 32 * 64 * 16 * 8;
constexpr size_t WS_KVCMP = 8 * MiB;
constexpr size_t WS_KVCMPB = 9 * MiB;
constexpr size_t WS_WGLU = 10 * MiB;
constexpr size_t WS_WIN = 12 * MiB, WIN_LAYER = (size_t)NP * DM * 2;
constexpr size_t WS_WOUT = 56 * MiB, WOUT_LAYER = (size_t)DM * DM * 2;
constexpr size_t WS_W1 = 72 * MiB, W1_LAYER = (size_t)DFF * DM * 2;
constexpr size_t WS_W2 = 136 * MiB, W2_LAYER = (size_t)DM * DFF * 2;
constexpr size_t WS_XB = 200 * MiB;
constexpr size_t WS_MIXED = 232 * MiB;
constexpr size_t WS_S5Y = 264 * MiB;
constexpr size_t WS_HID = 272 * MiB;
constexpr size_t WS_PROJ = 272 * MiB;
constexpr size_t WS_WCMP = 400 * MiB;
constexpr size_t WS_KPART = 404 * MiB;
constexpr size_t WS_END = 406 * MiB;

constexpr int NTHREADS = 512, NWAVES = 8;
constexpr int LDS_BYTES = 147456;

struct Params {
    const float* in[25];
    float* out;
    unsigned char* ws;
    float inv128[64];
    float inv64[32];
};

__device__ __forceinline__ float bf2f(bf16_t v) { return __uint_as_float((unsigned)v << 16); }
__device__ __forceinline__ unsigned f2bf(float f) { unsigned u = __float_as_uint(f); return (u + 0x7fffu + ((u >> 16) & 1u)) >> 16; }
__device__ __forceinline__ unsigned pk2(float lo, float hi) { return f2bf(lo) | (f2bf(hi) << 16); }
__device__ __forceinline__ float shx(float v, int o, int lane) { return __int_as_float(__builtin_amdgcn_ds_bpermute((lane ^ o) << 2, __float_as_int(v))); }
__device__ __forceinline__ float shl(float v, int src, int lane) { (void)lane; return __int_as_float(__builtin_amdgcn_ds_bpermute(src << 2, __float_as_int(v))); }
__device__ __forceinline__ float wave_sum(float v, int lane) {
#pragma unroll
    for (int o = 1; o < 64; o <<= 1) v += shx(v, o, lane);
    return v;
}
__device__ __forceinline__ float wave_max(float v, int lane) {
#pragma unroll
    for (int o = 1; o < 64; o <<= 1) v = fmaxf(v, shx(v, o, lane));
    return v;
}
__device__ __forceinline__ float half_sum(float v) { auto r = __builtin_amdgcn_permlane32_swap(__float_as_uint(v), __float_as_uint(v), false, false); return __uint_as_float(r[0]) + __uint_as_float(r[1]); }
__device__ __forceinline__ float half_max(float v) { auto r = __builtin_amdgcn_permlane32_swap(__float_as_uint(v), __float_as_uint(v), false, false); return fmaxf(__uint_as_float(r[0]), __uint_as_float(r[1])); }
#define LDS_WAIT() asm volatile("s_waitcnt lgkmcnt(0)" ::: "memory")
__device__ __forceinline__ int opaque_tid() { int t = (int)threadIdx.x; asm volatile("" : "+v"(t)); return t; }

__device__ __forceinline__ void transpose_item(const float* W, int K, int N, const float* gk, bf16_t* WT, bool winmap, float* scr, int item, int nblk, int lane) {
    const int kb = item / nblk, nb = item % nblk, k0 = 64 * kb, n0 = 32 * nb;
    const int c4 = (lane & 7) * 4, rr = lane >> 3;
    const int oc = winmap ? orig_col(n0 + c4) : n0 + c4;
    f32x4 v[8];
#pragma unroll
    for (int i = 0; i < 8; ++i) v[i] = (oc >= 0) ? *(const f32x4*)(W + (size_t)(k0 + 8 * i + rr) * N + oc) : (f32x4){0.f, 0.f, 0.f, 0.f};
#pragma unroll
    for (int i = 0; i < 8; ++i) {
        const int kk = 8 * i + rr;
        f32x4 t = v[i];
        if (gk) t = t * gk[k0 + kk];
        float* d = scr + kk * 33 + c4;
        d[0] = t.x; d[1] = t.y; d[2] = t.z; d[3] = t.w;
    }
    LDS_WAIT();
    const int c = lane & 7;
#pragma unroll
    for (int j = 0; j < 4; ++j) {
        const int nn = (lane >> 3) + 8 * j;
        const float* s = scr + (8 * c) * 33 + nn;
        u32x4 o;
        o.x = pk2(s[0 * 33], s[1 * 33]); o.y = pk2(s[2 * 33], s[3 * 33]); o.z = pk2(s[4 * 33], s[5 * 33]); o.w = pk2(s[6 * 33], s[7 * 33]);
        *(u32x4*)(WT + (size_t)(n0 + nn) * K + k0 + 8 * c) = o;
    }
    LDS_WAIT();
}

constexpr int I_IN = (DM / 64) * (NP / 32), I_OUT = (DM / 64) * (DM / 32), I_1 = (DM / 64) * (DFF / 32), I_2 = (DFF / 64) * (DM / 32), I_G = (512 / 64) * (512 / 32), I_C = (4096 / 64) * (128 / 32);
constexpr int I_LAYER = I_IN + I_OUT + I_1 + I_2 + I_G + 2 * I_C;
__device__ __forceinline__ void conv_wave_item(const Params& p, float* scr, int L, int r, int lane) {
    unsigned char* ws = p.ws;
    if (r < I_IN) { transpose_item(p.in[3] + (size_t)L * DM * NIN, DM, NIN, p.in[2] + L * DM, (bf16_t*)(ws + WS_WIN + L * WIN_LAYER), true, scr, r, NP / 32, lane); return; } r -= I_IN;
    if (r < I_OUT) { transpose_item(p.in[21] + (size_t)L * DM * DM, DM, DM, nullptr, (bf16_t*)(ws + WS_WOUT + L * WOUT_LAYER), false, scr, r, DM / 32, lane); return; } r -= I_OUT;
    if (r < I_1) { transpose_item(p.in[23] + (size_t)L * DM * DFF, DM, DFF, p.in[22] + L * DM, (bf16_t*)(ws + WS_W1 + L * W1_LAYER), false, scr, r, DFF / 32, lane); return; } r -= I_1;
    if (r < I_2) { transpose_item(p.in[24] + (size_t)L * DFF * DM, DFF, DM, nullptr, (bf16_t*)(ws + WS_W2 + L * W2_LAYER), false, scr, r, DM / 32, lane); return; } r -= I_2;
    if (r < I_G) { transpose_item(p.in[12] + (size_t)L * 512 * 512, 512, 512, nullptr, (bf16_t*)(ws + WS_WGLU + (size_t)L * 512 * 512 * 2), false, scr, r, 512 / 32, lane); return; } r -= I_G;
    { const int kv = r / I_C; r -= kv * I_C;
      transpose_item(p.in[15 + kv] + (size_t)L * 4096 * 128, 4096, 128, nullptr, (bf16_t*)(ws + WS_WCMP) + ((size_t)(L * 2 + kv)) * 128 * 4096, false, scr, r, 128 / 32, lane); }
}
constexpr int CONV_A = I_IN + I_G + 2 * I_C, CONV_B0 = I_OUT + I_1 + I_2, CONV_B = CONV_B0 + I_LAYER;
constexpr int CONV_A_BLK = CONV_A / 32, CONV_B_BLK = CONV_B / 32;
static_assert(CONV_A % 32 == 0 && CONV_B % 32 == 0, "conversion block-items");
__device__ __forceinline__ void conv_block_item(const Params& p, unsigned char* lds, int blk, int tid) {
    const int lane = tid & 63, wave = tid >> 6;
    float* scr = (float*)(lds + wave * 8448);
#pragma unroll 1
    for (int i = 0; i < 4; ++i) {
        int L = 0, r;
        if (blk < CONV_A_BLK) {
            const int a = blk * 32 + i * 8 + wave;
            r = a < I_IN ? a : (a < I_IN + I_G ? I_IN + I_OUT + I_1 + I_2 + (a - I_IN) : I_IN + I_OUT + I_1 + I_2 + I_G + (a - I_IN - I_G));
        } else {
            const int bidx = (blk - CONV_A_BLK) * 32 + i * 8 + wave;
            if (bidx < CONV_B0) r = I_IN + bidx; else { L = 1; r = bidx - CONV_B0; }
        }
        conv_wave_item(p, scr, L, r, lane);
    }
}
__device__ __forceinline__ void conv_fill(const Params& p, unsigned char* lds, int max_items) {
    const int tid = opaque_tid();
    volatile int* slot = (volatile int*)(lds + 131072 + 60);
    unsigned* qc = (unsigned*)(p.ws + WS_QUEUE) + 2 * 64;
    for (int n = 0; n < max_items; ++n) {
        if (tid == 0) *slot = (int)atomicAdd(qc, 1u);
        __syncthreads();
        const int q = *slot;
        __syncthreads();
        if (q >= CONV_B_BLK) break;
        conv_block_item(p, lds, CONV_A_BLK + q, tid);
    }
    __syncthreads();
}

__device__ void phase_prologue(const Params& p, unsigned char* lds) {
    const int tid = opaque_tid(), lane = tid & 63, wave = tid >> 6;
    const int gw = blockIdx.x * NWAVES + wave, NGW = gridDim.x * NWAVES;
    unsigned char* ws = p.ws;
    for (int blk = blockIdx.x; blk < CONV_A_BLK; blk += gridDim.x) conv_block_item(p, lds, blk, tid);
    if (blockIdx.x == gridDim.x - 1 && wave == 0) {
        for (int L = 0; L < DEPTH; ++L) {
            const float lam_init = 0.8f - 0.6f * expf(-0.3f * (float)L);
            const float a = p.in[17][L * 64 + lane] * p.in[18][L * 64 + lane];
            const float c = p.in[19][L * 64 + lane] * p.in[20][L * 64 + lane];
            const float lamv = expf(wave_sum(a, lane)) - expf(wave_sum(c, lane)) + lam_init;
            if (lane == 0) { float* lw = (float*)(ws + WS_LAM) + 2 * L; lw[0] = lamv; lw[1] = lam_init; }
        }
    }
    const float* x = p.in[0];
    bf16_t* xb = (bf16_t*)(ws + WS_XB);
    float* sumsq = (float*)(ws + WS_SUMSQ);
    const int* pos = (const int*)p.in[1];
    float2* r128 = (float2*)(ws + WS_ROPE128);
    float2* r64 = (float2*)(ws + WS_ROPE64);
    for (int m = gw; m < MTOK; m += NGW) {
        const f32x4* xr = (const f32x4*)(x + (size_t)m * DM);
        float ss = 0.f;
#pragma unroll
        for (int j = 0; j < 8; ++j) {
            const f32x4 v = xr[64 * j + lane];
            ss += v.x * v.x + v.y * v.y + v.z * v.z + v.w * v.w;
            u32x2 o; o.x = pk2(v.x, v.y); o.y = pk2(v.z, v.w);
            *(u32x2*)(xb + (size_t)m * DM + 4 * (64 * j + lane)) = o;
        }
        ss = wave_sum(ss, lane);
        if (lane == 0) sumsq[m] = ss;
        const float fp = (float)pos[m];
        { const float ang = fp * p.inv128[lane]; float s, c; sincosf(ang, &s, &c); r128[(size_t)m * 64 + lane] = make_float2(c, s); }
        if (lane < 32) { const float ang = fp * p.inv64[lane]; float s, c; sincosf(ang, &s, &c); r64[(size_t)m * 32 + lane] = make_float2(c, s); }
    }
    for (int it = blockIdx.x * NTHREADS + tid; it < DEPTH * 32 * 64; it += gridDim.x * NTHREADS) {
        const int L = it / (32 * 64), gp = it % (32 * 64), g = gp / 64;
        const float lr = p.in[4][(size_t)L * 2048 + gp], li = p.in[5][(size_t)L * 2048 + gp];
        const float dt = expf(p.in[6][L * 32 + g]);
        const float mag = expf(lr * dt);
        float sn, cs; sincosf(li * dt, &sn, &cs);
        const float lbr = mag * cs, lbi = mag * sn;
        const float den = lr * lr + li * li;
        const float fr = ((lbr - 1.0f) * lr + lbi * li) / den;
        const float fi = (lbi * lr - (lbr - 1.0f) * li) / den;
        unsigned char* pre = ws + WS_S5PRE + L * S5PRE_LAYER;
        float2* lb = (float2*)pre;
        bf16_t* bb16 = (bf16_t*)(pre + 16384);
        bf16_t* cm16 = (bf16_t*)(pre + 16384 + 131072);
        lb[gp] = make_float2(lbr, lbi);
        const int pst = gp & 63;
        const float* bre = p.in[7] + ((size_t)L * 2048 + gp) * 16;
        const float* bim = p.in[8] + ((size_t)L * 2048 + gp) * 16;
#pragma unroll
        for (int h = 0; h < 16; ++h) {
            bb16[((size_t)(g * 128 + 2 * pst)) * 16 + h] = (bf16_t)f2bf(fr * bre[h] - fi * bim[h]);
            bb16[((size_t)(g * 128 + 2 * pst + 1)) * 16 + h] = (bf16_t)f2bf(fr * bim[h] + fi * bre[h]);
        }
#pragma unroll
        for (int n = 0; n < 16; ++n) {
            const float cr = p.in[9][(((size_t)L * 32 + g) * 16 + n) * 64 + pst], ci = p.in[10][(((size_t)L * 32 + g) * 16 + n) * 64 + pst];
            *(unsigned*)(cm16 + ((size_t)(g * 16 + n)) * 128 + 2 * pst) = pk2(cr, -ci);
        }
    }
}

namespace pg8 {
#define PG8_LAS __attribute__((address_space(3)))
typedef unsigned short bf16_t;
typedef short bf16x8 __attribute__((ext_vector_type(8)));
typedef float f32x4 __attribute__((ext_vector_type(4)));
typedef unsigned u32x4 __attribute__((ext_vector_type(4)));
constexpr int BM = 256, BK = 64, HALF = 128, HTB = HALF * BK * 2  , STAGE_BYTES = 8 * HTB, NXCD = 8, WGM = 8;

__host__ __device__ __forceinline__ int lds_byte(int r, int c) { const int st = (r >> 4) * 2 + (c >> 5), rr = r & 15, cc = c & 31, ob = rr * 64 + cc * 2; return st * 1024 + (ob ^ (((ob >> 9) & 1) << 5)); }
__host__ __device__ __forceinline__ void stage_rc(int b, int& R, int& C) { const int st = b / 1024, sb = b % 1024, swz = sb ^ (((sb >> 9) & 1) << 5); R = (st >> 1) * 16 + swz / 64; C = (st & 1) * 32 + (swz % 64) / 2; }
__host__ __device__ __forceinline__ int perm32(int rho) { const int n = rho >> 4, i = rho & 15; return 8 * (i >> 2) + 4 * n + (i & 3); }

struct Unit { int pm, pn; };
struct Gemm { const bf16_t* A; const bf16_t* Bt; int M, N, K; };

struct StaticOrder {
    int nM, nN, nwg, G, c;
    __host__ __device__ void init(int M, int N, int G_, int c_) { nM = M / BM; nN = N / BM; nwg = nM * nN; G = G_; c = c_; }
    __host__ __device__ bool next(int i, Unit& u) const {
        const long L = (long)i * G + c; if (L >= nwg) return false;
        int wgid = (int)L; { const int q = nwg / NXCD, r = nwg % NXCD, xcd = wgid % NXCD, off = wgid / NXCD; wgid = (xcd < r ? xcd * (q + 1) : r * (q + 1) + (xcd - r) * q) + off; }
        const int nig = WGM * nN, gid = wgid / nig, fm = gid * WGM, gsz = (nM - fm) < WGM ? (nM - fm) : WGM;
        u.pm = fm + ((wgid % nig) % gsz); u.pn = (wgid % nig) / gsz; return true;
    }
    __device__ __forceinline__ void a_ready(const Unit&) const {}
    __device__ __forceinline__ void done(const Unit&) const {}
};

__device__ __forceinline__ unsigned cvt_pk_bf16(float lo, float hi) { unsigned r; asm volatile("v_cvt_pk_bf16_f32 %0, %1, %2" : "=v"(r) : "v"(lo), "v"(hi)); return r; }
template <class Epi, class Sched, bool ALIGN_EPI = false, bool SP2 = false>
__device__ __forceinline__ void gemm_phase(PG8_LAS unsigned char* lds, const Gemm g, const Sched& S, const Epi& E) {
    const int tid = opaque_tid(), wid = __builtin_amdgcn_readfirstlane(tid >> 6), lane = tid & 63, wr = wid >> 2, wc = wid & 3, fr = lane & 15, fq = lane >> 4;
    const int K = g.K, nt = K / BK;
    unsigned voffA[2], voffB[2];
#pragma unroll
    for (int i = 0; i < 2; ++i) { int R, C; stage_rc(tid * 16 + i * 8192, R, C); const int Rb = Epi::PERM ? ((R & ~31) + perm32(R & 31)) : R;
        voffA[i] = (unsigned)(R * K + C) * 2u; voffB[i] = (unsigned)(Rb * K + C) * 2u; }
    const size_t kstep = (size_t)(BK * 2);
    const size_t hstep = (size_t)HALF * K * 2;
    const size_t tstep = 2 * hstep;
    const unsigned ldsw = (unsigned)wid * 1024u;
    const int aoff = lds_byte(wr * 64 + fr, fq * 8), boff = lds_byte(wc * 32 + fr, fq * 8);
#define PG8_SA(b, h) (((b) * 2 + (h)) * HTB)
#define PG8_SB(b, h) ((4 + (b) * 2 + (h)) * HTB)
#define PG8_STAGE(bufoff, gbase, voff) do { _Pragma("unroll") for (int _i = 0; _i < 2; ++_i) \
        __builtin_amdgcn_global_load_lds((const unsigned*)((const char*)(gbase) + (voff)[_i]), (PG8_LAS unsigned*)(lds + (bufoff) + ldsw + _i * 8192), 16, 0, 0); } while (0)
#define PG8_LDA(dst, b, h) do { _Pragma("unroll") for (int m = 0; m < 4; ++m) _Pragma("unroll") for (int k = 0; k < 2; ++k) dst[m][k] = *(const PG8_LAS bf16x8*)(lds + PG8_SA(b, h) + aoff + m * 2048 + k * 1024); } while (0)
#define PG8_LDB(dst, b, h) do { _Pragma("unroll") for (int n = 0; n < 2; ++n) _Pragma("unroll") for (int k = 0; k < 2; ++k) dst[n][k] = *(const PG8_LAS bf16x8*)(lds + PG8_SB(b, h) + boff + n * 2048 + k * 1024); } while (0)
#define PG8_MMA(ai, bj, At, Bt) do { __builtin_amdgcn_s_setprio(1); _Pragma("unroll") for (int m = 0; m < 4; ++m) _Pragma("unroll") for (int n = 0; n < 2; ++n) _Pragma("unroll") for (int k = 0; k < 2; ++k) \
        acc[ai][bj][m][n] = __builtin_amdgcn_mfma_f32_16x16x32_bf16(Bt[n][k], At[m][k], acc[ai][bj][m][n], 0, 0, 0); __builtin_amdgcn_s_setprio(0); } while (0)
#define PG8_WAIT_V(n) asm volatile("s_waitcnt vmcnt(" #n ")" ::: "memory")
#define PG8_WAIT_L(n) asm volatile("s_waitcnt lgkmcnt(" #n ")" ::: "memory")
#define PG8_BAR __builtin_amdgcn_s_barrier()
#define PG8_SCHED __builtin_amdgcn_sched_barrier(0)
    Unit cur, nxt; int ui = 0;
    if (!S.next(0, cur)) return;
    f32x4 acc[2][2][4][2];
#pragma unroll
    for (int a = 0; a < 2; ++a)
#pragma unroll
        for (int b = 0; b < 2; ++b)
#pragma unroll
            for (int m = 0; m < 4; ++m)
#pragma unroll
                for (int n = 0; n < 2; ++n) acc[a][b][m][n] = (f32x4){0.f, 0.f, 0.f, 0.f};
    bf16x8 At[4][2], B0[2][2], B1[2][2];
    const char* cA = (const char*)g.A + (size_t)cur.pm * tstep; const char* cB = (const char*)g.Bt + (size_t)cur.pn * tstep;
    S.a_ready(cur);
    if constexpr (SP2) {
        PG8_STAGE(PG8_SB(0, 0), cB, voffB); PG8_STAGE(PG8_SB(0, 1), cB + hstep, voffB); PG8_STAGE(PG8_SA(0, 0), cA, voffA); PG8_STAGE(PG8_SA(0, 1), cA + hstep, voffA);
        if (wr == 1) PG8_BAR;
        PG8_WAIT_V(2); PG8_BAR;
        PG8_STAGE(PG8_SB(1, 0), cB + kstep, voffB); PG8_STAGE(PG8_SA(1, 0), cA + kstep, voffA); PG8_STAGE(PG8_SB(1, 1), cB + hstep + kstep, voffB);
        PG8_WAIT_V(6); PG8_BAR;
    } else {
        PG8_STAGE(PG8_SB(0, 0), cB, voffB); PG8_STAGE(PG8_SA(0, 0), cA, voffA); PG8_STAGE(PG8_SB(0, 1), cB + hstep, voffB); PG8_STAGE(PG8_SA(0, 1), cA + hstep, voffA);
        if (wr == 1) PG8_BAR;
        PG8_WAIT_V(4); PG8_BAR;
        PG8_STAGE(PG8_SB(1, 0), cB + kstep, voffB); PG8_STAGE(PG8_SA(1, 0), cA + kstep, voffA); PG8_STAGE(PG8_SB(1, 1), cB + hstep + kstep, voffB);
        PG8_WAIT_V(6); PG8_BAR;
    }
    for (;;) {
        const bool has_next = S.next(ui + 1, nxt);
        const char* nA = has_next ? (const char*)g.A + (size_t)nxt.pm * tstep : cA; const char* nB = has_next ? (const char*)g.Bt + (size_t)nxt.pn * tstep : cB;
        for (int t = 0; t < nt; t += 2) {
            const bool last = (t == nt - 2);
            const char* a1 = cA + (size_t)(t + 1) * kstep;
            const char* a2 = last ? nA : cA + (size_t)(t + 2) * kstep; const char* b2 = last ? nB : cB + (size_t)(t + 2) * kstep;
            const char* a3 = a2 + kstep; const char* b3 = b2 + kstep;
            if (last && has_next) S.a_ready(nxt);
            if constexpr (SP2) {
            PG8_LDB(B0, 0, 0); PG8_LDB(B1, 0, 1); PG8_SCHED; PG8_LDA(At, 0, 0); PG8_STAGE(PG8_SA(1, 1), a1 + hstep, voffA);
            PG8_WAIT_V(8); PG8_WAIT_L(0); PG8_BAR; PG8_MMA(0, 0, At, B0); PG8_MMA(0, 1, At, B1); PG8_BAR; PG8_SCHED;
            PG8_LDA(At, 0, 1); PG8_STAGE(PG8_SB(0, 0), b2, voffB); PG8_STAGE(PG8_SB(0, 1), b2 + hstep, voffB); PG8_STAGE(PG8_SA(0, 0), a2, voffA);
            PG8_WAIT_V(8); PG8_WAIT_L(0); PG8_BAR; PG8_MMA(1, 0, At, B0); PG8_MMA(1, 1, At, B1); PG8_BAR; PG8_SCHED;
            PG8_LDB(B0, 1, 0); PG8_LDB(B1, 1, 1); PG8_SCHED; PG8_LDA(At, 1, 0); PG8_STAGE(PG8_SA(0, 1), a2 + hstep, voffA);
            PG8_WAIT_V(8); PG8_WAIT_L(0); PG8_BAR; PG8_MMA(0, 0, At, B0); PG8_MMA(0, 1, At, B1); PG8_BAR; PG8_SCHED;
            PG8_LDA(At, 1, 1); PG8_STAGE(PG8_SB(1, 0), b3, voffB); PG8_STAGE(PG8_SB(1, 1), b3 + hstep, voffB); PG8_STAGE(PG8_SA(1, 0), a3, voffA);
            PG8_WAIT_V(8); PG8_WAIT_L(0); PG8_BAR; PG8_MMA(1, 0, At, B0); PG8_MMA(1, 1, At, B1); PG8_BAR; PG8_SCHED;
            } else {
            PG8_LDB(B0, 0, 0); PG8_SCHED; PG8_LDA(At, 0, 0); PG8_STAGE(PG8_SA(1, 1), a1 + hstep, voffA);
            PG8_WAIT_L(8); PG8_BAR; PG8_WAIT_L(0); PG8_MMA(0, 0, At, B0); PG8_BAR; PG8_SCHED;
            PG8_LDB(B1, 0, 1); PG8_STAGE(PG8_SB(0, 0), b2, voffB);
            PG8_BAR; PG8_WAIT_L(0); PG8_MMA(0, 1, At, B1); PG8_BAR;
            PG8_LDA(At, 0, 1); PG8_STAGE(PG8_SA(0, 0), a2, voffA);
            PG8_BAR; PG8_WAIT_L(0); PG8_MMA(1, 0, At, B0); PG8_BAR; PG8_SCHED;
            PG8_STAGE(PG8_SB(0, 1), b2 + hstep, voffB);
            PG8_WAIT_V(6); PG8_BAR; PG8_MMA(1, 1, At, B1); PG8_BAR;
            PG8_LDB(B0, 1, 0); PG8_SCHED; PG8_LDA(At, 1, 0); PG8_STAGE(PG8_SA(0, 1), a2 + hstep, voffA);
            PG8_WAIT_L(8); PG8_BAR; PG8_WAIT_L(0); PG8_MMA(0, 0, At, B0); PG8_BAR; PG8_SCHED;
            PG8_LDB(B1, 1, 1); PG8_STAGE(PG8_SB(1, 0), b3, voffB);
            PG8_BAR; PG8_WAIT_L(0); PG8_MMA(0, 1, At, B1); PG8_BAR;
            PG8_LDA(At, 1, 1); PG8_STAGE(PG8_SA(1, 0), a3, voffA);
            PG8_BAR; PG8_WAIT_L(0); PG8_MMA(1, 0, At, B0); PG8_BAR; PG8_SCHED;
            PG8_STAGE(PG8_SB(1, 1), b3 + hstep, voffB);
            PG8_WAIT_V(6); PG8_BAR; PG8_MMA(1, 1, At, B1); PG8_BAR;
            }
        }
        if constexpr (ALIGN_EPI) { if (wr == 0) PG8_BAR; }
        if constexpr (!Epi::AFTER_DRAIN) { E(acc, cur, wr, wc, fr, fq); S.done(cur); }
        if (!has_next) break;
#pragma unroll
        for (int a = 0; a < 2; ++a)
#pragma unroll
            for (int b = 0; b < 2; ++b)
#pragma unroll
                for (int m = 0; m < 4; ++m)
#pragma unroll
                    for (int n = 0; n < 2; ++n) acc[a][b][m][n] = (f32x4){0.f, 0.f, 0.f, 0.f};
        cur = nxt; cA = nA; cB = nB; ++ui;
        if constexpr (ALIGN_EPI) { if (wr == 1) PG8_BAR; }
    }
    PG8_WAIT_V(0);
    if constexpr (!ALIGN_EPI) { if (wr == 0) PG8_BAR; }
    PG8_BAR;
    if constexpr (Epi::AFTER_DRAIN) { E.fused(acc, cur, wr, wc, fr, fq, lds, wid, lane); S.done(cur); }
#undef PG8_SA
#undef PG8_SB
#undef PG8_STAGE
#undef PG8_LDA
#undef PG8_LDB
#undef PG8_MMA
#undef PG8_WAIT_V
#undef PG8_WAIT_L
#undef PG8_BAR
#undef PG8_SCHED
}
}

struct EpiScale {
    static constexpr bool PERM = true, AFTER_DRAIN = false;
    bf16_t* O; int ldc; const float* sumsq; int relu2;
    __device__ __forceinline__ void operator()(const f32x4 (&acc)[2][2][4][2], const pg8::Unit& u, int wr, int wc, int fr, int fq) const {
        const int row0 = u.pm * 256 + wr * 64 + fr, col0 = u.pn * 256 + wc * 32 + 8 * fq;
        float rs[2][4];
#pragma unroll
        for (int ai = 0; ai < 2; ++ai)
#pragma unroll
            for (int m = 0; m < 4; ++m) rs[ai][m] = sumsq[row0 + ai * 128 + m * 16];
#pragma unroll
        for (int ai = 0; ai < 2; ++ai)
#pragma unroll
            for (int m = 0; m < 4; ++m) {
                const int row = row0 + ai * 128 + m * 16;
                const float rstd = rsqrtf(rs[ai][m] * (1.0f / DM) + EPS);
                bf16_t* rowp = O + (size_t)row * ldc + col0;
#pragma unroll
                for (int bj = 0; bj < 2; ++bj) {
                    f32x4 v0 = acc[ai][bj][m][0] * rstd, v1 = acc[ai][bj][m][1] * rstd;
                    if (relu2) {
                        v0.x = fmaxf(v0.x, 0.f); v0.y = fmaxf(v0.y, 0.f); v0.z = fmaxf(v0.z, 0.f); v0.w = fmaxf(v0.w, 0.f);
                        v1.x = fmaxf(v1.x, 0.f); v1.y = fmaxf(v1.y, 0.f); v1.z = fmaxf(v1.z, 0.f); v1.w = fmaxf(v1.w, 0.f);
                        v0 = v0 * v0; v1 = v1 * v1;
                    }
                    u32x4 w; w.x = pg8::cvt_pk_bf16(v0[0], v0[1]); w.y = pg8::cvt_pk_bf16(v0[2], v0[3]); w.z = pg8::cvt_pk_bf16(v1[0], v1[1]); w.w = pg8::cvt_pk_bf16(v1[2], v1[3]);
                    *(u32x4*)(rowp + bj * 128) = w;
                }
                asm volatile("" ::: "memory");
            }
    }
};
struct EpiResid {
    static constexpr bool PERM = false, AFTER_DRAIN = false;
    const float* xold; float* xnew; bf16_t* xb; float* sumsq_next;
    __device__ __forceinline__ void operator()(const f32x4 (&acc)[2][2][4][2], const pg8::Unit& u, int wr, int wc, int fr, int fq) const {
        const int row0 = u.pm * 256 + wr * 64 + fr, col0 = u.pn * 256 + wc * 32 + 4 * fq;
        f32x4 res[2][2][2];
#define EPR_LOAD(slot, g) do { const int row_ = row0 + ((g) >> 2) * 128 + ((g) & 3) * 16; _Pragma("unroll") for (int bj = 0; bj < 2; ++bj) _Pragma("unroll") for (int n = 0; n < 2; ++n) \
        res[slot][bj][n] = *(const f32x4*)(xold + (size_t)row_ * DM + col0 + bj * 128 + n * 16); } while (0)
        EPR_LOAD(0, 0);
#pragma unroll
        for (int g = 0; g < 8; ++g) {
            const int ai = g >> 2, m = g & 3, row = row0 + ai * 128 + m * 16;
            if (g + 1 < 8) { if (g & 1) EPR_LOAD(0, g + 1); else EPR_LOAD(1, g + 1); }
            float ss = 0.f;
#pragma unroll
            for (int bj = 0; bj < 2; ++bj)
#pragma unroll
                for (int n = 0; n < 2; ++n) {
                    const size_t off = (size_t)row * DM + col0 + bj * 128 + n * 16;
                    const f32x4 v = res[g & 1][bj][n] + acc[ai][bj][m][n];
                    *(f32x4*)(xnew + off) = v;
                    if (xb) { u32x2 o; o.x = pg8::cvt_pk_bf16(v[0], v[1]); o.y = pg8::cvt_pk_bf16(v[2], v[3]); *(u32x2*)(xb + off) = o; }
                    ss += (v[0] * v[0] + v[1] * v[1]) + (v[2] * v[2] + v[3] * v[3]);
                }
            if (sumsq_next) {
                ss += shx(ss, 16, fq * 16 + fr); ss += shx(ss, 32, fq * 16 + fr);
                if (fq == 0) atomicAdd(sumsq_next + row, ss);
            }
            asm volatile("" ::: "memory");
        }
#undef EPR_LOAD
    }
};
struct EpiGlu {
    static constexpr bool PERM = true, AFTER_DRAIN = false;
    const bf16_t* y; bf16_t* mixed;
    __device__ __forceinline__ void operator()(const f32x4 (&acc)[2][2][4][2], const pg8::Unit& u, int wr, int wc, int fr, int fq) const {
        const int row0 = u.pm * 256 + wr * 64 + fr, col0 = u.pn * 256 + wc * 32 + 8 * fq;
#pragma unroll
        for (int ai = 0; ai < 2; ++ai)
#pragma unroll
            for (int m = 0; m < 4; ++m) {
                const int row = row0 + ai * 128 + m * 16;
#pragma unroll
                for (int bj = 0; bj < 2; ++bj) {
                    const int col = col0 + bj * 128;
                    const u32x4 yv = *(const u32x4*)(y + (size_t)row * 512 + col);
                    const f32x4 a0 = acc[ai][bj][m][0], a1 = acc[ai][bj][m][1];
                    float r[8];
#pragma unroll
                    for (int e = 0; e < 4; ++e) {
                        const unsigned w = yv[e];
                        const float ylo = __uint_as_float(w << 16), yhi = __uint_as_float(w & 0xffff0000u);
                        const float alo = e < 2 ? a0[2 * e] : a1[2 * (e - 2)], ahi = e < 2 ? a0[2 * e + 1] : a1[2 * (e - 2) + 1];
                        r[2 * e] = ylo / (1.f + __expf(-alo)); r[2 * e + 1] = yhi / (1.f + __expf(-ahi));
                    }
                    u32x4 w; w.x = pg8::cvt_pk_bf16(r[0], r[1]); w.y = pg8::cvt_pk_bf16(r[2], r[3]); w.z = pg8::cvt_pk_bf16(r[4], r[5]); w.w = pg8::cvt_pk_bf16(r[6], r[7]);
                    *(u32x4*)(mixed + (size_t)row * DM + col) = w;
                }
                asm volatile("" ::: "memory");
            }
    }
};
template <class Epi>
__device__ __forceinline__ void run_gemm(unsigned char* lds, const bf16_t* A, const bf16_t* Bt, int M, int N, int K, const Epi& E) {
    pg8::Gemm g{A, Bt, M, N, K};
    pg8::StaticOrder S; S.init(M, N, (int)gridDim.x, (int)blockIdx.x);
    pg8::gemm_phase<Epi, pg8::StaticOrder, true, true>((PG8_LAS unsigned char*)lds, g, S, E);
}

namespace att {
#define ATT_LAS __attribute__((address_space(3)))
typedef float f32x16 __attribute__((ext_vector_type(16)));
typedef short s16x4 __attribute__((ext_vector_type(4)));
typedef ATT_LAS const unsigned char* ldscp;
typedef ATT_LAS unsigned char* ldsp;
constexpr int TILE = 16384, BUFB = 32768;
constexpr float NEG = -1e30f;
__device__ __forceinline__ unsigned off_b(unsigned row, unsigned ch) { return 256u * row + 16u * (ch ^ (((row & 3u) << 2) | ((row >> 2) & 3u))); }
__device__ __forceinline__ int crow(int r, int hi) { return (r & 3) + 8 * (r >> 2) + 4 * hi; }

struct Stage { int dummy; };
__device__ __forceinline__ void stage_dma(const bf16_t* K, int kpitch, const bf16_t* V, int vpitch, int key0, int kmax, ldsp buf, int tid) {
    const int lane = tid & 63, wv = __builtin_amdgcn_readfirstlane(tid >> 6);
#pragma unroll
    for (int h = 0; h < 2; ++h) {
        const int i = wv + 8 * h;
        const int r = 4 * i + (lane >> 4), s = lane & 15;
        const int ch = s ^ (((r & 3) << 2) | ((r >> 2) & 3));
        int kr = key0 + r; kr = kr < 0 ? 0 : (kr > kmax ? kmax : kr);
        __builtin_amdgcn_global_load_lds((const unsigned*)(K + (size_t)kr * kpitch + 8 * ch), (ATT_LAS unsigned*)(buf + i * 1024), 16, 0, 0);
        __builtin_amdgcn_global_load_lds((const unsigned*)(V + (size_t)kr * vpitch + 8 * ch), (ATT_LAS unsigned*)(buf + TILE + i * 1024), 16, 0, 0);
    }
}
#define ATT_DMA_WAIT() asm volatile("s_waitcnt vmcnt(0)" ::: "memory")
constexpr int NRING = 4;
__device__ __forceinline__ void ring_wait(int rem) {
    if (rem >= 2) asm volatile("s_waitcnt vmcnt(8)" ::: "memory");
    else if (rem == 1) asm volatile("s_waitcnt vmcnt(4)" ::: "memory");
    else asm volatile("s_waitcnt vmcnt(0)" ::: "memory");
}
struct WaveCtx { int lane, r32, hi, kch0; };
__device__ __forceinline__ void ctx_init(WaveCtx& w, int lane, int kch0) { w.lane = lane; w.r32 = lane & 31; w.hi = lane >> 5; w.kch0 = kch0; }
#define ATT_SB() __builtin_amdgcn_sched_barrier(0)
template <int NKS>
__device__ __forceinline__ void qk(ldscp Kt, const WaveCtx& w, const bf16x8 (&qf)[NKS], f32x16& p0, f32x16& p1) {
#pragma unroll
    for (int r = 0; r < 16; ++r) { p0[r] = 0.f; p1[r] = 0.f; }
    int ln = w.lane; asm volatile("" : "+v"(ln));
    const unsigned r32 = ln & 31, hi = ln >> 5;
    bf16x8 ka[3][2];
#define ATT_KLOAD(buf, b) do { const unsigned ko = off_b(r32, (w.kch0 + 2 * (b) + hi) & 15); \
        ka[buf][0] = *(const ATT_LAS bf16x8*)(Kt + ko); ka[buf][1] = *(const ATT_LAS bf16x8*)(Kt + ko + 8192); } while (0)
#define ATT_KMMA(buf, b) do { \
        p0 = __builtin_amdgcn_mfma_f32_32x32x16_bf16(ka[buf][0], qf[b], p0, 0, 0, 0); \
        p1 = __builtin_amdgcn_mfma_f32_32x32x16_bf16(ka[buf][1], qf[b], p1, 0, 0, 0); } while (0)
    ATT_KLOAD(0, 0); ATT_KLOAD(1, 1); ATT_SB();
#pragma unroll
    for (int b = 0; b < NKS; ++b) {
        if (b + 2 < NKS) { if (b % 3 == 0) ATT_KLOAD(2, b + 2); else if (b % 3 == 1) ATT_KLOAD(0, b + 2); else ATT_KLOAD(1, b + 2); }
        if (b % 3 == 0) ATT_KMMA(0, b); else if (b % 3 == 1) ATT_KMMA(1, b); else ATT_KMMA(2, b);
        if (b + 2 < NKS) __builtin_amdgcn_sched_group_barrier(0x100, 2, 0);
        __builtin_amdgcn_sched_group_barrier(0x008, 2, 0);
        ATT_SB();
    }
#undef ATT_KLOAD
#undef ATT_KMMA
}
__device__ __forceinline__ s16x4 trd(unsigned addr, int off) { s16x4 r; asm volatile("ds_read_b64_tr_b16 %0, %1 offset:%c2" : "=v"(r) : "v"(addr), "i"(off)); return r; }
__device__ __forceinline__ void pv(ldscp Vt, const WaveCtx& w, const bf16x8 (&pf)[2][2], f32x16 (&o)[4]) {
    int ln = w.lane; asm volatile("" : "+v"(ln));
    const unsigned hh = ln >> 5, blk = (ln >> 4) & 1, q = (ln & 15) >> 2, pp = ln & 3;
    const unsigned vbase = (unsigned)(uintptr_t)Vt;
    s16x4 vl[2][4], vh[2][4];
#define ATT_VLOAD(buf, c) do { const unsigned vo0 = vbase + off_b(4 * hh + q, 4 * (c) + 2 * blk + (pp >> 1)) + 8 * (pp & 1), vo1 = vbase + off_b(8 + 4 * hh + q, 4 * (c) + 2 * blk + (pp >> 1)) + 8 * (pp & 1); \
        vl[buf][0] = trd(vo0, 0); vh[buf][0] = trd(vo1, 0); vl[buf][1] = trd(vo0, 4096); vh[buf][1] = trd(vo1, 4096); \
        vl[buf][2] = trd(vo0, 8192); vh[buf][2] = trd(vo1, 8192); vl[buf][3] = trd(vo0, 12288); vh[buf][3] = trd(vo1, 12288); } while (0)
#define ATT_VMMA(buf, c) do { _Pragma("unroll") for (int kb = 0; kb < 2; ++kb) _Pragma("unroll") for (int s = 0; s < 2; ++s) { \
            const s16x4 lo = vl[buf][2 * kb + s], hi4 = vh[buf][2 * kb + s]; \
            const bf16x8 vf = (bf16x8){lo[0], lo[1], lo[2], lo[3], hi4[0], hi4[1], hi4[2], hi4[3]}; \
            o[c] = __builtin_amdgcn_mfma_f32_32x32x16_bf16(vf, pf[kb][s], o[c], 0, 0, 0); } } while (0)
#define ATT_LWAIT(n) do { asm volatile("s_waitcnt lgkmcnt(" #n ")" ::: "memory"); ATT_SB(); } while (0)
    asm volatile("s_waitcnt lgkmcnt(0)" ::: "memory"); ATT_SB();
    ATT_VLOAD(0, 0); ATT_SB();
    ATT_VLOAD(1, 1); ATT_LWAIT(8); ATT_VMMA(0, 0); ATT_SB();
    ATT_VLOAD(0, 2); ATT_LWAIT(8); ATT_VMMA(1, 1); ATT_SB();
    ATT_VLOAD(1, 3); ATT_LWAIT(8); ATT_VMMA(0, 2); ATT_SB();
    ATT_LWAIT(0); ATT_VMMA(1, 3); ATT_SB();
#undef ATT_VLOAD
#undef ATT_VMMA
#undef ATT_LWAIT
}
__device__ __forceinline__ void pack_p(const f32x16& p0, const f32x16& p1, bf16x8 (&pf)[2][2]) {
#pragma unroll
    for (int s = 0; s < 2; ++s) {
        u32x4 a, b;
#pragma unroll
        for (int i = 0; i < 4; ++i) { a[i] = pg8::cvt_pk_bf16(p0[8 * s + 2 * i], p0[8 * s + 2 * i + 1]); b[i] = pg8::cvt_pk_bf16(p1[8 * s + 2 * i], p1[8 * s + 2 * i + 1]); }
        pf[0][s] = __builtin_bit_cast(bf16x8, a); pf[1][s] = __builtin_bit_cast(bf16x8, b);
    }
}
__device__ __forceinline__ void apply_bounds(f32x16& p0, f32x16& p1, int klo, int khi, int hi) {
#pragma unroll
    for (int r = 0; r < 16; ++r) {
        const int k = crow(r, hi);
        if (k < klo || k > khi) p0[r] = NEG;
        if (k + 32 < klo || k + 32 > khi) p1[r] = NEG;
    }
}
__device__ __forceinline__ float ex2(float x) { return __builtin_amdgcn_exp2f(x); }
template <int NKS>
__device__ __forceinline__ void tile_softmax(ldscp Kt, ldscp Vt, const WaveCtx& w, const bf16x8 (&qf)[NKS], f32x16 (&o)[4], float& m, float& l, float c, bool need_mask, int klo, int khi) {
    f32x16 p0, p1;
    qk<NKS>(Kt, w, qf, p0, p1);
    if (need_mask) apply_bounds(p0, p1, klo, khi, w.hi);
    float mx = fmaxf(p0[0], p1[0]);
#pragma unroll
    for (int r = 1; r < 16; ++r) mx = fmaxf(mx, fmaxf(p0[r], p1[r]));
    mx = half_max(mx);
    const float mnew = fmaxf(m, mx * c);
    const float alpha = ex2(m - mnew);
    m = mnew;
    float ls = 0.f;
#pragma unroll
    for (int r = 0; r < 16; ++r) { p0[r] = ex2(fmaf(p0[r], c, -mnew)); p1[r] = ex2(fmaf(p1[r], c, -mnew)); ls += p0[r] + p1[r]; }
    l = l * alpha + ls;
    if (__any(alpha != 1.f)) {
#pragma unroll
        for (int cc = 0; cc < 4; ++cc)
#pragma unroll
            for (int r = 0; r < 16; ++r) o[cc][r] *= alpha;
    }
    bf16x8 pf[2][2];
    pack_p(p0, p1, pf);
    pv(Vt, w, pf, o);
}
}

__device__ void phase_prep(const Params& p) {
    const int tid = opaque_tid(), lane = tid & 63, wave = tid >> 6;
    const int gw = blockIdx.x * NWAVES + wave, NGW = gridDim.x * NWAVES;
    bf16_t* proj = (bf16_t*)(p.ws + WS_PROJ);
    const float2* r128 = (const float2*)(p.ws + WS_ROPE128);
    const float2* r64 = (const float2*)(p.ws + WS_ROPE64);
    constexpr int NH = 14;
    for (int m = gw; m < MTOK; m += NGW) {
        bf16_t* row = proj + (size_t)m * NP;
        const float2 cs = r128[(size_t)m * 64 + lane];
        const float2 cs2 = r64[(size_t)m * 32 + (lane & 31)];
        float x1[NH], x2[NH], y1[8], y2[8];
#pragma unroll
        for (int hh = 0; hh < NH; ++hh) {
            const int col = hh < 4 ? C_RQ + hh * 128 : (hh < 8 ? C_RK + (hh - 4) * 128 : (hh < 12 ? C_NQ + (hh - 8) * 128 : (hh == 12 ? C_NKS : C_NKW)));
            x1[hh] = bf2f(row[col + lane]); x2[hh] = bf2f(row[col + 64 + lane]);
        }
#pragma unroll
        for (int hp = 0; hp < 8; ++hp) {
            const int col = (hp < 4 ? C_DQ + hp * 128 : C_DK + (hp - 4) * 128) + (lane >> 5) * 64 + (lane & 31);
            y1[hp] = bf2f(row[col]); y2[hp] = bf2f(row[col + 32]);
        }
#pragma unroll
        for (int hh = 0; hh < NH; ++hh) {
            const int col = hh < 4 ? C_RQ + hh * 128 : (hh < 8 ? C_RK + (hh - 4) * 128 : (hh < 12 ? C_NQ + (hh - 8) * 128 : (hh == 12 ? C_NKS : C_NKW)));
            float mul = (hh >= 4 && hh < 8) ? 0.08838834764831845f : 1.f;
            if (hh >= 8) { const float ss = wave_sum(x1[hh] * x1[hh] + x2[hh] * x2[hh], lane); mul = rsqrtf(ss * (1.f / 128.f) + EPS); }
            const float a = x1[hh] * mul, c = x2[hh] * mul;
            row[col + lane] = (bf16_t)f2bf(a * cs.x - c * cs.y);
            row[col + 64 + lane] = (bf16_t)f2bf(c * cs.x + a * cs.y);
        }
#pragma unroll
        for (int hp = 0; hp < 8; ++hp) {
            const int col = (hp < 4 ? C_DQ + hp * 128 : C_DK + (hp - 4) * 128) + (lane >> 5) * 64 + (lane & 31);
            float ss = y1[hp] * y1[hp] + y2[hp] * y2[hp];
#pragma unroll
            for (int o = 1; o < 32; o <<= 1) ss += shx(ss, o, lane);
            const float mul = rsqrtf(ss * (1.f / 64.f) + EPS);
            const float a = y1[hp] * mul, c = y2[hp] * mul;
            row[col] = (bf16_t)f2bf(a * cs2.x - c * cs2.y);
            row[col + 32] = (bf16_t)f2bf(c * cs2.x + a * cs2.y);
        }
    }
}

__device__ __forceinline__ void diff_unit(const Params& p, unsigned char* lds, int unit, float lam, float lam_init) {
    const int tid = opaque_tid(), lane = tid & 63, wave = __builtin_amdgcn_readfirstlane(tid >> 6);
    const int qb = 15 - (unit & 15), bh = unit >> 4, h = bh & 3, b = bh >> 2;
    const int comp = wave >> 2, qsub = wave & 3, q0 = qb * 128 + qsub * 32;
    att::WaveCtx w; att::ctx_init(w, lane, 8 * comp);
    const int tq = q0 + w.r32;
    const bf16_t* base = (const bf16_t*)(p.ws + WS_PROJ) + (size_t)b * SEQ * NP;
    bf16x8 qf[4];
#pragma unroll
    for (int ks = 0; ks < 4; ++ks) qf[ks] = *(const bf16x8*)(base + (size_t)tq * NP + C_DQ + h * 128 + comp * 64 + 16 * ks + 8 * w.hi);
    att::f32x16 o[4];
#pragma unroll
    for (int c = 0; c < 4; ++c)
#pragma unroll
        for (int r = 0; r < 16; ++r) o[c][r] = 0.f;
    float m = att::NEG, l = 0.f;
    const float csc = 0.125f * 1.4426950408889634f;
    const bf16_t* Kg = base + C_DK + h * 128; const bf16_t* Vg = base + C_DV + h * 128;
    const int nt = 2 * qb + 2;
    att::ldsp L3 = (att::ldsp)lds;
    ATT_DMA_WAIT();
#pragma unroll
    for (int ks = 0; ks < 4; ++ks) asm volatile("" : "+v"(qf[ks]));
    int issued = 0;
    for (; issued < nt && issued < att::NRING - 1; ++issued) att::stage_dma(Kg, NP, Vg, NP, issued * 64, SEQ - 1, L3 + issued * att::BUFB, tid);
    for (int kt = 0; kt < nt; ++kt) {
        att::ring_wait(issued - 1 - kt);
        __syncthreads();
        if (issued < nt) { att::stage_dma(Kg, NP, Vg, NP, issued * 64, SEQ - 1, L3 + (issued & (att::NRING - 1)) * att::BUFB, tid); ++issued; }
        const int cur = kt & (att::NRING - 1);
        const int key0 = kt * 64;
        if (key0 <= q0 + 31)
            att::tile_softmax<4>((att::ldscp)(L3 + cur * att::BUFB), (att::ldscp)(L3 + cur * att::BUFB + att::TILE), w, qf, o, m, l, csc, key0 + 63 > q0, 0, tq - key0);
    }
    __syncthreads();
    const float linv = 1.f / half_sum(l);
    float* cb = (float*)lds;
    if (comp == 1) {
#pragma unroll
        for (int c = 0; c < 4; ++c)
#pragma unroll
            for (int r = 0; r < 16; ++r) cb[(qsub * 128 + 32 * c + att::crow(r, w.hi)) * 32 + w.r32] = o[c][r] * linv * lam;
    }
    __syncthreads();
    if (comp == 0) {
        float ss = 0.f;
#pragma unroll
        for (int c = 0; c < 4; ++c)
#pragma unroll
            for (int r = 0; r < 16; ++r) { const float v = o[c][r] * linv - cb[(qsub * 128 + 32 * c + att::crow(r, w.hi)) * 32 + w.r32]; o[c][r] = v; ss += v * v; }
        ss = half_sum(ss);
        const float sc = rsqrtf(ss * (1.f / 128.f) + EPS) * (1.f - lam_init);
        bf16_t* orow = (bf16_t*)(p.ws + WS_MIXED) + ((size_t)b * SEQ + tq) * DM + 1536 + h * 128;
#pragma unroll
        for (int c = 0; c < 4; ++c)
#pragma unroll
            for (int g = 0; g < 4; ++g) {
                u32x2 v; v.x = pg8::cvt_pk_bf16(o[c][4 * g] * sc, o[c][4 * g + 1] * sc); v.y = pg8::cvt_pk_bf16(o[c][4 * g + 2] * sc, o[c][4 * g + 3] * sc);
                *(u32x2*)(orow + 32 * c + 8 * g + 4 * w.hi) = v;
            }
    }
    __syncthreads();
}
__device__ void phase_diff_mfma(const Params& p, unsigned char* lds, int L) {
    const int lane = opaque_tid() & 63;
    const float lam_init = 0.8f - 0.6f * expf(-0.3f * (float)L);
    const float a = p.in[17][L * 64 + lane] * p.in[18][L * 64 + lane];
    const float c = p.in[19][L * 64 + lane] * p.in[20][L * 64 + lane];
    const float lam = expf(wave_sum(a, lane)) - expf(wave_sum(c, lane)) + lam_init;
    for (int unit = blockIdx.x; unit < NB * 4 * 16; unit += gridDim.x) diff_unit(p, lds, unit, lam, lam_init);
}

template <int NKS>
__device__ __forceinline__ void tile_decay(att::ldscp Kt, att::ldscp Vt, const att::WaveCtx& w, const bf16x8 (&qf)[NKS], att::f32x16 (&o)[4], float log2g, int dq, bool need_mask) {
    att::f32x16 p0, p1;
    att::qk<NKS>(Kt, w, qf, p0, p1);
#pragma unroll
    for (int r = 0; r < 16; ++r) {
        const int d0 = dq - att::crow(r, w.hi), d1 = d0 - 32;
        const float f0 = att::ex2(log2g * (float)d0), f1 = att::ex2(log2g * (float)d1);
        p0[r] = (need_mask && d0 < 0) ? 0.f : p0[r] * f0;
        p1[r] = (need_mask && d1 < 0) ? 0.f : p1[r] * f1;
    }
    bf16x8 pf[2][2];
    att::pack_p(p0, p1, pf);
    att::pv(Vt, w, pf, o);
}
__device__ __forceinline__ void ret_unit(const Params& p, unsigned char* lds, int unit) {
    const int tid = opaque_tid(), lane = tid & 63, wave = __builtin_amdgcn_readfirstlane(tid >> 6);
    const int qb = 7 - (unit & 7), bh = unit >> 3, h = bh & 3, b = bh >> 2;
    const int q0 = qb * 256 + wave * 32;
    att::WaveCtx w; att::ctx_init(w, lane, 0);
    const int tq = q0 + w.r32;
    const bf16_t* base = (const bf16_t*)(p.ws + WS_PROJ) + (size_t)b * SEQ * NP;
    bf16x8 qf[8];
#pragma unroll
    for (int ks = 0; ks < 8; ++ks) qf[ks] = *(const bf16x8*)(base + (size_t)tq * NP + C_RQ + h * 128 + 16 * ks + 8 * w.hi);
    att::f32x16 o[4];
#pragma unroll
    for (int c = 0; c < 4; ++c)
#pragma unroll
        for (int r = 0; r < 16; ++r) o[c][r] = 0.f;
    const float log2g = log2f(1.0f - exp2f(-5.0f - (float)h));
    const bf16_t* Kg = base + C_RK + h * 128; const bf16_t* Vg = base + C_RV + h * 128;
    const int nt = 4 * qb + 4;
    att::ldsp L3 = (att::ldsp)lds;
    ATT_DMA_WAIT();
#pragma unroll
    for (int ks = 0; ks < 8; ++ks) asm volatile("" : "+v"(qf[ks]));
    int issued = 0;
    for (; issued < nt && issued < att::NRING - 1; ++issued) att::stage_dma(Kg, NP, Vg, NP, issued * 64, SEQ - 1, L3 + issued * att::BUFB, tid);
    for (int kt = 0; kt < nt; ++kt) {
        att::ring_wait(issued - 1 - kt);
        __syncthreads();
        if (issued < nt) { att::stage_dma(Kg, NP, Vg, NP, issued * 64, SEQ - 1, L3 + (issued & (att::NRING - 1)) * att::BUFB, tid); ++issued; }
        const int cur = kt & (att::NRING - 1);
        const int key0 = kt * 64;
        if (key0 <= q0 + 31)
            tile_decay<8>((att::ldscp)(L3 + cur * att::BUFB), (att::ldscp)(L3 + cur * att::BUFB + att::TILE), w, qf, o, log2g, tq - key0, key0 + 63 > q0);
    }
    __syncthreads();
    float s1 = 0.f;
#pragma unroll
    for (int c = 0; c < 4; ++c)
#pragma unroll
        for (int r = 0; r < 16; ++r) s1 += o[c][r];
    s1 = half_sum(s1);
    const float mu = s1 * (1.f / 128.f);
    float s2 = 0.f;
#pragma unroll
    for (int c = 0; c < 4; ++c)
#pragma unroll
        for (int r = 0; r < 16; ++r) { const float d = o[c][r] - mu; o[c][r] = d; s2 += d * d; }
    s2 = half_sum(s2);
    const float rs = rsqrtf(s2 * (1.f / 128.f) + EPS);
    const size_t mrow = (size_t)b * SEQ + tq;
    const bf16_t* grow = (const bf16_t*)(p.ws + WS_PROJ) + mrow * NP + C_RG + h * 128;
    bf16_t* orow = (bf16_t*)(p.ws + WS_MIXED) + mrow * DM + 512 + h * 128;
#pragma unroll
    for (int c = 0; c < 4; ++c)
#pragma unroll
        for (int g = 0; g < 4; ++g) {
            const int e0 = 32 * c + 8 * g + 4 * w.hi;
            const u32x2 gv = *(const u32x2*)(grow + e0);
            const float g0 = __uint_as_float(gv.x << 16), g1 = __uint_as_float(gv.x & 0xffff0000u), g2 = __uint_as_float(gv.y << 16), g3 = __uint_as_float(gv.y & 0xffff0000u);
            u32x2 v;
            v.x = pg8::cvt_pk_bf16(g0 / (1.f + __expf(-g0)) * o[c][4 * g] * rs, g1 / (1.f + __expf(-g1)) * o[c][4 * g + 1] * rs);
            v.y = pg8::cvt_pk_bf16(g2 / (1.f + __expf(-g2)) * o[c][4 * g + 2] * rs, g3 / (1.f + __expf(-g3)) * o[c][4 * g + 3] * rs);
            *(u32x2*)(orow + e0) = v;
        }
    __syncthreads();
}
__device__ void phase_ret_mfma(const Params& p, unsigned char* lds) {
    for (int unit = (blockIdx.x + gridDim.x / 2) % gridDim.x; unit < NB * 4 * 8; unit += gridDim.x) ret_unit(p, lds, unit);
}

__device__ __forceinline__ void nsa_unit(const Params& p, unsigned char* lds, int unit) {
    const int tid = opaque_tid(), lane = tid & 63, wave = __builtin_amdgcn_readfirstlane(tid >> 6);
    const int tb = 31 - (unit & 31), b = unit >> 5;
    const int head = wave >> 1, thalf = wave & 1, t0w = tb * 64 + thalf * 32;
    att::WaveCtx w; att::ctx_init(w, lane, 0);
    const int tq = t0w + w.r32, tloc = thalf * 32 + w.r32;
    const bf16_t* base = (const bf16_t*)(p.ws + WS_PROJ) + (size_t)b * SEQ * NP;
    bf16x8 qf[8];
#pragma unroll
    for (int ks = 0; ks < 8; ++ks) qf[ks] = *(const bf16x8*)(base + (size_t)tq * NP + C_NQ + head * 128 + 16 * ks + 8 * w.hi);
#define NSA_GATE(br) (1.f / (1.f + __expf(-bf2f(base[(size_t)tq * NP + C_GATE + head * 3 + (br)]))))
    const float csc = 0.08838834764831845f * 1.4426950408889634f;
    float* impQ = (float*)(lds + 65536);
    float* impE = (float*)(lds + 65536 + 32768);
    float* scb = (float*)lds;
    unsigned* selm = (unsigned*)(lds + 8192);
    att::ldsp L3 = (att::ldsp)lds;
    att::f32x16 o[4];
#pragma unroll
    for (int c = 0; c < 4; ++c)
#pragma unroll
        for (int r = 0; r < 16; ++r) o[c][r] = 0.f;
    {
        const bf16_t* Kc = (const bf16_t*)(p.ws + WS_KVCMPB) + (size_t)b * 128 * 128; const bf16_t* Vc = Kc + 4 * 128 * 128;
        att::stage_dma(Kc, 128, Vc, 128, 0, 127, L3, tid);
        att::stage_dma(Kc, 128, Vc, 128, 64, 127, L3 + att::BUFB, tid);
        ATT_DMA_WAIT();
        __syncthreads();
        const int jmax = tq >= 31 ? ((tq - 31) >> 4) : -1;
        float m = att::NEG, l = 0.f;
#pragma unroll 1
        for (int kt = 0; kt < 2; ++kt) {
            att::f32x16 p0, p1;
            att::qk<8>((att::ldscp)(L3 + kt * att::BUFB), w, qf, p0, p1);
            att::apply_bounds(p0, p1, 0, jmax - 64 * kt, w.hi);
            float mx = fmaxf(p0[0], p1[0]);
#pragma unroll
            for (int r = 1; r < 16; ++r) mx = fmaxf(mx, fmaxf(p0[r], p1[r]));
            mx = half_max(mx);
            const float mnew = fmaxf(m, mx * csc);
            float ls = 0.f;
#pragma unroll
            for (int r = 0; r < 16; ++r) ls += att::ex2(fmaf(p0[r], csc, -mnew)) + att::ex2(fmaf(p1[r], csc, -mnew));
            l = l * att::ex2(m - mnew) + ls; m = mnew;
        }
        l = half_sum(l);
        const float inv = (jmax >= 0) ? 1.f / l : 0.f;
#pragma unroll 1
        for (int kt = 0; kt < 2; ++kt) {
            att::f32x16 p0, p1;
            att::qk<8>((att::ldscp)(L3 + kt * att::BUFB), w, qf, p0, p1);
            att::apply_bounds(p0, p1, 0, jmax - 64 * kt, w.hi);
#pragma unroll
            for (int r = 0; r < 16; ++r) { p0[r] = att::ex2(fmaf(p0[r], csc, -m)) * inv; p1[r] = att::ex2(fmaf(p1[r], csc, -m)) * inv; }
#pragma unroll
            for (int g = 0; g < 4; ++g) {
                const int ia = ((head * 32 + 16 * kt + 2 * g + w.hi) * 64) + tloc, ib = ia + 8 * 64;
                impQ[ia] = (p0[4 * g] + p0[4 * g + 1]) + (p0[4 * g + 2] + p0[4 * g + 3]); impE[ia] = p0[4 * g + 3];
                impQ[ib] = (p1[4 * g] + p1[4 * g + 1]) + (p1[4 * g + 2] + p1[4 * g + 3]); impE[ib] = p1[4 * g + 3];
            }
            bf16x8 pf[2][2];
            att::pack_p(p0, p1, pf);
            att::pv((att::ldscp)(L3 + kt * att::BUFB + att::TILE), w, pf, o);
        }
    }
    __syncthreads();
    unsigned mymask, tmask;
    {
        const int token = tid >> 3, js0 = (tid & 7) * 4;
        if (tid < 65) selm[tid] = 0u;
#pragma unroll
        for (int i = 0; i < 4; ++i) {
            const int js = js0 + i;
            float s = 0.f;
#pragma unroll
            for (int h = 0; h < 4; ++h) { s += impQ[(h * 32 + js) * 64 + token]; if (js > 0) s += impE[(h * 32 + js - 1) * 64 + token]; }
            const bool valid = js <= tb, forced = (js == 0) || (js == tb) || (js == tb - 1);
            scb[token * 32 + js] = valid ? s + (forced ? 1e4f : 0.f) : -1e30f;
        }
        __syncthreads();
        unsigned mine = 0u;
#pragma unroll
        for (int i = 0; i < 4; ++i) {
            const int js = js0 + i;
            const float my = scb[token * 32 + js];
            int rank = 0;
            for (int jj = 0; jj < 32; ++jj) { const float sj = scb[token * 32 + jj]; rank += (sj > my || (sj == my && jj < js)) ? 1 : 0; }
            if (js <= tb && rank < 8) mine |= 1u << js;
        }
        if (mine) { atomicOr(&selm[token], mine); atomicOr(&selm[64], mine); }
        __syncthreads();
        mymask = selm[tloc]; tmask = selm[64];
        __syncthreads();
    }
    bf16_t* orow = (bf16_t*)(p.ws + WS_MIXED) + ((size_t)b * SEQ + tq) * DM + 1024 + head * 128 + 4 * w.hi;
    {
        const float g0 = NSA_GATE(0);
#pragma unroll
        for (int c = 0; c < 4; ++c)
#pragma unroll
            for (int g = 0; g < 4; ++g) {
                u32x2 v; v.x = pg8::cvt_pk_bf16(g0 * o[c][4 * g], g0 * o[c][4 * g + 1]); v.y = pg8::cvt_pk_bf16(g0 * o[c][4 * g + 2], g0 * o[c][4 * g + 3]);
                *(u32x2*)(orow + 32 * c + 8 * g) = v;
                o[c][4 * g] = 0.f; o[c][4 * g + 1] = 0.f; o[c][4 * g + 2] = 0.f; o[c][4 * g + 3] = 0.f;
            }
    }
#define NSA_ACCUM(f) do { _Pragma("unroll") for (int c = 0; c < 4; ++c) _Pragma("unroll") for (int g = 0; g < 4; ++g) { \
        const u32x2 u = *(const u32x2*)(orow + 32 * c + 8 * g); u32x2 v; \
        v.x = pg8::cvt_pk_bf16(__uint_as_float(u.x << 16) + (f) * o[c][4 * g], __uint_as_float(u.x & 0xffff0000u) + (f) * o[c][4 * g + 1]); \
        v.y = pg8::cvt_pk_bf16(__uint_as_float(u.y << 16) + (f) * o[c][4 * g + 2], __uint_as_float(u.y & 0xffff0000u) + (f) * o[c][4 * g + 3]); \
        *(u32x2*)(orow + 32 * c + 8 * g) = v; \
        o[c][4 * g] = 0.f; o[c][4 * g + 1] = 0.f; o[c][4 * g + 2] = 0.f; o[c][4 * g + 3] = 0.f; } } while (0)
    {
        const bf16_t* Kg = base + C_NKS; const bf16_t* Vg = base + C_NVS;
        float m = att::NEG, l = 0.f;
        const unsigned tm = (unsigned)__builtin_amdgcn_readfirstlane((int)tmask);
        const int nt = __builtin_popcount(tm);
        unsigned mi = tm, mc = tm;
        ATT_DMA_WAIT();
#pragma unroll
        for (int ks = 0; ks < 8; ++ks) asm volatile("" : "+v"(qf[ks]));
        int issued = 0;
        for (; issued < nt && issued < att::NRING - 1; ++issued) { const int j = __builtin_ctz(mi); mi &= mi - 1; att::stage_dma(Kg, NP, Vg, NP, j * 64, SEQ - 1, L3 + issued * att::BUFB, tid); }
        for (int i = 0; i < nt; ++i) {
            att::ring_wait(issued - 1 - i);
            __syncthreads();
            if (issued < nt) { const int j = __builtin_ctz(mi); mi &= mi - 1; att::stage_dma(Kg, NP, Vg, NP, j * 64, SEQ - 1, L3 + (issued & (att::NRING - 1)) * att::BUFB, tid); ++issued; }
            const int cur = i & (att::NRING - 1);
            const int curj = __builtin_ctz(mc); mc &= mc - 1;
            const bool allowed = (mymask >> curj) & 1u;
            if (__any(allowed))
                att::tile_softmax<8>((att::ldscp)(L3 + cur * att::BUFB), (att::ldscp)(L3 + cur * att::BUFB + att::TILE), w, qf, o, m, l, csc, (curj == tb) || __any(!allowed), 0, allowed ? tq - curj * 64 : -1);
        }
        __syncthreads();
        l = half_sum(l);
        const float f = NSA_GATE(1) / l;
        NSA_ACCUM(f);
    }
    {
        const bf16_t* Kg = base + C_NKW; const bf16_t* Vg = base + C_NVW;
        float m = att::NEG, l = 0.f;
        const int kt0 = tb >= 4 ? tb - 4 : 0, nt = tb - kt0 + 1;
        ATT_DMA_WAIT();
        int issued = 0;
        for (; issued < nt && issued < att::NRING - 1; ++issued) att::stage_dma(Kg, NP, Vg, NP, (kt0 + issued) * 64, SEQ - 1, L3 + issued * att::BUFB, tid);
        for (int i = 0; i < nt; ++i) {
            att::ring_wait(issued - 1 - i);
            __syncthreads();
            if (issued < nt) { att::stage_dma(Kg, NP, Vg, NP, (kt0 + issued) * 64, SEQ - 1, L3 + (issued & (att::NRING - 1)) * att::BUFB, tid); ++issued; }
            const int kt = kt0 + i, cur = i & (att::NRING - 1);
            const int key0 = kt * 64;
            att::tile_softmax<8>((att::ldscp)(L3 + cur * att::BUFB), (att::ldscp)(L3 + cur * att::BUFB + att::TILE), w, qf, o, m, l, csc, (kt == tb) || (kt == tb - 4), tq - 255 - key0, tq - key0);
        }
        l = half_sum(l);
        const float f = NSA_GATE(2) / l;
        NSA_ACCUM(f);
    }
    __syncthreads();
#undef NSA_ACCUM
#undef NSA_GATE
}
__device__ void phase_nsa_mfma(const Params& p, unsigned char* lds) {
    for (int unit = blockIdx.x; unit < NB * 32; unit += gridDim.x) nsa_unit(p, lds, unit);
}

__device__ void phase_cmp_mfma(const Params& p, unsigned char* lds, int L) {
    const int tid = opaque_tid(), lane = tid & 63, wave = __builtin_amdgcn_readfirstlane(tid >> 6);
    const int r32 = lane & 31, hi = lane >> 5;
    const bf16_t* proj = (const bf16_t*)(p.ws + WS_PROJ);
    const float2* r128 = (const float2*)(p.ws + WS_ROPE128);
    float* part = (float*)lds;
    float* slabs = (float*)(p.ws + WS_KPART);
    unsigned* cnt = (unsigned*)(p.ws + WS_CMPCNT) + L * 32;
    volatile int* slot = (volatile int*)(lds + 131072 + 56);
    for (int item = (blockIdx.x + gridDim.x / 2) % gridDim.x; item < NB * 2 * 4 * 4; item += gridDim.x) {
        const int lq = item & 3, jb = (item >> 2) & 3, kv = (item >> 4) & 1, b = item >> 5;
        const bf16_t* Wt = (const bf16_t*)(p.ws + WS_WCMP) + ((size_t)(L * 2 + kv)) * 128 * 4096;
        const float* pe = p.in[kv ? 14 : 13] + (size_t)L * 32 * 128;
        const int col = kv ? C_NVC : C_NKC;
        int j = jb * 32 + r32; if (j > 126) j = 126;
        att::f32x16 acc[4];
#pragma unroll
        for (int nb = 0; nb < 4; ++nb)
#pragma unroll
            for (int r = 0; r < 16; ++r) acc[nb][r] = 0.f;
        {
            const int l = lq * 8 + wave;
            const size_t m = (size_t)b * SEQ + 16 * j + l;
            const bf16_t* xrow = proj + m * NP + col;
#pragma unroll 4
            for (int ks = 0; ks < 8; ++ks) {
                const int d0 = 16 * ks + 8 * hi;
                const bf16x8 xv = *(const bf16x8*)(xrow + d0);
                float xf[8];
#pragma unroll
                for (int e = 0; e < 8; ++e) xf[e] = bf2f((bf16_t)xv[e]);
                if (!kv) {
                    const bf16x8 xp = *(const bf16x8*)(xrow + (d0 ^ 64));
                    const f32x4* cs4 = (const f32x4*)(r128 + m * 64 + (d0 & 63));
#pragma unroll
                    for (int e2 = 0; e2 < 4; ++e2) {
                        const f32x4 t = cs4[e2];
                        const float o0 = bf2f((bf16_t)xp[2 * e2]), o1 = bf2f((bf16_t)xp[2 * e2 + 1]);
                        xf[2 * e2] = (d0 < 64) ? xf[2 * e2] * t.x - o0 * t.y : xf[2 * e2] * t.x + o0 * t.y;
                        xf[2 * e2 + 1] = (d0 < 64) ? xf[2 * e2 + 1] * t.z - o1 * t.w : xf[2 * e2 + 1] * t.z + o1 * t.w;
                    }
                }
                const f32x4 pe0 = *(const f32x4*)(pe + l * 128 + d0), pe1 = *(const f32x4*)(pe + l * 128 + d0 + 4);
                u32x4 xa;
                xa.x = pg8::cvt_pk_bf16(xf[0] + pe0.x, xf[1] + pe0.y); xa.y = pg8::cvt_pk_bf16(xf[2] + pe0.z, xf[3] + pe0.w);
                xa.z = pg8::cvt_pk_bf16(xf[4] + pe1.x, xf[5] + pe1.y); xa.w = pg8::cvt_pk_bf16(xf[6] + pe1.z, xf[7] + pe1.w);
                const bf16x8 xfr = __builtin_bit_cast(bf16x8, xa);
#pragma unroll
                for (int nb = 0; nb < 4; ++nb) {
                    const bf16x8 wf = *(const bf16x8*)(Wt + (size_t)(nb * 32 + r32) * 4096 + l * 128 + d0);
                    acc[nb] = __builtin_amdgcn_mfma_f32_32x32x16_bf16(wf, xfr, acc[nb], 0, 0, 0);
                }
            }
        }
        __syncthreads();
#pragma unroll
        for (int nb = 0; nb < 4; ++nb)
#pragma unroll
            for (int r = 0; r < 16; ++r) part[(wave * 128 + nb * 32 + att::crow(r, hi)) * 32 + r32] = acc[nb][r];
        __syncthreads();
        const int jj = tid & 31, ng = tid >> 5;
        const int jrow = jb * 32 + jj;
        float v[8];
#pragma unroll
        for (int i = 0; i < 8; ++i) {
            float s = 0.f;
#pragma unroll
            for (int w8 = 0; w8 < 8; ++w8) s += part[(w8 * 128 + ng * 8 + i) * 32 + jj];
            v[i] = s;
        }
        {
            float* my = slabs + ((size_t)((lq * 2 + kv) * 4 + b) * 128 + jrow) * 128 + ng * 8;
            *(f32x4*)my = (f32x4){v[0], v[1], v[2], v[3]}; *(f32x4*)(my + 4) = (f32x4){v[4], v[5], v[6], v[7]};
        }
        asm volatile("s_waitcnt vmcnt(0)" ::: "memory");
        __syncthreads();
        if (tid == 0) {
            __builtin_amdgcn_fence(__ATOMIC_RELEASE, "agent");
            asm volatile("s_waitcnt vmcnt(0)" ::: "memory");
            *slot = (int)__hip_atomic_fetch_add(cnt + (item >> 2), 1u, __ATOMIC_RELAXED, __HIP_MEMORY_SCOPE_AGENT);
        }
        __syncthreads();
        const int ticket = *slot;
        if (ticket == 3) {
            if (tid == 0) { __builtin_amdgcn_fence(__ATOMIC_ACQUIRE, "agent"); asm volatile("s_waitcnt vmcnt(0)" ::: "memory"); }
            __syncthreads();
            float ss = 0.f;
#pragma unroll
            for (int i = 0; i < 8; ++i) v[i] = 0.f;
#pragma unroll
            for (int q4 = 0; q4 < 4; ++q4) {
                const float* sp = slabs + ((size_t)((q4 * 2 + kv) * 4 + b) * 128 + jrow) * 128 + ng * 8;
                const f32x4 a0 = *(const f32x4*)sp, a1 = *(const f32x4*)(sp + 4);
                v[0] += a0.x; v[1] += a0.y; v[2] += a0.z; v[3] += a0.w; v[4] += a1.x; v[5] += a1.y; v[6] += a1.z; v[7] += a1.w;
            }
#pragma unroll
            for (int i = 0; i < 8; ++i) ss += v[i] * v[i];
            float sc = 1.f;
            if (!kv) {
                part[ng * 32 + jj] = ss;
                __syncthreads();
                float tot = 0.f;
#pragma unroll
                for (int g2 = 0; g2 < 16; ++g2) tot += part[g2 * 32 + jj];
                sc = rsqrtf(tot * (1.f / 128.f) + EPS);
            }
            if (jrow > 126) sc = 0.f;
            u32x4 ov;
            ov.x = pg8::cvt_pk_bf16(v[0] * sc, v[1] * sc); ov.y = pg8::cvt_pk_bf16(v[2] * sc, v[3] * sc); ov.z = pg8::cvt_pk_bf16(v[4] * sc, v[5] * sc); ov.w = pg8::cvt_pk_bf16(v[6] * sc, v[7] * sc);
            *(u32x4*)((bf16_t*)(p.ws + WS_KVCMPB) + (size_t)kv * 4 * 128 * 128 + ((size_t)b * 128 + jrow) * 128 + ng * 8) = ov;
        }
        __syncthreads();
    }
    __syncthreads();
}

__device__ __forceinline__ float gelu_tanh(float x) {
    const float u = 0.7978845608028654f * (x + 0.044715f * x * x * x);
    const float e = __expf(2.f * u);
    const float th = 1.f - 2.f / (e + 1.f);
    return 0.5f * x * (1.f + th);
}
__device__ void phase_s5v2(const Params& p, unsigned char* lds, int L) {
    const int tid = opaque_tid(), lane = tid & 63, wave = __builtin_amdgcn_readfirstlane(tid >> 6);
    const int r32 = lane & 31, hi = lane >> 5, l15 = lane & 15, q4 = lane >> 4;
    float* bub = (float*)lds;
    unsigned char* s16 = lds + 65536;
    const bf16_t* proj = (const bf16_t*)(p.ws + WS_PROJ);
    bf16_t* s5y = (bf16_t*)(p.ws + WS_S5Y);
    const unsigned char* pre = p.ws + WS_S5PRE + L * S5PRE_LAYER;
    const float2* lbp = (const float2*)pre;
    const bf16_t* bb16 = (const bf16_t*)(pre + 16384);
    const bf16_t* cm16 = (const bf16_t*)(pre + 16384 + 131072);
    for (int it = blockIdx.x; it < NB * 32; it += gridDim.x) {
        const int b = it >> 5, g = it & 31;
        const size_t m0 = (size_t)b * SEQ;
        float2 lb = make_float2(0.f, 0.f); float sr = 0.f, si = 0.f;
        bf16x8 bfa, bfa7, cm[4]; float dsk = 0.f;
        const int a_tb = wave & 1, a_pb = wave >> 1;
        float l2r = 0.f, l2i = 0.f, l3r = 0.f, l3i = 0.f, l4r = 0.f, l4i = 0.f;
        if (wave == 7) {
            lb = lbp[g * 64 + lane];
            l2r = lb.x * lb.x - lb.y * lb.y; l2i = 2.f * lb.x * lb.y;
            l3r = l2r * lb.x - l2i * lb.y; l3i = l2r * lb.y + l2i * lb.x;
            l4r = l2r * l2r - l2i * l2i; l4i = 2.f * l2r * l2i;
        }
        else {
            bfa = *(const bf16x8*)(bb16 + ((size_t)(g * 128 + 32 * a_pb + r32)) * 16 + 8 * hi);
            if (wave == 0) bfa7 = *(const bf16x8*)(bb16 + ((size_t)(g * 128 + 32 * 3 + r32)) * 16 + 8 * hi);
            if (wave < 4) {
#pragma unroll
                for (int ks = 0; ks < 4; ++ks) cm[ks] = *(const bf16x8*)(cm16 + ((size_t)(g * 16 + l15)) * 128 + 32 * ks + 8 * q4);
                dsk = p.in[11][((size_t)L * 32 + g) * 16 + l15];
            }
        }
        const bf16_t* urow = proj + (m0 + 32 * a_tb + r32) * NP + C_U + g * 16 + 8 * hi;
        const bf16_t* urow7 = proj + (m0 + 32 + r32) * NP + C_U + g * 16 + 8 * hi;
        const bf16_t* yrow = proj + (m0 + 16 * wave + 4 * q4) * NP + C_U + g * 16 + l15;
        bf16x8 af0, af1, af70, af71; bf16_t uy0[4], uy1[4];
        af0 = af1 = af70 = af71 = (bf16x8){0, 0, 0, 0, 0, 0, 0, 0};
#pragma unroll
        for (int r = 0; r < 4; ++r) { uy0[r] = 0; uy1[r] = 0; }
        if (wave != 7) {
            af0 = *(const bf16x8*)(urow); af1 = *(const bf16x8*)(urow + (size_t)64 * NP);
            if (wave == 0) { af70 = *(const bf16x8*)(urow7); af71 = *(const bf16x8*)(urow7 + (size_t)64 * NP); }
            if (wave < 4) {
#pragma unroll
                for (int r = 0; r < 4; ++r) { uy0[r] = yrow[(size_t)r * NP]; uy1[r] = yrow[(size_t)(64 + r) * NP]; }
            }
        }
        __syncthreads();
#pragma unroll 1
        for (int c = -1; c <= SEQ / 64; ++c) {
            if (wave == 7) {
                if (c >= 0 && c < SEQ / 64) {
                    const float2* bc = (const float2*)(bub + (c & 1) * 8192);
                    unsigned* sc = (unsigned*)(s16 + (c & 1) * 17408);
#define S5_CFMA(ar, ai, xr, xi, yr, yi, outr, outi) do { outr = fmaf(ar, xr, fmaf(-(ai), xi, yr)); outi = fmaf(ar, xi, fmaf(ai, xr, yi)); } while (0)
#pragma unroll 1
                    for (int tb = 0; tb < 4; ++tb) {
                        float2 bu[16];
#pragma unroll
                        for (int i = 0; i < 16; ++i) bu[i] = bc[(tb * 16 + i) * 64 + lane];
#pragma unroll
                        for (int q = 0; q < 4; ++q) {
                            float c2r, c2i, c3r, c3i, c4r, c4i, s1r, s1i, s2r, s2i, s3r, s3i, s4r, s4i;
                            S5_CFMA(lb.x, lb.y, bu[4 * q].x, bu[4 * q].y, bu[4 * q + 1].x, bu[4 * q + 1].y, c2r, c2i);
                            S5_CFMA(lb.x, lb.y, c2r, c2i, bu[4 * q + 2].x, bu[4 * q + 2].y, c3r, c3i);
                            S5_CFMA(lb.x, lb.y, c3r, c3i, bu[4 * q + 3].x, bu[4 * q + 3].y, c4r, c4i);
                            S5_CFMA(lb.x, lb.y, sr, si, bu[4 * q].x, bu[4 * q].y, s1r, s1i);
                            S5_CFMA(l2r, l2i, sr, si, c2r, c2i, s2r, s2i);
                            S5_CFMA(l3r, l3i, sr, si, c3r, c3i, s3r, s3i);
                            S5_CFMA(l4r, l4i, sr, si, c4r, c4i, s4r, s4i);
                            sc[(tb * 16 + 4 * q) * 68 + lane] = pg8::cvt_pk_bf16(s1r, s1i);
                            sc[(tb * 16 + 4 * q + 1) * 68 + lane] = pg8::cvt_pk_bf16(s2r, s2i);
                            sc[(tb * 16 + 4 * q + 2) * 68 + lane] = pg8::cvt_pk_bf16(s3r, s3i);
                            sc[(tb * 16 + 4 * q + 3) * 68 + lane] = pg8::cvt_pk_bf16(s4r, s4i);
                            sr = s4r; si = s4i;
                        }
                    }
#undef S5_CFMA
                }
            } else {
                if (c + 1 < SEQ / 64) {
                    const int cc = c + 1;
                    float* bw = bub + (cc & 1) * 8192;
                    {
                        att::f32x16 d;
#pragma unroll
                        for (int r = 0; r < 16; ++r) d[r] = 0.f;
                        d = __builtin_amdgcn_mfma_f32_32x32x16_bf16(af0, bfa, d, 0, 0, 0);
#pragma unroll
                        for (int r = 0; r < 16; ++r) bw[(32 * a_tb + att::crow(r, hi)) * 128 + 32 * a_pb + r32] = d[r];
                    }
                    if (wave == 0) {
                        att::f32x16 d;
#pragma unroll
                        for (int r = 0; r < 16; ++r) d[r] = 0.f;
                        d = __builtin_amdgcn_mfma_f32_32x32x16_bf16(af70, bfa7, d, 0, 0, 0);
#pragma unroll
                        for (int r = 0; r < 16; ++r) bw[(32 + att::crow(r, hi)) * 128 + 96 + r32] = d[r];
                    }
                    af0 = af1; af70 = af71;
                    if (cc + 2 < SEQ / 64) {
                        af1 = *(const bf16x8*)(urow + (size_t)(64 * (cc + 2)) * NP);
                        if (wave == 0) af71 = *(const bf16x8*)(urow7 + (size_t)(64 * (cc + 2)) * NP);
                    }
                }
                if (c >= 1 && wave < 4) {
                    const int cc = c - 1;
                    const unsigned char* sb = s16 + (cc & 1) * 17408;
                    f32x4 acc = (f32x4){0.f, 0.f, 0.f, 0.f};
#pragma unroll
                    for (int ks = 0; ks < 4; ++ks) {
                        const bf16x8 af = *(const bf16x8*)(sb + (16 * wave + l15) * 272 + 64 * ks + 16 * q4);
                        acc = __builtin_amdgcn_mfma_f32_16x16x32_bf16(af, cm[ks], acc, 0, 0, 0);
                    }
#pragma unroll
                    for (int r = 0; r < 4; ++r) {
                        const size_t m = m0 + 64 * cc + 16 * wave + 4 * q4 + r;
                        s5y[m * 512 + g * 16 + l15] = (bf16_t)f2bf(gelu_tanh(acc[r] + dsk * bf2f(uy0[r])));
                    }
#pragma unroll
                    for (int r = 0; r < 4; ++r) { uy0[r] = uy1[r]; if (cc + 2 < SEQ / 64) uy1[r] = yrow[(size_t)(64 * (cc + 2) + r) * NP]; }
                }
            }
            __syncthreads();
        }
    }
}

struct OneUnit {
    pg8::Unit u;
    __device__ __forceinline__ bool next(int i, pg8::Unit& o) const { if (i) return false; o = u; return true; }
    __device__ __forceinline__ void a_ready(const pg8::Unit&) const {}
    __device__ __forceinline__ void done(const pg8::Unit&) const {}
};
constexpr int P3_NSA = NB * 32, P3_DIFF = NB * 4 * 16, P3_RET = NB * 4 * 8, P3_GLU = (MTOK / 256) * 2, P3_ITEMS = P3_NSA + P3_DIFF + P3_RET + P3_GLU;
__device__ __forceinline__ int p3_key(int e) {
    int c;
    if (e < P3_NSA) c = 4 * ((31 - (e & 31)) + 9);
    else if (e < P3_NSA + P3_DIFF) c = 3 * (2 * (15 - ((e - P3_NSA) & 15)) + 2);
    else if (e < P3_NSA + P3_DIFF + P3_RET) c = 4 * (4 * (7 - ((e - P3_NSA - P3_DIFF) & 7)) + 4);
    else c = 8;
    return c * 1024 + e;
}
__device__ void phase_p3(const Params& p, unsigned char* lds, int L) {
    const int tid = opaque_tid(), lane = tid & 63;
    unsigned short* order = (unsigned short*)(lds + 131072 + 64);
    volatile int* slot = (volatile int*)(lds + 131072 + 48);
    int* keys = (int*)lds;
    for (int e = tid; e < P3_ITEMS; e += NTHREADS) keys[e] = p3_key(e);
    __syncthreads();
    for (int e = tid; e < P3_ITEMS; e += NTHREADS) {
        const int ke = keys[e]; int rank = 0;
#pragma unroll 8
        for (int f = 0; f < P3_ITEMS; ++f) rank += keys[f] > ke ? 1 : 0;
        order[rank] = (unsigned short)e;
    }
    const float* lamw = (const float*)(p.ws + WS_LAM) + 2 * L;
    unsigned* qctr = (unsigned*)(p.ws + WS_QUEUE) + L * 64;
    __syncthreads();
    for (;;) {
        if (tid == 0) *slot = (int)atomicAdd(qctr, 1u);
        __syncthreads();
        const int q = *slot;
        __syncthreads();
        if (q >= P3_ITEMS) break;
        const int e = order[q];
        if (e < P3_NSA) nsa_unit(p, lds, e);
        else if (e < P3_NSA + P3_DIFF) diff_unit(p, lds, e - P3_NSA, lamw[0], lamw[1]);
        else if (e < P3_NSA + P3_DIFF + P3_RET) ret_unit(p, lds, e - P3_NSA - P3_DIFF);
        else {
            const int g = e - P3_NSA - P3_DIFF - P3_RET;
            pg8::Gemm gm{(const bf16_t*)(p.ws + WS_S5Y), (const bf16_t*)(p.ws + WS_WGLU + (size_t)L * 512 * 512 * 2), MTOK, 512, 512};
            OneUnit S{pg8::Unit{g >> 1, g & 1}};
            EpiGlu E{(const bf16_t*)(p.ws + WS_S5Y), (bf16_t*)(p.ws + WS_MIXED)};
            pg8::gemm_phase<EpiGlu, OneUnit, true, true>((PG8_LAS unsigned char*)lds, gm, S, E);
            __syncthreads();
        }
    }
    if (L == 0) conv_fill(p, lds, CONV_B_BLK);
}

#define LAS __attribute__((address_space(3)))
#define XB_TMO      128
#define XB_XCNT(j)  (256  + 64 * (j))
#define XB_XSUB(j)  (1280 + 64 * (j))
#define XB_XGEN(j)  (2304 + 64 * (j))
#define XB_TOP      3328
#define XB_TOPGEN   3392
#define XCD_BAR_WORDS 3456
#define XB_SPIN_CAP (1u << 18)

__device__ __forceinline__ unsigned xb_ld(unsigned* p)              { return __hip_atomic_load(p, __ATOMIC_RELAXED, __HIP_MEMORY_SCOPE_AGENT); }
__device__ __forceinline__ unsigned xb_add(unsigned* p, unsigned v) { return __hip_atomic_fetch_add(p, v, __ATOMIC_RELAXED, __HIP_MEMORY_SCOPE_AGENT); }
__device__ __forceinline__ unsigned xb_xcc_id() { return (unsigned)__builtin_amdgcn_s_getreg((3 << 11) | 20) & 0xFu; }
#define XB_SPIN(cond, bar) do { unsigned _sp = 0; while (cond) { __builtin_amdgcn_s_sleep(1); \
    if ((++_sp & 255u) == 0u) { if (xb_ld(&(bar)[XB_TMO])) break; if (_sp > XB_SPIN_CAP) { atomicAdd(&(bar)[XB_TMO], 1u); break; } } } } while (0)

struct XcdBarrier {
    unsigned* bar; unsigned x;
    volatile LAS unsigned* st;
};

__device__ __forceinline__ XcdBarrier xcd_barrier_post(unsigned* bar, volatile LAS unsigned* st) {
    XcdBarrier b; b.bar = bar; b.x = xb_xcc_id(); b.st = st;
    if (threadIdx.x == 0) (void)xb_add(&bar[XB_XCNT(b.x)], 1u);
    return b;
}
__device__ __forceinline__ void xcd_barrier_complete(unsigned* bar, unsigned x, unsigned& nloc, unsigned& nx) {
    const unsigned G = gridDim.x * gridDim.y * gridDim.z;
    unsigned sum, cnt, mine, sp = 0u;
    for (;;) {
        sum = 0u; cnt = 0u; mine = 0u;
#pragma unroll
        for (unsigned j = 0; j < 16; ++j) { const unsigned c = xb_ld(&bar[XB_XCNT(j)]); sum += c; cnt += (c > 0u) ? 1u : 0u; mine = (j == x) ? c : mine; }
        if (sum == G) break;
        __builtin_amdgcn_s_sleep(1);
        if ((++sp & 255u) == 0u) { if (xb_ld(&bar[XB_TMO])) break; if (sp > XB_SPIN_CAP) { atomicAdd(&bar[XB_TMO], 1u); break; } }
    }
    nloc = mine > 0u ? mine : 1u; nx = cnt > 0u ? cnt : 1u;
}

__device__ __forceinline__ void xcd_barrier(const XcdBarrier& b) {
    asm volatile("s_waitcnt vmcnt(0)" ::: "memory");
    __syncthreads();
    if (threadIdx.x == 0) {
        unsigned* bar = b.bar;
        __builtin_amdgcn_s_waitcnt(0);
        unsigned nloc = b.st[0], nx = b.st[1];
        if (nloc == 0u) { xcd_barrier_complete(bar, b.x, nloc, nx); b.st[0] = nloc; b.st[1] = nx; }
        const unsigned old = xb_add(&bar[XB_XSUB(b.x)], 1u);
        const unsigned gen = old / nloc;
        if (old + 1u == (gen + 1u) * nloc) {
            __builtin_amdgcn_fence(__ATOMIC_RELEASE, "agent");
            asm volatile("s_waitcnt vmcnt(0)" ::: "memory");
            const unsigned og = xb_add(&bar[XB_TOP], 1u);
            const unsigned tg = og / nx;
            if (og + 1u == (tg + 1u) * nx) xb_add(&bar[XB_TOPGEN], 1u);
            else XB_SPIN(xb_ld(&bar[XB_TOPGEN]) == tg, bar);
            __builtin_amdgcn_fence(__ATOMIC_ACQUIRE, "agent");
            xb_add(&bar[XB_XGEN(b.x)], 1u);
            asm volatile("s_waitcnt vmcnt(0)" ::: "memory");
        } else {
            XB_SPIN(xb_ld(&bar[XB_XGEN(b.x)]) == gen, bar);
            __builtin_amdgcn_fence(__ATOMIC_ACQUIRE, "agent");
            asm volatile("s_waitcnt vmcnt(0)" ::: "memory");
        }
    }
    __syncthreads();
}

__global__ void __launch_bounds__(NTHREADS, 2) fwd_megakernel(Params p) {
    extern __shared__ __attribute__((aligned(16))) unsigned char lds[];
    cg::grid_group grid = cg::this_grid();
    unsigned char* ws = p.ws;
    bf16_t* xb = (bf16_t*)(ws + WS_XB);
    bf16_t* proj = (bf16_t*)(ws + WS_PROJ);
    bf16_t* mixed = (bf16_t*)(ws + WS_MIXED);
    bf16_t* hid = (bf16_t*)(ws + WS_HID);
    float* sumsq = (float*)(ws + WS_SUMSQ);

    volatile LAS unsigned* misc = (volatile LAS unsigned*)((LAS unsigned char*)lds + 131072);
    if (threadIdx.x < 16) misc[threadIdx.x] = 0u;
    __syncthreads();
    XcdBarrier bar = xcd_barrier_post((unsigned*)(ws + WS_BAR), misc + 8);
    phase_prologue(p, lds);
    grid.sync();
#pragma unroll 1
    for (int L = 0; L < DEPTH; ++L) {
        const float* xin = (L == 0) ? p.in[0] : p.out;
        float* ss1 = sumsq + (2 * L) * MTOK;
        float* ss2 = sumsq + (2 * L + 1) * MTOK;
        float* ss3 = (L + 1 < DEPTH) ? sumsq + (2 * L + 2) * MTOK : nullptr;
        run_gemm(lds, xb, (const bf16_t*)(ws + WS_WIN + L * WIN_LAYER), MTOK, NP, DM, EpiScale{proj, NP, ss1, 0});
        xcd_barrier(bar);
        phase_prep(p);
        phase_cmp_mfma(p, lds, L);
        phase_s5v2(p, lds, L);
        if (L == 0 && blockIdx.x >= NB * 32) conv_fill(p, lds, 3);
        xcd_barrier(bar);
        phase_p3(p, lds, L);
        xcd_barrier(bar);
        run_gemm(lds, mixed, (const bf16_t*)(ws + WS_WOUT + L * WOUT_LAYER), MTOK, DM, DM, EpiResid{xin, p.out, xb, ss2});
        xcd_barrier(bar);
        run_gemm(lds, xb, (const bf16_t*)(ws + WS_W1 + L * W1_LAYER), MTOK, DFF, DM, EpiScale{hid, DFF, ss2, 1});
        xcd_barrier(bar);
        run_gemm(lds, hid, (const bf16_t*)(ws + WS_W2 + L * W2_LAYER), MTOK, DM, DFF, EpiResid{p.out, p.out, (L + 1 < DEPTH) ? xb : nullptr, ss3});
        if (L + 1 < DEPTH) xcd_barrier(bar);
    }
}

extern "C" void kernel_launch(void* const* d_in, const int* in_sizes, int n_in, void* d_out, int out_size, void* d_ws, size_t ws_size, hipStream_t stream) {
    static int grid = 0;
    if (grid == 0) {
        if (n_in != 25 || out_size != MTOK * DM || ws_size < WS_END) { fprintf(stderr, "kernel_launch: unexpected problem (n_in %d out %d ws %zu)\n", n_in, out_size, ws_size); grid = -1; return; }
        int dev = 0, cus = 0, per_cu = 0;
        (void)hipGetDevice(&dev);
        (void)hipDeviceGetAttribute(&cus, hipDeviceAttributeMultiprocessorCount, dev);
        (void)hipFuncSetAttribute((const void*)fwd_megakernel, hipFuncAttributeMaxDynamicSharedMemorySize, LDS_BYTES);
        (void)hipOccupancyMaxActiveBlocksPerMultiprocessor(&per_cu, (const void*)fwd_megakernel, NTHREADS, LDS_BYTES);
        if (per_cu < 1) { fprintf(stderr, "kernel_launch: occupancy query says %d blocks/CU\n", per_cu); grid = -1; return; }
        grid = cus;
    }
    if (grid < 0) return;
    (void)hipMemsetAsync((char*)d_ws + WS_CTL, 0, CTL_BYTES, stream);
    Params p{};
    for (int i = 0; i < 25; ++i) p.in[i] = (const float*)d_in[i];
    p.out = (float*)d_out; p.ws = (unsigned char*)d_ws;
    for (int j = 0; j < 64; ++j) p.inv128[j] = (float)pow(10000.0, -(double)(2 * j) / 128.0);
    for (int j = 0; j < 32; ++j) p.inv64[j] = (float)pow(10000.0, -(double)(2 * j) / 64.0);
    void* args[] = {&p};
    hipError_t e = hipLaunchCooperativeKernel((const void*)fwd_megakernel, dim3(grid), dim3(NTHREADS), args, LDS_BYTES, stream);
    if (e != hipSuccess) fprintf(stderr, "cooperative launch failed: %s (grid %d)\n", hipGetErrorString(e), grid);
}
```

```cpp
#include <hip/hip_runtime.h>
#include <hip/hip_cooperative_groups.h>
#include <cstdio>
#include <cstdint>
#include <cmath>
namespace cg = cooperative_groups;

typedef unsigned short bf16_t;
typedef short bf16x8 __attribute__((ext_vector_type(8)));
typedef float f32x4 __attribute__((ext_vector_type(4)));
typedef unsigned u32x2 __attribute__((ext_vector_type(2)));
typedef unsigned u32x4 __attribute__((ext_vector_type(4)));

constexpr int DM = 2048, NB = 4, SEQ = 2048, DEPTH = 2, MTOK = NB * SEQ;
constexpr int DFF = 8192, NIN = 5388, NP = 5632;
constexpr float EPS = 1e-6f;
constexpr int C_U = 0, C_RQ = 512, C_RK = 1024, C_RV = 1536, C_RG = 2048, C_NQ = 2560, C_NKC = 3072, C_NVC = 3200, C_NKS = 3328, C_NVS = 3456,
              C_NKW = 3584, C_NVW = 3712, C_DQ = 3840, C_DK = 4352, C_DV = 4864, C_GATE = 5376;
__host__ __device__ inline int orig_col(int c) { if (c < 3840) return c; if (c < 5376) return c + 12; if (c < 5388) return 3840 + (c - 5376); return -1; }

constexpr size_t MiB = 1u << 20;
constexpr size_t WS_CTL = 0, CTL_BYTES = 1 * MiB;
constexpr size_t WS_QUEUE = 8 * 1024;
constexpr size_t WS_CMPCNT = 10 * 1024;
constexpr size_t WS_LAM = 12 * 1024;
constexpr size_t WS_BAR = 16 * 1024;
constexpr size_t WS_SUMSQ = 64 * 1024;
constexpr size_t WS_ROPE128 = 1 * MiB;
constexpr size_t WS_ROPE64 = 5 * MiB;
constexpr size_t WS_S5PRE = 7 * MiB;
constexpr size_t S5PRE_LAYER = 32 * 64 * 8 + 32 * 64 * 16 * 8;
constexpr size_t WS_KVCMP = 8 * MiB;
constexpr size_t WS_KVCMPB = 9 * MiB;
constexpr size_t WS_WGLU = 10 * MiB;
constexpr size_t WS_WIN = 12 * MiB, WIN_LAYER = (size_t)NP * DM * 2;
constexpr size_t WS_WOUT = 56 * MiB, WOUT_LAYER = (size_t)DM * DM * 2;
constexpr size_t WS_W1 = 72 * MiB, W1_LAYER = (size_t)DFF * DM * 2;
constexpr size_t WS_W2 = 136 * MiB, W2_LAYER = (size_t)DM * DFF * 2;
constexpr size_t WS_XB = 200 * MiB;
constexpr size_t WS_MIXED = 232 * MiB;
constexpr size_t WS_S5Y = 264 * MiB;
constexpr size_t WS_HID = 272 * MiB;
constexpr size_t WS_PROJ = 272 * MiB;
constexpr size_t WS_WCMP = 400 * MiB;
constexpr size_t WS_KPART = 404 * MiB;
constexpr size_t WS_END = 406 * MiB;

constexpr int NTHREADS = 512, NWAVES = 8;
constexpr int LDS_BYTES = 147456;

struct Params {
    const float* in[25];
    float* out;
    unsigned char* ws;
    float inv128[64];
    float inv64[32];
};

__device__ __forceinline__ float bf2f(bf16_t v) { return __uint_as_float((unsigned)v << 16); }
__device__ __forceinline__ unsigned f2bf(float f) { unsigned u = __float_as_uint(f); return (u + 0x7fffu + ((u >> 16) & 1u)) >> 16; }
__device__ __forceinline__ unsigned pk2(float lo, float hi) { return f2bf(lo) | (f2bf(hi) << 16); }
__device__ __forceinline__ float shx(float v, int o, int lane) { return __int_as_float(__builtin_amdgcn_ds_bpermute((lane ^ o) << 2, __float_as_int(v))); }
__device__ __forceinline__ float shl(float v, int src, int lane) { (void)lane; return __int_as_float(__builtin_amdgcn_ds_bpermute(src << 2, __float_as_int(v))); }
__device__ __forceinline__ float wave_sum(float v, int lane) {
#pragma unroll
    for (int o = 1; o < 64; o <<= 1) v += shx(v, o, lane);
    return v;
}
__device__ __forceinline__ float wave_max(float v, int lane) {
#pragma unroll
    for (int o = 1; o < 64; o <<= 1) v = fmaxf(v, shx(v, o, lane));
    return v;
}
__device__ __forceinline__ float half_sum(float v) { auto r = __builtin_amdgcn_permlane32_swap(__float_as_uint(v), __float_as_uint(v), false, false); return __uint_as_float(r[0]) + __uint_as_float(r[1]); }
__device__ __forceinline__ float half_max(float v) { auto r = __builtin_amdgcn_permlane32_swap(__float_as_uint(v), __float_as_uint(v), false, false); return fmaxf(__uint_as_float(r[0]), __uint_as_float(r[1])); }
#define LDS_WAIT() asm volatile("s_waitcnt lgkmcnt(0)" ::: "memory")
__device__ __forceinline__ int opaque_tid() { int t = (int)threadIdx.x; asm volatile("" : "+v"(t)); return t; }

__device__ __forceinline__ void transpose_item(const float* W, int K, int N, const float* gk, bf16_t* WT, bool winmap, float* scr, int item, int nblk, int lane) {
    const int kb = item / nblk, nb = item % nblk, k0 = 64 * kb, n0 = 32 * nb;
    const int c4 = (lane & 7) * 4, rr = lane >> 3;
    const int oc = winmap ? orig_col(n0 + c4) : n0 + c4;
    f32x4 v[8];
#pragma unroll
    for (int i = 0; i < 8; ++i) v[i] = (oc >= 0) ? *(const f32x4*)(W + (size_t)(k0 + 8 * i + rr) * N + oc) : (f32x4){0.f, 0.f, 0.f, 0.f};
#pragma unroll
    for (int i = 0; i < 8; ++i) {
        const int kk = 8 * i + rr;
        f32x4 t = v[i];
        if (gk) t = t * gk[k0 + kk];
        float* d = scr + kk * 33 + c4;
        d[0] = t.x; d[1] = t.y; d[2] = t.z; d[3] = t.w;
    }
    LDS_WAIT();
    const int c = lane & 7;
#pragma unroll
    for (int j = 0; j < 4; ++j) {
        const int nn = (lane >> 3) + 8 * j;
        const float* s = scr + (8 * c) * 33 + nn;
        u32x4 o;
        o.x = pk2(s[0 * 33], s[1 * 33]); o.y = pk2(s[2 * 33], s[3 * 33]); o.z = pk2(s[4 * 33], s[5 * 33]); o.w = pk2(s[6 * 33], s[7 * 33]);
        *(u32x4*)(WT + (size_t)(n0 + nn) * K + k0 + 8 * c) = o;
    }
    LDS_WAIT();
}

constexpr int I_IN = (DM / 64) * (NP / 32), I_OUT = (DM / 64) * (DM / 32), I_1 = (DM / 64) * (DFF / 32), I_2 = (DFF / 64) * (DM / 32), I_G = (512 / 64) * (512 / 32), I_C = (4096 / 64) * (128 / 32);
constexpr int I_LAYER = I_IN + I_OUT + I_1 + I_2 + I_G + 2 * I_C;
__device__ __forceinline__ void conv_wave_item(const Params& p, float* scr, int L, int r, int lane) {
    unsigned char* ws = p.ws;
    if (r < I_IN) { transpose_item(p.in[3] + (size_t)L * DM * NIN, DM, NIN, p.in[2] + L * DM, (bf16_t*)(ws + WS_WIN + L * WIN_LAYER), true, scr, r, NP / 32, lane); return; } r -= I_IN;
    if (r < I_OUT) { transpose_item(p.in[21] + (size_t)L * DM * DM, DM, DM, nullptr, (bf16_t*)(ws + WS_WOUT + L * WOUT_LAYER), false, scr, r, DM / 32, lane); return; } r -= I_OUT;
    if (r < I_1) { transpose_item(p.in[23] + (size_t)L * DM * DFF, DM, DFF, p.in[22] + L * DM, (bf16_t*)(ws + WS_W1 + L * W1_LAYER), false, scr, r, DFF / 32, lane); return; } r -= I_1;
    if (r < I_2) { transpose_item(p.in[24] + (size_t)L * DFF * DM, DFF, DM, nullptr, (bf16_t*)(ws + WS_W2 + L * W2_LAYER), false, scr, r, DM / 32, lane); return; } r -= I_2;
    if (r < I_G) { transpose_item(p.in[12] + (size_t)L * 512 * 512, 512, 512, nullptr, (bf16_t*)(ws + WS_WGLU + (size_t)L * 512 * 512 * 2), false, scr, r, 512 / 32, lane); return; } r -= I_G;
    { const int kv = r / I_C; r -= kv * I_C;
      transpose_item(p.in[15 + kv] + (size_t)L * 4096 * 128, 4096, 128, nullptr, (bf16_t*)(ws + WS_WCMP) + ((size_t)(L * 2 + kv)) * 128 * 4096, false, scr, r, 128 / 32, lane); }
}
constexpr int CONV_A = I_IN + I_G + 2 * I_C, CONV_B0 = I_OUT + I_1 + I_2, CONV_B = CONV_B0 + I_LAYER;
constexpr int CONV_A_BLK = CONV_A / 32, CONV_B_BLK = CONV_B / 32;
static_assert(CONV_A % 32 == 0 && CONV_B % 32 == 0, "conversion block-items");
__device__ __forceinline__ void conv_block_item(const Params& p, unsigned char* lds, int blk, int tid) {
    const int lane = tid & 63, wave = tid >> 6;
    float* scr = (float*)(lds + wave * 8448);
#pragma unroll 1
    for (int i = 0; i < 4; ++i) {
        int L = 0, r;
        if (blk < CONV_A_BLK) {
            const int a = blk * 32 + i * 8 + wave;
            r = a < I_IN ? a : (a < I_IN + I_G ? I_IN + I_OUT + I_1 + I_2 + (a - I_IN) : I_IN + I_OUT + I_1 + I_2 + I_G + (a - I_IN - I_G));
        } else {
            const int bidx = (blk - CONV_A_BLK) * 32 + i * 8 + wave;
            if (bidx < CONV_B0) r = I_IN + bidx; else { L = 1; r = bidx - CONV_B0; }
        }
        conv_wave_item(p, scr, L, r, lane);
    }
}
__device__ __forceinline__ void conv_fill(const Params& p, unsigned char* lds, int max_items) {
    const int tid = opaque_tid();
    volatile int* slot = (volatile int*)(lds + 131072 + 60);
    unsigned* qc = (unsigned*)(p.ws + WS_QUEUE) + 2 * 64;
    for (int n = 0; n < max_items; ++n) {
        if (tid == 0) *slot = (int)atomicAdd(qc, 1u);
        __syncthreads();
        const int q = *slot;
        __syncthreads();
        if (q >= CONV_B_BLK) break;
        conv_block_item(p, lds, CONV_A_BLK + q, tid);
    }
    __syncthreads();
}

__device__ void phase_prologue(const Params& p, unsigned char* lds) {
    const int tid = opaque_tid(), lane = tid & 63, wave = tid >> 6;
    const int gw = blockIdx.x * NWAVES + wave, NGW = gridDim.x * NWAVES;
    unsigned char* ws = p.ws;
    for (int blk = blockIdx.x; blk < CONV_A_BLK; blk += gridDim.x) conv_block_item(p, lds, blk, tid);
    if (blockIdx.x == gridDim.x - 1 && wave == 0) {
        for (int L = 0; L < DEPTH; ++L) {
            const float lam_init = 0.8f - 0.6f * expf(-0.3f * (float)L);
            const float a = p.in[17][L * 64 + lane] * p.in[18][L * 64 + lane];
            const float c = p.in[19][L * 64 + lane] * p.in[20][L * 64 + lane];
            const float lamv = expf(wave_sum(a, lane)) - expf(wave_sum(c, lane)) + lam_init;
            if (lane == 0) { float* lw = (float*)(ws + WS_LAM) + 2 * L; lw[0] = lamv; lw[1] = lam_init; }
        }
    }
    const float* x = p.in[0];
    bf16_t* xb = (bf16_t*)(ws + WS_XB);
    float* sumsq = (float*)(ws + WS_SUMSQ);
    const int* pos = (const int*)p.in[1];
    float2* r128 = (float2*)(ws + WS_ROPE128);
    float2* r64 = (float2*)(ws + WS_ROPE64);
    for (int m = gw; m < MTOK; m += NGW) {
        const f32x4* xr = (const f32x4*)(x + (size_t)m * DM);
        float ss = 0.f;
#pragma unroll
        for (int j = 0; j < 8; ++j) {
            const f32x4 v = xr[64 * j + lane];
            ss += v.x * v.x + v.y * v.y + v.z * v.z + v.w * v.w;
            u32x2 o; o.x = pk2(v.x, v.y); o.y = pk2(v.z, v.w);
            *(u32x2*)(xb + (size_t)m * DM + 4 * (64 * j + lane)) = o;
        }
        ss = wave_sum(ss, lane);
        if (lane == 0) sumsq[m] = ss;
        const float fp = (float)pos[m];
        { const float ang = fp * p.inv128[lane]; float s, c; sincosf(ang, &s, &c); r128[(size_t)m * 64 + lane] = make_float2(c, s); }
        if (lane < 32) { const float ang = fp * p.inv64[lane]; float s, c; sincosf(ang, &s, &c); r64[(size_t)m * 32 + lane] = make_float2(c, s); }
    }
    for (int it = blockIdx.x * NTHREADS + tid; it < DEPTH * 32 * 64; it += gridDim.x * NTHREADS) {
        const int L = it / (32 * 64), gp = it % (32 * 64), g = gp / 64;
        const float lr = p.in[4][(size_t)L * 2048 + gp], li = p.in[5][(size_t)L * 2048 + gp];
        const float dt = expf(p.in[6][L * 32 + g]);
        const float mag = expf(lr * dt);
        float sn, cs; sincosf(li * dt, &sn, &cs);
        const float lbr = mag * cs, lbi = mag * sn;
        const float den = lr * lr + li * li;
        const float fr = ((lbr - 1.0f) * lr + lbi * li) / den;
        const float fi = (lbi * lr - (lbr - 1.0f) * li) / den;
        unsigned char* pre = ws + WS_S5PRE + L * S5PRE_LAYER;
        float2* lb = (float2*)pre;
        bf16_t* bb16 = (bf16_t*)(pre + 16384);
        bf16_t* cm16 = (bf16_t*)(pre + 16384 + 131072);
        lb[gp] = make_float2(lbr, lbi);
        const int pst = gp & 63;
        const float* bre = p.in[7] + ((size_t)L * 2048 + gp) * 16;
        const float* bim = p.in[8] + ((size_t)L * 2048 + gp) * 16;
#pragma unroll
        for (int h = 0; h < 16; ++h) {
            bb16[((size_t)(g * 128 + 2 * pst)) * 16 + h] = (bf16_t)f2bf(fr * bre[h] - fi * bim[h]);
            bb16[((size_t)(g * 128 + 2 * pst + 1)) * 16 + h] = (bf16_t)f2bf(fr * bim[h] + fi * bre[h]);
        }
#pragma unroll
        for (int n = 0; n < 16; ++n) {
            const float cr = p.in[9][(((size_t)L * 32 + g) * 16 + n) * 64 + pst], ci = p.in[10][(((size_t)L * 32 + g) * 16 + n) * 64 + pst];
            *(unsigned*)(cm16 + ((size_t)(g * 16 + n)) * 128 + 2 * pst) = pk2(cr, -ci);
        }
    }
}

namespace pg8 {
#define PG8_LAS __attribute__((address_space(3)))
typedef unsigned short bf16_t;
typedef short bf16x8 __attribute__((ext_vector_type(8)));
typedef float f32x4 __attribute__((ext_vector_type(4)));
typedef unsigned u32x4 __attribute__((ext_vector_type(4)));
constexpr int BM = 256, BK = 64, HALF = 128, HTB = HALF * BK * 2  , STAGE_BYTES = 8 * HTB, NXCD = 8, WGM = 8;

__host__ __device__ __forceinline__ int lds_byte(int r, int c) { const int st = (r >> 4) * 2 + (c >> 5), rr = r & 15, cc = c & 31, ob = rr * 64 + cc * 2; return st * 1024 + (ob ^ (((ob >> 9) & 1) << 5)); }
__host__ __device__ __forceinline__ void stage_rc(int b, int& R, int& C) { const int st = b / 1024, sb = b % 1024, swz = sb ^ (((sb >> 9) & 1) << 5); R = (st >> 1) * 16 + swz / 64; C = (st & 1) * 32 + (swz % 64) / 2; }
__host__ __device__ __forceinline__ int perm32(int rho) { const int n = rho >> 4, i = rho & 15; return 8 * (i >> 2) + 4 * n + (i & 3); }

struct Unit { int pm, pn; };
struct Gemm { const bf16_t* A; const bf16_t* Bt; int M, N, K; };

struct StaticOrder {
    int nM, nN, nwg, G, c;
    __host__ __device__ void init(int M, int N, int G_, int c_) { nM = M / BM; nN = N / BM; nwg = nM * nN; G = G_; c = c_; }
    __host__ __device__ bool next(int i, Unit& u) const {
        const long L = (long)i * G + c; if (L >= nwg) return false;
        int wgid = (int)L; { const int q = nwg / NXCD, r = nwg % NXCD, xcd = wgid % NXCD, off = wgid / NXCD; wgid = (xcd < r ? xcd * (q + 1) : r * (q + 1) + (xcd - r) * q) + off; }
        const int nig = WGM * nN, gid = wgid / nig, fm = gid * WGM, gsz = (nM - fm) < WGM ? (nM - fm) : WGM;
        u.pm = fm + ((wgid % nig) % gsz); u.pn = (wgid % nig) / gsz; return true;
    }
    __device__ __forceinline__ void a_ready(const Unit&) const {}
    __device__ __forceinline__ void done(const Unit&) const {}
};

__device__ __forceinline__ unsigned cvt_pk_bf16(float lo, float hi) { unsigned r; asm volatile("v_cvt_pk_bf16_f32 %0, %1, %2" : "=v"(r) : "v"(lo), "v"(hi)); return r; }
template <class Epi, class Sched, bool ALIGN_EPI = false, bool SP2 = false>
__device__ __forceinline__ void gemm_phase(PG8_LAS unsigned char* lds, const Gemm g, const Sched& S, const Epi& E) {
    const int tid = opaque_tid(), wid = __builtin_amdgcn_readfirstlane(tid >> 6), lane = tid & 63, wr = wid >> 2, wc = wid & 3, fr = lane & 15, fq = lane >> 4;
    const int K = g.K, nt = K / BK;
    unsigned voffA[2], voffB[2];
#pragma unroll
    for (int i = 0; i < 2; ++i) { int R, C; stage_rc(tid * 16 + i * 8192, R, C); const int Rb = Epi::PERM ? ((R & ~31) + perm32(R & 31)) : R;
        voffA[i] = (unsigned)(R * K + C) * 2u; voffB[i] = (unsigned)(Rb * K + C) * 2u; }
    const size_t kstep = (size_t)(BK * 2);
    const size_t hstep = (size_t)HALF * K * 2;
    const size_t tstep = 2 * hstep;
    const unsigned ldsw = (unsigned)wid * 1024u;
    const int aoff = lds_byte(wr * 64 + fr, fq * 8), boff = lds_byte(wc * 32 + fr, fq * 8);
#define PG8_SA(b, h) (((b) * 2 + (h)) * HTB)
#define PG8_SB(b, h) ((4 + (b) * 2 + (h)) * HTB)
#define PG8_STAGE(bufoff, gbase, voff) do { _Pragma("unroll") for (int _i = 0; _i < 2; ++_i) \
        __builtin_amdgcn_global_load_lds((const unsigned*)((const char*)(gbase) + (voff)[_i]), (PG8_LAS unsigned*)(lds + (bufoff) + ldsw + _i * 8192), 16, 0, 0); } while (0)
#define PG8_LDA(dst, b, h) do { _Pragma("unroll") for (int m = 0; m < 4; ++m) _Pragma("unroll") for (int k = 0; k < 2; ++k) dst[m][k] = *(const PG8_LAS bf16x8*)(lds + PG8_SA(b, h) + aoff + m * 2048 + k * 1024); } while (0)
#define PG8_LDB(dst, b, h) do { _Pragma("unroll") for (int n = 0; n < 2; ++n) _Pragma("unroll") for (int k = 0; k < 2; ++k) dst[n][k] = *(const PG8_LAS bf16x8*)(lds + PG8_SB(b, h) + boff + n * 2048 + k * 1024); } while (0)
#define PG8_MMA(ai, bj, At, Bt) do { __builtin_amdgcn_s_setprio(1); _Pragma("unroll") for (int m = 0; m < 4; ++m) _Pragma("unroll") for (int n = 0; n < 2; ++n) _Pragma("unroll") for (int k = 0; k < 2; ++k) \
        acc[ai][bj][m][n] = __builtin_amdgcn_mfma_f32_16x16x32_bf16(Bt[n][k], At[m][k], acc[ai][bj][m][n], 0, 0, 0); __builtin_amdgcn_s_setprio(0); } while (0)
#define PG8_WAIT_V(n) asm volatile("s_waitcnt vmcnt(" #n ")" ::: "memory")
#define PG8_WAIT_L(n) asm volatile("s_waitcnt lgkmcnt(" #n ")" ::: "memory")
#define PG8_BAR __builtin_amdgcn_s_barrier()
#define PG8_SCHED __builtin_amdgcn_sched_barrier(0)
    Unit cur, nxt; int ui = 0;
    if (!S.next(0, cur)) return;
    f32x4 acc[2][2][4][2];
#pragma unroll
    for (int a = 0; a < 2; ++a)
#pragma unroll
        for (int b = 0; b < 2; ++b)
#pragma unroll
            for (int m = 0; m < 4; ++m)
#pragma unroll
                for (int n = 0; n < 2; ++n) acc[a][b][m][n] = (f32x4){0.f, 0.f, 0.f, 0.f};
    bf16x8 At[4][2], B0[2][2], B1[2][2];
    const char* cA = (const char*)g.A + (size_t)cur.pm * tstep; const char* cB = (const char*)g.Bt + (size_t)cur.pn * tstep;
    S.a_ready(cur);
    if constexpr (SP2) {
        PG8_STAGE(PG8_SB(0, 0), cB, voffB); PG8_STAGE(PG8_SB(0, 1), cB + hstep, voffB); PG8_STAGE(PG8_SA(0, 0), cA, voffA); PG8_STAGE(PG8_SA(0, 1), cA + hstep, voffA);
        if (wr == 1) PG8_BAR;
        PG8_WAIT_V(2); PG8_BAR;
        PG8_STAGE(PG8_SB(1, 0), cB + kstep, voffB); PG8_STAGE(PG8_SA(1, 0), cA + kstep, voffA); PG8_STAGE(PG8_SB(1, 1), cB + hstep + kstep, voffB);
        PG8_WAIT_V(6); PG8_BAR;
    } else {
        PG8_STAGE(PG8_SB(0, 0), cB, voffB); PG8_STAGE(PG8_SA(0, 0), cA, voffA); PG8_STAGE(PG8_SB(0, 1), cB + hstep, voffB); PG8_STAGE(PG8_SA(0, 1), cA + hstep, voffA);
        if (wr == 1) PG8_BAR;
        PG8_WAIT_V(4); PG8_BAR;
        PG8_STAGE(PG8_SB(1, 0), cB + kstep, voffB); PG8_STAGE(PG8_SA(1, 0), cA + kstep, voffA); PG8_STAGE(PG8_SB(1, 1), cB + hstep + kstep, voffB);
        PG8_WAIT_V(6); PG8_BAR;
    }
    for (;;) {
        const bool has_next = S.next(ui + 1, nxt);
        const char* nA = has_next ? (const char*)g.A + (size_t)nxt.pm * tstep : cA; const char* nB = has_next ? (const char*)g.Bt + (size_t)nxt.pn * tstep : cB;
        for (int t = 0; t < nt; t += 2) {
            const bool last = (t == nt - 2);
            const char* a1 = cA + (size_t)(t + 1) * kstep;
            const char* a2 = last ? nA : cA + (size_t)(t + 2) * kstep; const char* b2 = last ? nB : cB + (size_t)(t + 2) * kstep;
            const char* a3 = a2 + kstep; const char* b3 = b2 + kstep;
            if (last && has_next) S.a_ready(nxt);
            if constexpr (SP2) {
            PG8_LDB(B0, 0, 0); PG8_LDB(B1, 0, 1); PG8_SCHED; PG8_LDA(At, 0, 0); PG8_STAGE(PG8_SA(1, 1), a1 + hstep, voffA);
            PG8_WAIT_V(8); PG8_WAIT_L(0); PG8_BAR; PG8_MMA(0, 0, At, B0); PG8_MMA(0, 1, At, B1); PG8_BAR; PG8_SCHED;
            PG8_LDA(At, 0, 1); PG8_STAGE(PG8_SB(0, 0), b2, voffB); PG8_STAGE(PG8_SB(0, 1), b2 + hstep, voffB); PG8_STAGE(PG8_SA(0, 0), a2, voffA);
            PG8_WAIT_V(8); PG8_WAIT_L(0); PG8_BAR; PG8_MMA(1, 0, At, B0); PG8_MMA(1, 1, At, B1); PG8_BAR; PG8_SCHED;
            PG8_LDB(B0, 1, 0); PG8_LDB(B1, 1, 1); PG8_SCHED; PG8_LDA(At, 1, 0); PG8_STAGE(PG8_SA(0, 1), a2 + hstep, voffA);
            PG8_WAIT_V(8); PG8_WAIT_L(0); PG8_BAR; PG8_MMA(0, 0, At, B0); PG8_MMA(0, 1, At, B1); PG8_BAR; PG8_SCHED;
            PG8_LDA(At, 1, 1); PG8_STAGE(PG8_SB(1, 0), b3, voffB); PG8_STAGE(PG8_SB(1, 1), b3 + hstep, voffB); PG8_STAGE(PG8_SA(1, 0), a3, voffA);
            PG8_WAIT_V(8); PG8_WAIT_L(0); PG8_BAR; PG8_MMA(1, 0, At, B0); PG8_MMA(1, 1, At, B1); PG8_BAR; PG8_SCHED;
            } else {
            PG8_LDB(B0, 0, 0); PG8_SCHED; PG8_LDA(At, 0, 0); PG8_STAGE(PG8_SA(1, 1), a1 + hstep, voffA);
            PG8_WAIT_L(8); PG8_BAR; PG8_WAIT_L(0); PG8_MMA(0, 0, At, B0); PG8_BAR; PG8_SCHED;
            PG8_LDB(B1, 0, 1); PG8_STAGE(PG8_SB(0, 0), b2, voffB);
            PG8_BAR; PG8_WAIT_L(0); PG8_MMA(0, 1, At, B1); PG8_BAR;
            PG8_LDA(At, 0, 1); PG8_STAGE(PG8_SA(0, 0), a2, voffA);
            PG8_BAR; PG8_WAIT_L(0); PG8_MMA(1, 0, At, B0); PG8_BAR; PG8_SCHED;
            PG8_STAGE(PG8_SB(0, 1), b2 + hstep, voffB);
            PG8_WAIT_V(6); PG8_BAR; PG8_MMA(1, 1, At, B1); PG8_BAR;
            PG8_LDB(B0, 1, 0); PG8_SCHED; PG8_LDA(At, 1, 0); PG8_STAGE(PG8_SA(0, 1), a2 + hstep, voffA);
            PG8_WAIT_L(8); PG8_BAR; PG8_WAIT_L(0); PG8_MMA(0, 0, At, B0); PG8_BAR; PG8_SCHED;
            PG8_LDB(B1, 1, 1); PG8_STAGE(PG8_SB(1, 0), b3, voffB);
            PG8_BAR; PG8_WAIT_L(0); PG8_MMA(0, 1, At, B1); PG8_BAR;
            PG8_LDA(At, 1, 1); PG8_STAGE(PG8_SA(1, 0), a3, voffA);
            PG8_BAR; PG8_WAIT_L(0); PG8_MMA(1, 0, At, B0); PG8_BAR; PG8_SCHED;
            PG8_STAGE(PG8_SB(1, 1), b3 + hstep, voffB);
            PG8_WAIT_V(6); PG8_BAR; PG8_MMA(1, 1, At, B1); PG8_BAR;
            }
        }
        if constexpr (ALIGN_EPI) { if (wr == 0) PG8_BAR; }
        if constexpr (!Epi::AFTER_DRAIN) { E(acc, cur, wr, wc, fr, fq); S.done(cur); }
        if (!has_next) break;
#pragma unroll
        for (int a = 0; a < 2; ++a)
#pragma unroll
            for (int b = 0; b < 2; ++b)
#pragma unroll
                for (int m = 0; m < 4; ++m)
#pragma unroll
                    for (int n = 0; n < 2; ++n) acc[a][b][m][n] = (f32x4){0.f, 0.f, 0.f, 0.f};
        cur = nxt; cA = nA; cB = nB; ++ui;
        if constexpr (ALIGN_EPI) { if (wr == 1) PG8_BAR; }
    }
    PG8_WAIT_V(0);
    if constexpr (!ALIGN_EPI) { if (wr == 0) PG8_BAR; }
    PG8_BAR;
    if constexpr (Epi::AFTER_DRAIN) { E.fused(acc, cur, wr, wc, fr, fq, lds, wid, lane); S.done(cur); }
#undef PG8_SA
#undef PG8_SB
#undef PG8_STAGE
#undef PG8_LDA
#undef PG8_LDB
#undef PG8_MMA
#undef PG8_WAIT_V
#undef PG8_WAIT_L
#undef PG8_BAR
#undef PG8_SCHED
}
}

struct EpiScale {
    static constexpr bool PERM = true, AFTER_DRAIN = false;
    bf16_t* O; int ldc; const float* sumsq; int relu2;
    __device__ __forceinline__ void operator()(const f32x4 (&acc)[2][2][4][2], const pg8::Unit& u, int wr, int wc, int fr, int fq) const {
        const int row0 = u.pm * 256 + wr * 64 + fr, col0 = u.pn * 256 + wc * 32 + 8 * fq;
        float rs[2][4];
#pragma unroll
        for (int ai = 0; ai < 2; ++ai)
#pragma unroll
            for (int m = 0; m < 4; ++m) rs[ai][m] = sumsq[row0 + ai * 128 + m * 16];
#pragma unroll
        for (int ai = 0; ai < 2; ++ai)
#pragma unroll
            for (int m = 0; m < 4; ++m) {
                const int row = row0 + ai * 128 + m * 16;
                const float rstd = rsqrtf(rs[ai][m] * (1.0f / DM) + EPS);
                bf16_t* rowp = O + (size_t)row * ldc + col0;
#pragma unroll
                for (int bj = 0; bj < 2; ++bj) {
                    f32x4 v0 = acc[ai][bj][m][0] * rstd, v1 = acc[ai][bj][m][1] * rstd;
                    if (relu2) {
                        v0.x = fmaxf(v0.x, 0.f); v0.y = fmaxf(v0.y, 0.f); v0.z = fmaxf(v0.z, 0.f); v0.w = fmaxf(v0.w, 0.f);
                        v1.x = fmaxf(v1.x, 0.f); v1.y = fmaxf(v1.y, 0.f); v1.z = fmaxf(v1.z, 0.f); v1.w = fmaxf(v1.w, 0.f);
                        v0 = v0 * v0; v1 = v1 * v1;
                    }
                    u32x4 w; w.x = pg8::cvt_pk_bf16(v0[0], v0[1]); w.y = pg8::cvt_pk_bf16(v0[2], v0[3]); w.z = pg8::cvt_pk_bf16(v1[0], v1[1]); w.w = pg8::cvt_pk_bf16(v1[2], v1[3]);
                    *(u32x4*)(rowp + bj * 128) = w;
                }
                asm volatile("" ::: "memory");
            }
    }
};
struct EpiResid {
    static constexpr bool PERM = false, AFTER_DRAIN = false;
    const float* xold; float* xnew; bf16_t* xb; float* sumsq_next;
    __device__ __forceinline__ void operator()(const f32x4 (&acc)[2][2][4][2], const pg8::Unit& u, int wr, int wc, int fr, int fq) const {
        const int row0 = u.pm * 256 + wr * 64 + fr, col0 = u.pn * 256 + wc * 32 + 4 * fq;
        f32x4 res[2][2][2];
#define EPR_LOAD(slot, g) do { const int row_ = row0 + ((g) >> 2) * 128 + ((g) & 3) * 16; _Pragma("unroll") for (int bj = 0; bj < 2; ++bj) _Pragma("unroll") for (int n = 0; n < 2; ++n) \
        res[slot][bj][n] = *(const f32x4*)(xold + (size_t)row_ * DM + col0 + bj * 128 + n * 16); } while (0)
        EPR_LOAD(0, 0);
#pragma unroll
        for (int g = 0; g < 8; ++g) {
            const int ai = g >> 2, m = g & 3, row = row0 + ai * 128 + m * 16;
            if (g + 1 < 8) { if (g & 1) EPR_LOAD(0, g + 1); else EPR_LOAD(1, g + 1); }
            float ss = 0.f;
#pragma unroll
            for (int bj = 0; bj < 2; ++bj)
#pragma unroll
                for (int n = 0; n < 2; ++n) {
                    const size_t off = (size_t)row * DM + col0 + bj * 128 + n * 16;
                    const f32x4 v = res[g & 1][bj][n] + acc[ai][bj][m][n];
                    *(f32x4*)(xnew + off) = v;
                    if (xb) { u32x2 o; o.x = pg8::cvt_pk_bf16(v[0], v[1]); o.y = pg8::cvt_pk_bf16(v[2], v[3]); *(u32x2*)(xb + off) = o; }
                    ss += (v[0] * v[0] + v[1] * v[1]) + (v[2] * v[2] + v[3] * v[3]);
                }
            if (sumsq_next) {
                ss += shx(ss, 16, fq * 16 + fr); ss += shx(ss, 32, fq * 16 + fr);
                if (fq == 0) atomicAdd(sumsq_next + row, ss);
            }
            asm volatile("" ::: "memory");
        }
#undef EPR_LOAD
    }
};
struct EpiGlu {
    static constexpr bool PERM = true, AFTER_DRAIN = false;
    const bf16_t* y; bf16_t* mixed;
    __device__ __forceinline__ void operator()(const f32x4 (&acc)[2][2][4][2], const pg8::Unit& u, int wr, int wc, int fr, int fq) const {
        const int row0 = u.pm * 256 + wr * 64 + fr, col0 = u.pn * 256 + wc * 32 + 8 * fq;
#pragma unroll
        for (int ai = 0; ai < 2; ++ai)
#pragma unroll
            for (int m = 0; m < 4; ++m) {
                const int row = row0 + ai * 128 + m * 16;
#pragma unroll
                for (int bj = 0; bj < 2; ++bj) {
                    const int col = col0 + bj * 128;
                    const u32x4 yv = *(const u32x4*)(y + (size_t)row * 512 + col);
                    const f32x4 a0 = acc[ai][bj][m][0], a1 = acc[ai][bj][m][1];
                    float r[8];
#pragma unroll
                    for (int e = 0; e < 4; ++e) {
                        const unsigned w = yv[e];
                        const float ylo = __uint_as_float(w << 16), yhi = __uint_as_float(w & 0xffff0000u);
                        const float alo = e < 2 ? a0[2 * e] : a1[2 * (e - 2)], ahi = e < 2 ? a0[2 * e + 1] : a1[2 * (e - 2) + 1];
                        r[2 * e] = ylo / (1.f + __expf(-alo)); r[2 * e + 1] = yhi / (1.f + __expf(-ahi));
                    }
                    u32x4 w; w.x = pg8::cvt_pk_bf16(r[0], r[1]); w.y = pg8::cvt_pk_bf16(r[2], r[3]); w.z = pg8::cvt_pk_bf16(r[4], r[5]); w.w = pg8::cvt_pk_bf16(r[6], r[7]);
                    *(u32x4*)(mixed + (size_t)row * DM + col) = w;
                }
                asm volatile("" ::: "memory");
            }
    }
};
template <class Epi>
__device__ __forceinline__ void run_gemm(unsigned char* lds, const bf16_t* A, const bf16_t* Bt, int M, int N, int K, const Epi& E) {
    pg8::Gemm g{A, Bt, M, N, K};
    pg8::StaticOrder S; S.init(M, N, (int)gridDim.x, (int)blockIdx.x);
    pg8::gemm_phase<Epi, pg8::StaticOrder, true, true>((PG8_LAS unsigned char*)lds, g, S, E);
}

namespace att {
#define ATT_LAS __attribute__((address_space(3)))
typedef float f32x16 __attribute__((ext_vector_type(16)));
typedef short s16x4 __attribute__((ext_vector_type(4)));
typedef ATT_LAS const unsigned char* ldscp;
typedef ATT_LAS unsigned char* ldsp;
constexpr int TILE = 16384, BUFB = 32768;
constexpr float NEG = -1e30f;
__device__ __forceinline__ unsigned off_b(unsigned row, unsigned ch) { return 256u * row + 16u * (ch ^ (((row & 3u) << 2) | ((row >> 2) & 3u))); }
__device__ __forceinline__ int crow(int r, int hi) { return (r & 3) + 8 * (r >> 2) + 4 * hi; }

struct Stage { int dummy; };
__device__ __forceinline__ void stage_dma(const bf16_t* K, int kpitch, const bf16_t* V, int vpitch, int key0, int kmax, ldsp buf, int tid) {
    const int lane = tid & 63, wv = __builtin_amdgcn_readfirstlane(tid >> 6);
#pragma unroll
    for (int h = 0; h < 2; ++h) {
        const int i = wv + 8 * h;
        const int r = 4 * i + (lane >> 4), s = lane & 15;
        const int ch = s ^ (((r & 3) << 2) | ((r >> 2) & 3));
        int kr = key0 + r; kr = kr < 0 ? 0 : (kr > kmax ? kmax : kr);
        __builtin_amdgcn_global_load_lds((const unsigned*)(K + (size_t)kr * kpitch + 8 * ch), (ATT_LAS unsigned*)(buf + i * 1024), 16, 0, 0);
        __builtin_amdgcn_global_load_lds((const unsigned*)(V + (size_t)kr * vpitch + 8 * ch), (ATT_LAS unsigned*)(buf + TILE + i * 1024), 16, 0, 0);
    }
}
#define ATT_DMA_WAIT() asm volatile("s_waitcnt vmcnt(0)" ::: "memory")
constexpr int NRING = 4;
__device__ __forceinline__ void ring_wait(int rem) {
    if (rem >= 2) asm volatile("s_waitcnt vmcnt(8)" ::: "memory");
    else if (rem == 1) asm volatile("s_waitcnt vmcnt(4)" ::: "memory");
    else asm volatile("s_waitcnt vmcnt(0)" ::: "memory");
}
struct WaveCtx { int lane, r32, hi, kch0; };
__device__ __forceinline__ void ctx_init(WaveCtx& w, int lane, int kch0) { w.lane = lane; w.r32 = lane & 31; w.hi = lane >> 5; w.kch0 = kch0; }
#define ATT_SB() __builtin_amdgcn_sched_barrier(0)
template <int NKS>
__device__ __forceinline__ void qk(ldscp Kt, const WaveCtx& w, const bf16x8 (&qf)[NKS], f32x16& p0, f32x16& p1) {
#pragma unroll
    for (int r = 0; r < 16; ++r) { p0[r] = 0.f; p1[r] = 0.f; }
    int ln = w.lane; asm volatile("" : "+v"(ln));
    const unsigned r32 = ln & 31, hi = ln >> 5;
    bf16x8 ka[3][2];
#define ATT_KLOAD(buf, b) do { const unsigned ko = off_b(r32, (w.kch0 + 2 * (b) + hi) & 15); \
        ka[buf][0] = *(const ATT_LAS bf16x8*)(Kt + ko); ka[buf][1] = *(const ATT_LAS bf16x8*)(Kt + ko + 8192); } while (0)
#define ATT_KMMA(buf, b) do { \
        p0 = __builtin_amdgcn_mfma_f32_32x32x16_bf16(ka[buf][0], qf[b], p0, 0, 0, 0); \
        p1 = __builtin_amdgcn_mfma_f32_32x32x16_bf16(ka[buf][1], qf[b], p1, 0, 0, 0); } while (0)
    ATT_KLOAD(0, 0); ATT_KLOAD(1, 1); ATT_SB();
#pragma unroll
    for (int b = 0; b < NKS; ++b) {
        if (b + 2 < NKS) { if (b % 3 == 0) ATT_KLOAD(2, b + 2); else if (b % 3 == 1) ATT_KLOAD(0, b + 2); else ATT_KLOAD(1, b + 2); }
        if (b % 3 == 0) ATT_KMMA(0, b); else if (b % 3 == 1) ATT_KMMA(1, b); else ATT_KMMA(2, b);
        if (b + 2 < NKS) __builtin_amdgcn_sched_group_barrier(0x100, 2, 0);
        __builtin_amdgcn_sched_group_barrier(0x008, 2, 0);
        ATT_SB();
    }
#undef ATT_KLOAD
#undef ATT_KMMA
}
__device__ __forceinline__ s16x4 trd(unsigned addr, int off) { s16x4 r; asm volatile("ds_read_b64_tr_b16 %0, %1 offset:%c2" : "=v"(r) : "v"(addr), "i"(off)); return r; }
__device__ __forceinline__ void pv(ldscp Vt, const WaveCtx& w, const bf16x8 (&pf)[2][2], f32x16 (&o)[4]) {
    int ln = w.lane; asm volatile("" : "+v"(ln));
    const unsigned hh = ln >> 5, blk = (ln >> 4) & 1, q = (ln & 15) >> 2, pp = ln & 3;
    const unsigned vbase = (unsigned)(uintptr_t)Vt;
    s16x4 vl[2][4], vh[2][4];
#define ATT_VLOAD(buf, c) do { const unsigned vo0 = vbase + off_b(4 * hh + q, 4 * (c) + 2 * blk + (pp >> 1)) + 8 * (pp & 1), vo1 = vbase + off_b(8 + 4 * hh + q, 4 * (c) + 2 * blk + (pp >> 1)) + 8 * (pp & 1); \
        vl[buf][0] = trd(vo0, 0); vh[buf][0] = trd(vo1, 0); vl[buf][1] = trd(vo0, 4096); vh[buf][1] = trd(vo1, 4096); \
        vl[buf][2] = trd(vo0, 8192); vh[buf][2] = trd(vo1, 8192); vl[buf][3] = trd(vo0, 12288); vh[buf][3] = trd(vo1, 12288); } while (0)
#define ATT_VMMA(buf, c) do { _Pragma("unroll") for (int kb = 0; kb < 2; ++kb) _Pragma("unroll") for (int s = 0; s < 2; ++s) { \
            const s16x4 lo = vl[buf][2 * kb + s], hi4 = vh[buf][2 * kb + s]; \
            const bf16x8 vf = (bf16x8){lo[0], lo[1], lo[2], lo[3], hi4[0], hi4[1], hi4[2], hi4[3]}; \
            o[c] = __builtin_amdgcn_mfma_f32_32x32x16_bf16(vf, pf[kb][s], o[c], 0, 0, 0); } } while (0)
#define ATT_LWAIT(n) do { asm volatile("s_waitcnt lgkmcnt(" #n ")" ::: "memory"); ATT_SB(); } while (0)
    asm volatile("s_waitcnt lgkmcnt(0)" ::: "memory"); ATT_SB();
    ATT_VLOAD(0, 0); ATT_SB();
    ATT_VLOAD(1, 1); ATT_LWAIT(8); ATT_VMMA(0, 0); ATT_SB();
    ATT_VLOAD(0, 2); ATT_LWAIT(8); ATT_VMMA(1, 1); ATT_SB();
    ATT_VLOAD(1, 3); ATT_LWAIT(8); ATT_VMMA(0, 2); ATT_SB();
    ATT_LWAIT(0); ATT_VMMA(1, 3); ATT_SB();
#undef ATT_VLOAD
#undef ATT_VMMA
#undef ATT_LWAIT
}
__device__ __forceinline__ void pack_p(const f32x16& p0, const f32x16& p1, bf16x8 (&pf)[2][2]) {
#pragma unroll
    for (int s = 0; s < 2; ++s) {
        u32x4 a, b;
#pragma unroll
        for (int i = 0; i < 4; ++i) { a[i] = pg8::cvt_pk_bf16(p0[8 * s + 2 * i], p0[8 * s + 2 * i + 1]); b[i] = pg8::cvt_pk_bf16(p1[8 * s + 2 * i], p1[8 * s + 2 * i + 1]); }
        pf[0][s] = __builtin_bit_cast(bf16x8, a); pf[1][s] = __builtin_bit_cast(bf16x8, b);
    }
}
__device__ __forceinline__ void apply_bounds(f32x16& p0, f32x16& p1, int klo, int khi, int hi) {
#pragma unroll
    for (int r = 0; r < 16; ++r) {
        const int k = crow(r, hi);
        if (k < klo || k > khi) p0[r] = NEG;
        if (k + 32 < klo || k + 32 > khi) p1[r] = NEG;
    }
}
__device__ __forceinline__ float ex2(float x) { return __builtin_amdgcn_exp2f(x); }
template <int NKS>
__device__ __forceinline__ void tile_softmax(ldscp Kt, ldscp Vt, const WaveCtx& w, const bf16x8 (&qf)[NKS], f32x16 (&o)[4], float& m, float& l, float c, bool need_mask, int klo, int khi) {
    f32x16 p0, p1;
    qk<NKS>(Kt, w, qf, p0, p1);
    if (need_mask) apply_bounds(p0, p1, klo, khi, w.hi);
    float mx = fmaxf(p0[0], p1[0]);
#pragma unroll
    for (int r = 1; r < 16; ++r) mx = fmaxf(mx, fmaxf(p0[r], p1[r]));
    mx = half_max(mx);
    const float mnew = fmaxf(m, mx * c);
    const float alpha = ex2(m - mnew);
    m = mnew;
    float ls = 0.f;
#pragma unroll
    for (int r = 0; r < 16; ++r) { p0[r] = ex2(fmaf(p0[r], c, -mnew)); p1[r] = ex2(fmaf(p1[r], c, -mnew)); ls += p0[r] + p1[r]; }
    l = l * alpha + ls;
    if (__any(alpha != 1.f)) {
#pragma unroll
        for (int cc = 0; cc < 4; ++cc)
#pragma unroll
            for (int r = 0; r < 16; ++r) o[cc][r] *= alpha;
    }
    bf16x8 pf[2][2];
    pack_p(p0, p1, pf);
    pv(Vt, w, pf, o);
}
}

__device__ __forceinline__ float row16_sum(float v) {
    v += __int_as_float(__builtin_amdgcn_mov_dpp(__float_as_int(v), 0xB1, 0xF, 0xF, true));
    v += __int_as_float(__builtin_amdgcn_mov_dpp(__float_as_int(v), 0x4E, 0xF, 0xF, true));
    v += __int_as_float(__builtin_amdgcn_mov_dpp(__float_as_int(v), 0x141, 0xF, 0xF, true));
    v += __int_as_float(__builtin_amdgcn_mov_dpp(__float_as_int(v), 0x140, 0xF, 0xF, true));
    return v;
}
__device__ void phase_prep(const Params& p) {
    const int tid = opaque_tid(), lane = tid & 63, wave = tid >> 6;
    if ((int)blockIdx.x < (int)gridDim.x / 2) return;
    const int gw = ((int)blockIdx.x - (int)gridDim.x / 2) * NWAVES + wave, NGW = ((int)gridDim.x - (int)gridDim.x / 2) * NWAVES;
    bf16_t* proj = (bf16_t*)(p.ws + WS_PROJ);
    const float2* r128 = (const float2*)(p.ws + WS_ROPE128);
    const float2* r64 = (const float2*)(p.ws + WS_ROPE64);
    const bool up32 = lane >= 32, up16 = (lane & 16) != 0;
    for (int m0 = 2 * gw; m0 < MTOK; m0 += 2 * NGW) {
        unsigned xa[2][14], ya[2][8]; f32x4 ca[2], cb[2];
#pragma unroll
        for (int t = 0; t < 2; ++t) {
            const bf16_t* row = proj + (size_t)(m0 + t) * NP;
            ca[t] = *(const f32x4*)(r128 + (size_t)(m0 + t) * 64 + 2 * (lane & 31));
            cb[t] = *(const f32x4*)(r64 + (size_t)(m0 + t) * 32 + 2 * (lane & 15));
#pragma unroll
            for (int hh = 0; hh < 14; ++hh) {
                const int col = hh < 4 ? C_RQ + hh * 128 : (hh < 8 ? C_RK + (hh - 4) * 128 : (hh < 12 ? C_NQ + (hh - 8) * 128 : (hh == 12 ? C_NKS : C_NKW)));
                xa[t][hh] = *(const unsigned*)(row + col + 2 * lane);
            }
#pragma unroll
            for (int hp = 0; hp < 8; ++hp) {
                const int col = hp < 4 ? C_DQ + hp * 128 : C_DK + (hp - 4) * 128;
                ya[t][hp] = *(const unsigned*)(row + col + 2 * lane);
            }
        }
#pragma unroll
        for (int t = 0; t < 2; ++t) {
            bf16_t* row = proj + (size_t)(m0 + t) * NP;
#pragma unroll
            for (int hh = 0; hh < 14; ++hh) {
                const int col = hh < 4 ? C_RQ + hh * 128 : (hh < 8 ? C_RK + (hh - 4) * 128 : (hh < 12 ? C_NQ + (hh - 8) * 128 : (hh == 12 ? C_NKS : C_NKW)));
                const unsigned v = xa[t][hh];
                const auto sw = __builtin_amdgcn_permlane32_swap(v, v, false, false);
                const unsigned pv_ = sw[0] ^ sw[1] ^ v;
                float o0 = __uint_as_float(v << 16), o1 = __uint_as_float(v & 0xffff0000u), q0 = __uint_as_float(pv_ << 16), q1 = __uint_as_float(pv_ & 0xffff0000u);
                float mul = (hh >= 4 && hh < 8) ? 0.08838834764831845f : 1.f;
                if (hh >= 8) {
                    const float rsum = row16_sum(o0 * o0 + o1 * o1);
                    const float tot = (__int_as_float(__builtin_amdgcn_readlane(__float_as_int(rsum), 0)) + __int_as_float(__builtin_amdgcn_readlane(__float_as_int(rsum), 16)))
                                    + (__int_as_float(__builtin_amdgcn_readlane(__float_as_int(rsum), 32)) + __int_as_float(__builtin_amdgcn_readlane(__float_as_int(rsum), 48)));
                    mul = rsqrtf(tot * (1.f / 128.f) + EPS);
                }
                o0 *= mul; o1 *= mul; q0 *= mul; q1 *= mul;
                const float sg = up32 ? 1.f : -1.f;
                const float r0 = o0 * ca[t].x + sg * q0 * ca[t].y, r1 = o1 * ca[t].z + sg * q1 * ca[t].w;
                *(unsigned*)(row + col + 2 * lane) = pg8::cvt_pk_bf16(r0, r1);
            }
#pragma unroll
            for (int hp = 0; hp < 8; ++hp) {
                const int col = hp < 4 ? C_DQ + hp * 128 : C_DK + (hp - 4) * 128;
                const unsigned v = ya[t][hp];
                const auto sw = __builtin_amdgcn_permlane16_swap(v, v, false, false);
                const unsigned pv_ = sw[0] ^ sw[1] ^ v;
                float o0 = __uint_as_float(v << 16), o1 = __uint_as_float(v & 0xffff0000u), q0 = __uint_as_float(pv_ << 16), q1 = __uint_as_float(pv_ & 0xffff0000u);
                const float rsum = row16_sum(o0 * o0 + o1 * o1);
                const float h0 = __int_as_float(__builtin_amdgcn_readlane(__float_as_int(rsum), 0)) + __int_as_float(__builtin_amdgcn_readlane(__float_as_int(rsum), 16));
                const float h1 = __int_as_float(__builtin_amdgcn_readlane(__float_as_int(rsum), 32)) + __int_as_float(__builtin_amdgcn_readlane(__float_as_int(rsum), 48));
                const float mul = rsqrtf((up32 ? h1 : h0) * (1.f / 64.f) + EPS);
                o0 *= mul; o1 *= mul; q0 *= mul; q1 *= mul;
                const float sg = up16 ? 1.f : -1.f;
                const float r0 = o0 * cb[t].x + sg * q0 * cb[t].y, r1 = o1 * cb[t].z + sg * q1 * cb[t].w;
                *(unsigned*)(row + col + 2 * lane) = pg8::cvt_pk_bf16(r0, r1);
            }
        }
    }
}

__device__ __forceinline__ void diff_unit(const Params& p, unsigned char* lds, int unit, float lam, float lam_init) {
    const int tid = opaque_tid(), lane = tid & 63, wave = __builtin_amdgcn_readfirstlane(tid >> 6);
    const int qb = 15 - (unit & 15), bh = unit >> 4, h = bh & 3, b = bh >> 2;
    const int comp = wave >> 2, qsub = wave & 3, q0 = qb * 128 + qsub * 32;
    att::WaveCtx w; att::ctx_init(w, lane, 8 * comp);
    const int tq = q0 + w.r32;
    const bf16_t* base = (const bf16_t*)(p.ws + WS_PROJ) + (size_t)b * SEQ * NP;
    bf16x8 qf[4];
#pragma unroll
    for (int ks = 0; ks < 4; ++ks) qf[ks] = *(const bf16x8*)(base + (size_t)tq * NP + C_DQ + h * 128 + comp * 64 + 16 * ks + 8 * w.hi);
    att::f32x16 o[4];
#pragma unroll
    for (int c = 0; c < 4; ++c)
#pragma unroll
        for (int r = 0; r < 16; ++r) o[c][r] = 0.f;
    float m = att::NEG, l = 0.f;
    const float csc = 0.125f * 1.4426950408889634f;
    const bf16_t* Kg = base + C_DK + h * 128; const bf16_t* Vg = base + C_DV + h * 128;
    const int nt = 2 * qb + 2;
    att::ldsp L3 = (att::ldsp)lds;
    ATT_DMA_WAIT();
#pragma unroll
    for (int ks = 0; ks < 4; ++ks) asm volatile("" : "+v"(qf[ks]));
    int issued = 0;
    for (; issued < nt && issued < att::NRING - 1; ++issued) att::stage_dma(Kg, NP, Vg, NP, issued * 64, SEQ - 1, L3 + issued * att::BUFB, tid);
    for (int kt = 0; kt < nt; ++kt) {
        att::ring_wait(issued - 1 - kt);
        __syncthreads();
        if (issued < nt) { att::stage_dma(Kg, NP, Vg, NP, issued * 64, SEQ - 1, L3 + (issued & (att::NRING - 1)) * att::BUFB, tid); ++issued; }
        const int cur = kt & (att::NRING - 1);
        const int key0 = kt * 64;
        if (key0 <= q0 + 31)
            att::tile_softmax<4>((att::ldscp)(L3 + cur * att::BUFB), (att::ldscp)(L3 + cur * att::BUFB + att::TILE), w, qf, o, m, l, csc, key0 + 63 > q0, 0, tq - key0);
    }
    __syncthreads();
    const float linv = 1.f / half_sum(l);
    float* cb = (float*)lds;
    if (comp == 1) {
#pragma unroll
        for (int c = 0; c < 4; ++c)
#pragma unroll
            for (int r = 0; r < 16; ++r) cb[(qsub * 128 + 32 * c + att::crow(r, w.hi)) * 32 + w.r32] = o[c][r] * linv * lam;
    }
    __syncthreads();
    if (comp == 0) {
        float ss = 0.f;
#pragma unroll
        for (int c = 0; c < 4; ++c)
#pragma unroll
            for (int r = 0; r < 16; ++r) { const float v = o[c][r] * linv - cb[(qsub * 128 + 32 * c + att::crow(r, w.hi)) * 32 + w.r32]; o[c][r] = v; ss += v * v; }
        ss = half_sum(ss);
        const float sc = rsqrtf(ss * (1.f / 128.f) + EPS) * (1.f - lam_init);
        bf16_t* orow = (bf16_t*)(p.ws + WS_MIXED) + ((size_t)b * SEQ + tq) * DM + 1536 + h * 128;
#pragma unroll
        for (int c = 0; c < 4; ++c)
#pragma unroll
            for (int g = 0; g < 4; ++g) {
                u32x2 v; v.x = pg8::cvt_pk_bf16(o[c][4 * g] * sc, o[c][4 * g + 1] * sc); v.y = pg8::cvt_pk_bf16(o[c][4 * g + 2] * sc, o[c][4 * g + 3] * sc);
                *(u32x2*)(orow + 32 * c + 8 * g + 4 * w.hi) = v;
            }
    }
    __syncthreads();
}
__device__ void phase_diff_mfma(const Params& p, unsigned char* lds, int L) {
    const int lane = opaque_tid() & 63;
    const float lam_init = 0.8f - 0.6f * expf(-0.3f * (float)L);
    const float a = p.in[17][L * 64 + lane] * p.in[18][L * 64 + lane];
    const float c = p.in[19][L * 64 + lane] * p.in[20][L * 64 + lane];
    const float lam = expf(wave_sum(a, lane)) - expf(wave_sum(c, lane)) + lam_init;
    for (int unit = blockIdx.x; unit < NB * 4 * 16; unit += gridDim.x) diff_unit(p, lds, unit, lam, lam_init);
}

template <int NKS>
__device__ __forceinline__ void tile_decay(att::ldscp Kt, att::ldscp Vt, const att::WaveCtx& w, const bf16x8 (&qf)[NKS], att::f32x16 (&o)[4], float log2g, int dq, bool need_mask) {
    att::f32x16 p0, p1;
    att::qk<NKS>(Kt, w, qf, p0, p1);
#pragma unroll
    for (int r = 0; r < 16; ++r) {
        const int d0 = dq - att::crow(r, w.hi), d1 = d0 - 32;
        const float f0 = att::ex2(log2g * (float)d0), f1 = att::ex2(log2g * (float)d1);
        p0[r] = (need_mask && d0 < 0) ? 0.f : p0[r] * f0;
        p1[r] = (need_mask && d1 < 0) ? 0.f : p1[r] * f1;
    }
    bf16x8 pf[2][2];
    att::pack_p(p0, p1, pf);
    att::pv(Vt, w, pf, o);
}
__device__ __forceinline__ void ret_unit(const Params& p, unsigned char* lds, int unit) {
    const int tid = opaque_tid(), lane = tid & 63, wave = __builtin_amdgcn_readfirstlane(tid >> 6);
    const int qb = 7 - (unit & 7), bh = unit >> 3, h = bh & 3, b = bh >> 2;
    const int q0 = qb * 256 + wave * 32;
    att::WaveCtx w; att::ctx_init(w, lane, 0);
    const int tq = q0 + w.r32;
    const bf16_t* base = (const bf16_t*)(p.ws + WS_PROJ) + (size_t)b * SEQ * NP;
    bf16x8 qf[8];
#pragma unroll
    for (int ks = 0; ks < 8; ++ks) qf[ks] = *(const bf16x8*)(base + (size_t)tq * NP + C_RQ + h * 128 + 16 * ks + 8 * w.hi);
    att::f32x16 o[4];
#pragma unroll
    for (int c = 0; c < 4; ++c)
#pragma unroll
        for (int r = 0; r < 16; ++r) o[c][r] = 0.f;
    const float log2g = log2f(1.0f - exp2f(-5.0f - (float)h));
    const bf16_t* Kg = base + C_RK + h * 128; const bf16_t* Vg = base + C_RV + h * 128;
    const int nt = 4 * qb + 4;
    att::ldsp L3 = (att::ldsp)lds;
    ATT_DMA_WAIT();
#pragma unroll
    for (int ks = 0; ks < 8; ++ks) asm volatile("" : "+v"(qf[ks]));
    int issued = 0;
    for (; issued < nt && issued < att::NRING - 1; ++issued) att::stage_dma(Kg, NP, Vg, NP, issued * 64, SEQ - 1, L3 + issued * att::BUFB, tid);
    for (int kt = 0; kt < nt; ++kt) {
        att::ring_wait(issued - 1 - kt);
        __syncthreads();
        if (issued < nt) { att::stage_dma(Kg, NP, Vg, NP, issued * 64, SEQ - 1, L3 + (issued & (att::NRING - 1)) * att::BUFB, tid); ++issued; }
        const int cur = kt & (att::NRING - 1);
        const int key0 = kt * 64;
        if (key0 <= q0 + 31)
            tile_decay<8>((att::ldscp)(L3 + cur * att::BUFB), (att::ldscp)(L3 + cur * att::BUFB + att::TILE), w, qf, o, log2g, tq - key0, key0 + 63 > q0);
    }
    __syncthreads();
    float s1 = 0.f;
#pragma unroll
    for (int c = 0; c < 4; ++c)
#pragma unroll
        for (int r = 0; r < 16; ++r) s1 += o[c][r];
    s1 = half_sum(s1);
    const float mu = s1 * (1.f / 128.f);
    float s2 = 0.f;
#pragma unroll
    for (int c = 0; c < 4; ++c)
#pragma unroll
        for (int r = 0; r < 16; ++r) { const float d = o[c][r] - mu; o[c][r] = d; s2 += d * d; }
    s2 = half_sum(s2);
    const float rs = rsqrtf(s2 * (1.f / 128.f) + EPS);
    const size_t mrow = (size_t)b * SEQ + tq;
    const bf16_t* grow = (const bf16_t*)(p.ws + WS_PROJ) + mrow * NP + C_RG + h * 128;
    bf16_t* orow = (bf16_t*)(p.ws + WS_MIXED) + mrow * DM + 512 + h * 128;
#pragma unroll
    for (int c = 0; c < 4; ++c)
#pragma unroll
        for (int g = 0; g < 4; ++g) {
            const int e0 = 32 * c + 8 * g + 4 * w.hi;
            const u32x2 gv = *(const u32x2*)(grow + e0);
            const float g0 = __uint_as_float(gv.x << 16), g1 = __uint_as_float(gv.x & 0xffff0000u), g2 = __uint_as_float(gv.y << 16), g3 = __uint_as_float(gv.y & 0xffff0000u);
            u32x2 v;
            v.x = pg8::cvt_pk_bf16(g0 / (1.f + __expf(-g0)) * o[c][4 * g] * rs, g1 / (1.f + __expf(-g1)) * o[c][4 * g + 1] * rs);
            v.y = pg8::cvt_pk_bf16(g2 / (1.f + __expf(-g2)) * o[c][4 * g + 2] * rs, g3 / (1.f + __expf(-g3)) * o[c][4 * g + 3] * rs);
            *(u32x2*)(orow + e0) = v;
        }
    __syncthreads();
}
__device__ void phase_ret_mfma(const Params& p, unsigned char* lds) {
    for (int unit = (blockIdx.x + gridDim.x / 2) % gridDim.x; unit < NB * 4 * 8; unit += gridDim.x) ret_unit(p, lds, unit);
}

__device__ __forceinline__ void nsa_unit(const Params& p, unsigned char* lds, int unit) {
    const int tid = opaque_tid(), lane = tid & 63, wave = __builtin_amdgcn_readfirstlane(tid >> 6);
    const int tb = 31 - (unit & 31), b = unit >> 5;
    const int head = wave >> 1, thalf = wave & 1, t0w = tb * 64 + thalf * 32;
    att::WaveCtx w; att::ctx_init(w, lane, 0);
    const int tq = t0w + w.r32, tloc = thalf * 32 + w.r32;
    const bf16_t* base = (const bf16_t*)(p.ws + WS_PROJ) + (size_t)b * SEQ * NP;
    bf16x8 qf[8];
#pragma unroll
    for (int ks = 0; ks < 8; ++ks) qf[ks] = *(const bf16x8*)(base + (size_t)tq * NP + C_NQ + head * 128 + 16 * ks + 8 * w.hi);
#define NSA_GATE(br) (1.f / (1.f + __expf(-bf2f(base[(size_t)tq * NP + C_GATE + head * 3 + (br)]))))
    const float csc = 0.08838834764831845f * 1.4426950408889634f;
    float* impQ = (float*)(lds + 65536);
    float* impE = (float*)(lds + 65536 + 32768);
    float* scb = (float*)lds;
    unsigned* selm = (unsigned*)(lds + 8192);
    att::ldsp L3 = (att::ldsp)lds;
    att::f32x16 o[4];
#pragma unroll
    for (int c = 0; c < 4; ++c)
#pragma unroll
        for (int r = 0; r < 16; ++r) o[c][r] = 0.f;
    {
        const bf16_t* Kc = (const bf16_t*)(p.ws + WS_KVCMPB) + (size_t)b * 128 * 128; const bf16_t* Vc = Kc + 4 * 128 * 128;
        att::stage_dma(Kc, 128, Vc, 128, 0, 127, L3, tid);
        att::stage_dma(Kc, 128, Vc, 128, 64, 127, L3 + att::BUFB, tid);
        ATT_DMA_WAIT();
        __syncthreads();
        const int jmax = tq >= 31 ? ((tq - 31) >> 4) : -1;
        float m = att::NEG, l = 0.f;
#pragma unroll 1
        for (int kt = 0; kt < 2; ++kt) {
            att::f32x16 p0, p1;
            att::qk<8>((att::ldscp)(L3 + kt * att::BUFB), w, qf, p0, p1);
            att::apply_bounds(p0, p1, 0, jmax - 64 * kt, w.hi);
            float mx = fmaxf(p0[0], p1[0]);
#pragma unroll
            for (int r = 1; r < 16; ++r) mx = fmaxf(mx, fmaxf(p0[r], p1[r]));
            mx = half_max(mx);
            const float mnew = fmaxf(m, mx * csc);
            float ls = 0.f;
#pragma unroll
            for (int r = 0; r < 16; ++r) ls += att::ex2(fmaf(p0[r], csc, -mnew)) + att::ex2(fmaf(p1[r], csc, -mnew));
            l = l * att::ex2(m - mnew) + ls; m = mnew;
        }
        l = half_sum(l);
        const float inv = (jmax >= 0) ? 1.f / l : 0.f;
#pragma unroll 1
        for (int kt = 0; kt < 2; ++kt) {
            att::f32x16 p0, p1;
            att::qk<8>((att::ldscp)(L3 + kt * att::BUFB), w, qf, p0, p1);
            att::apply_bounds(p0, p1, 0, jmax - 64 * kt, w.hi);
#pragma unroll
            for (int r = 0; r < 16; ++r) { p0[r] = att::ex2(fmaf(p0[r], csc, -m)) * inv; p1[r] = att::ex2(fmaf(p1[r], csc, -m)) * inv; }
#pragma unroll
            for (int g = 0; g < 4; ++g) {
                const int ia = ((head * 32 + 16 * kt + 2 * g + w.hi) * 64) + tloc, ib = ia + 8 * 64;
                impQ[ia] = (p0[4 * g] + p0[4 * g + 1]) + (p0[4 * g + 2] + p0[4 * g + 3]); impE[ia] = p0[4 * g + 3];
                impQ[ib] = (p1[4 * g] + p1[4 * g + 1]) + (p1[4 * g + 2] + p1[4 * g + 3]); impE[ib] = p1[4 * g + 3];
            }
            bf16x8 pf[2][2];
            att::pack_p(p0, p1, pf);
            att::pv((att::ldscp)(L3 + kt * att::BUFB + att::TILE), w, pf, o);
        }
    }
    __syncthreads();
    unsigned mymask, tmask;
    {
        const int token = tid >> 3, js0 = (tid & 7) * 4;
        if (tid < 65) selm[tid] = 0u;
#pragma unroll
        for (int i = 0; i < 4; ++i) {
            const int js = js0 + i;
            float s = 0.f;
#pragma unroll
            for (int h = 0; h < 4; ++h) { s += impQ[(h * 32 + js) * 64 + token]; if (js > 0) s += impE[(h * 32 + js - 1) * 64 + token]; }
            const bool valid = js <= tb, forced = (js == 0) || (js == tb) || (js == tb - 1);
            scb[token * 32 + js] = valid ? s + (forced ? 1e4f : 0.f) : -1e30f;
        }
        __syncthreads();
        unsigned mine = 0u;
#pragma unroll
        for (int i = 0; i < 4; ++i) {
            const int js = js0 + i;
            const float my = scb[token * 32 + js];
            int rank = 0;
            for (int jj = 0; jj < 32; ++jj) { const float sj = scb[token * 32 + jj]; rank += (sj > my || (sj == my && jj < js)) ? 1 : 0; }
            if (js <= tb && rank < 8) mine |= 1u << js;
        }
        if (mine) { atomicOr(&selm[token], mine); atomicOr(&selm[64], mine); }
        __syncthreads();
        mymask = selm[tloc]; tmask = selm[64];
        __syncthreads();
    }
    bf16_t* orow = (bf16_t*)(p.ws + WS_MIXED) + ((size_t)b * SEQ + tq) * DM + 1024 + head * 128 + 4 * w.hi;
    {
        const float g0 = NSA_GATE(0);
#pragma unroll
        for (int c = 0; c < 4; ++c)
#pragma unroll
            for (int g = 0; g < 4; ++g) {
                u32x2 v; v.x = pg8::cvt_pk_bf16(g0 * o[c][4 * g], g0 * o[c][4 * g + 1]); v.y = pg8::cvt_pk_bf16(g0 * o[c][4 * g + 2], g0 * o[c][4 * g + 3]);
                *(u32x2*)(orow + 32 * c + 8 * g) = v;
                o[c][4 * g] = 0.f; o[c][4 * g + 1] = 0.f; o[c][4 * g + 2] = 0.f; o[c][4 * g + 3] = 0.f;
            }
    }
#define NSA_ACCUM(f) do { _Pragma("unroll") for (int c = 0; c < 4; ++c) _Pragma("unroll") for (int g = 0; g < 4; ++g) { \
        const u32x2 u = *(const u32x2*)(orow + 32 * c + 8 * g); u32x2 v; \
        v.x = pg8::cvt_pk_bf16(__uint_as_float(u.x << 16) + (f) * o[c][4 * g], __uint_as_float(u.x & 0xffff0000u) + (f) * o[c][4 * g + 1]); \
        v.y = pg8::cvt_pk_bf16(__uint_as_float(u.y << 16) + (f) * o[c][4 * g + 2], __uint_as_float(u.y & 0xffff0000u) + (f) * o[c][4 * g + 3]); \
        *(u32x2*)(orow + 32 * c + 8 * g) = v; \
        o[c][4 * g] = 0.f; o[c][4 * g + 1] = 0.f; o[c][4 * g + 2] = 0.f; o[c][4 * g + 3] = 0.f; } } while (0)
    {
        const bf16_t* Kg = base + C_NKS; const bf16_t* Vg = base + C_NVS;
        float m = att::NEG, l = 0.f;
        const unsigned tm = (unsigned)__builtin_amdgcn_readfirstlane((int)tmask);
        const int nt = __builtin_popcount(tm);
        unsigned mi = tm, mc = tm;
        ATT_DMA_WAIT();
#pragma unroll
        for (int ks = 0; ks < 8; ++ks) asm volatile("" : "+v"(qf[ks]));
        int issued = 0;
        for (; issued < nt && issued < att::NRING - 1; ++issued) { const int j = __builtin_ctz(mi); mi &= mi - 1; att::stage_dma(Kg, NP, Vg, NP, j * 64, SEQ - 1, L3 + issued * att::BUFB, tid); }
        for (int i = 0; i < nt; ++i) {
            att::ring_wait(issued - 1 - i);
            __syncthreads();
            if (issued < nt) { const int j = __builtin_ctz(mi); mi &= mi - 1; att::stage_dma(Kg, NP, Vg, NP, j * 64, SEQ - 1, L3 + (issued & (att::NRING - 1)) * att::BUFB, tid); ++issued; }
            const int cur = i & (att::NRING - 1);
            const int curj = __builtin_ctz(mc); mc &= mc - 1;
            const bool allowed = (mymask >> curj) & 1u;
            if (__any(allowed))
                att::tile_softmax<8>((att::ldscp)(L3 + cur * att::BUFB), (att::ldscp)(L3 + cur * att::BUFB + att::TILE), w, qf, o, m, l, csc, (curj == tb) || __any(!allowed), 0, allowed ? tq - curj * 64 : -1);
        }
        __syncthreads();
        l = half_sum(l);
        const float f = NSA_GATE(1) / l;
        NSA_ACCUM(f);
    }
    {
        const bf16_t* Kg = base + C_NKW; const bf16_t* Vg = base + C_NVW;
        float m = att::NEG, l = 0.f;
        const int kt0 = tb >= 4 ? tb - 4 : 0, nt = tb - kt0 + 1;
        ATT_DMA_WAIT();
        int issued = 0;
        for (; issued < nt && issued < att::NRING - 1; ++issued) att::stage_dma(Kg, NP, Vg, NP, (kt0 + issued) * 64, SEQ - 1, L3 + issued * att::BUFB, tid);
        for (int i = 0; i < nt; ++i) {
            att::ring_wait(issued - 1 - i);
            __syncthreads();
            if (issued < nt) { att::stage_dma(Kg, NP, Vg, NP, (kt0 + issued) * 64, SEQ - 1, L3 + (issued & (att::NRING - 1)) * att::BUFB, tid); ++issued; }
            const int kt = kt0 + i, cur = i & (att::NRING - 1);
            const int key0 = kt * 64;
            att::tile_softmax<8>((att::ldscp)(L3 + cur * att::BUFB), (att::ldscp)(L3 + cur * att::BUFB + att::TILE), w, qf, o, m, l, csc, (kt == tb) || (kt == tb - 4), tq - 255 - key0, tq - key0);
        }
        l = half_sum(l);
        const float f = NSA_GATE(2) / l;
        NSA_ACCUM(f);
    }
    __syncthreads();
#undef NSA_ACCUM
#undef NSA_GATE
}
__device__ void phase_nsa_mfma(const Params& p, unsigned char* lds) {
    for (int unit = blockIdx.x; unit < NB * 32; unit += gridDim.x) nsa_unit(p, lds, unit);
}

__device__ void phase_cmp_mfma(const Params& p, unsigned char* lds, int L) {
    const int tid = opaque_tid(), lane = tid & 63, wave = __builtin_amdgcn_readfirstlane(tid >> 6);
    const int r32 = lane & 31, hi = lane >> 5;
    const bf16_t* proj = (const bf16_t*)(p.ws + WS_PROJ);
    const float2* r128 = (const float2*)(p.ws + WS_ROPE128);
    float* part = (float*)lds;
    float* slabs = (float*)(p.ws + WS_KPART);
    unsigned* cnt = (unsigned*)(p.ws + WS_CMPCNT) + L * 32;
    volatile int* slot = (volatile int*)(lds + 131072 + 56);
    for (int item = (blockIdx.x + gridDim.x / 2) % gridDim.x; item < NB * 2 * 4 * 4; item += gridDim.x) {
        const int lq = item & 3, jb = (item >> 2) & 3, kv = (item >> 4) & 1, b = item >> 5;
        const bf16_t* Wt = (const bf16_t*)(p.ws + WS_WCMP) + ((size_t)(L * 2 + kv)) * 128 * 4096;
        const float* pe = p.in[kv ? 14 : 13] + (size_t)L * 32 * 128;
        const int col = kv ? C_NVC : C_NKC;
        int j = jb * 32 + r32; if (j > 126) j = 126;
        att::f32x16 acc[4];
#pragma unroll
        for (int nb = 0; nb < 4; ++nb)
#pragma unroll
            for (int r = 0; r < 16; ++r) acc[nb][r] = 0.f;
        {
            const int l = lq * 8 + wave;
            const size_t m = (size_t)b * SEQ + 16 * j + l;
            const bf16_t* xrow = proj + m * NP + col;
#pragma unroll 4
            for (int ks = 0; ks < 8; ++ks) {
                const int d0 = 16 * ks + 8 * hi;
                const bf16x8 xv = *(const bf16x8*)(xrow + d0);
                float xf[8];
#pragma unroll
                for (int e = 0; e < 8; ++e) xf[e] = bf2f((bf16_t)xv[e]);
                if (!kv) {
                    const bf16x8 xp = *(const bf16x8*)(xrow + (d0 ^ 64));
                    const f32x4* cs4 = (const f32x4*)(r128 + m * 64 + (d0 & 63));
#pragma unroll
                    for (int e2 = 0; e2 < 4; ++e2) {
                        const f32x4 t = cs4[e2];
                        const float o0 = bf2f((bf16_t)xp[2 * e2]), o1 = bf2f((bf16_t)xp[2 * e2 + 1]);
                        xf[2 * e2] = (d0 < 64) ? xf[2 * e2] * t.x - o0 * t.y : xf[2 * e2] * t.x + o0 * t.y;
                        xf[2 * e2 + 1] = (d0 < 64) ? xf[2 * e2 + 1] * t.z - o1 * t.w : xf[2 * e2 + 1] * t.z + o1 * t.w;
                    }
                }
                const f32x4 pe0 = *(const f32x4*)(pe + l * 128 + d0), pe1 = *(const f32x4*)(pe + l * 128 + d0 + 4);
                u32x4 xa;
                xa.x = pg8::cvt_pk_bf16(xf[0] + pe0.x, xf[1] + pe0.y); xa.y = pg8::cvt_pk_bf16(xf[2] + pe0.z, xf[3] + pe0.w);
                xa.z = pg8::cvt_pk_bf16(xf[4] + pe1.x, xf[5] + pe1.y); xa.w = pg8::cvt_pk_bf16(xf[6] + pe1.z, xf[7] + pe1.w);
                const bf16x8 xfr = __builtin_bit_cast(bf16x8, xa);
#pragma unroll
                for (int nb = 0; nb < 4; ++nb) {
                    const bf16x8 wf = *(const bf16x8*)(Wt + (size_t)(nb * 32 + r32) * 4096 + l * 128 + d0);
                    acc[nb] = __builtin_amdgcn_mfma_f32_32x32x16_bf16(wf, xfr, acc[nb], 0, 0, 0);
                }
            }
        }
        __syncthreads();
#pragma unroll
        for (int nb = 0; nb < 4; ++nb)
#pragma unroll
            for (int r = 0; r < 16; ++r) part[(wave * 128 + nb * 32 + att::crow(r, hi)) * 32 + r32] = acc[nb][r];
        __syncthreads();
        const int jj = tid & 31, ng = tid >> 5;
        const int jrow = jb * 32 + jj;
        float v[8];
#pragma unroll
        for (int i = 0; i < 8; ++i) {
            float s = 0.f;
#pragma unroll
            for (int w8 = 0; w8 < 8; ++w8) s += part[(w8 * 128 + ng * 8 + i) * 32 + jj];
            v[i] = s;
        }
        {
            float* my = slabs + ((size_t)((lq * 2 + kv) * 4 + b) * 128 + jrow) * 128 + ng * 8;
            *(f32x4*)my = (f32x4){v[0], v[1], v[2], v[3]}; *(f32x4*)(my + 4) = (f32x4){v[4], v[5], v[6], v[7]};
        }
        asm volatile("s_waitcnt vmcnt(0)" ::: "memory");
        __syncthreads();
        if (tid == 0) {
            __builtin_amdgcn_fence(__ATOMIC_RELEASE, "agent");
            asm volatile("s_waitcnt vmcnt(0)" ::: "memory");
            *slot = (int)__hip_atomic_fetch_add(cnt + (item >> 2), 1u, __ATOMIC_RELAXED, __HIP_MEMORY_SCOPE_AGENT);
        }
        __syncthreads();
        const int ticket = *slot;
        if (ticket == 3) {
            if (tid == 0) { __builtin_amdgcn_fence(__ATOMIC_ACQUIRE, "agent"); asm volatile("s_waitcnt vmcnt(0)" ::: "memory"); }
            __syncthreads();
            float ss = 0.f;
#pragma unroll
            for (int i = 0; i < 8; ++i) v[i] = 0.f;
#pragma unroll
            for (int q4 = 0; q4 < 4; ++q4) {
                const float* sp = slabs + ((size_t)((q4 * 2 + kv) * 4 + b) * 128 + jrow) * 128 + ng * 8;
                const f32x4 a0 = *(const f32x4*)sp, a1 = *(const f32x4*)(sp + 4);
                v[0] += a0.x; v[1] += a0.y; v[2] += a0.z; v[3] += a0.w; v[4] += a1.x; v[5] += a1.y; v[6] += a1.z; v[7] += a1.w;
            }
#pragma unroll
            for (int i = 0; i < 8; ++i) ss += v[i] * v[i];
            float sc = 1.f;
            if (!kv) {
                part[ng * 32 + jj] = ss;
                __syncthreads();
                float tot = 0.f;
#pragma unroll
                for (int g2 = 0; g2 < 16; ++g2) tot += part[g2 * 32 + jj];
                sc = rsqrtf(tot * (1.f / 128.f) + EPS);
            }
            if (jrow > 126) sc = 0.f;
            u32x4 ov;
            ov.x = pg8::cvt_pk_bf16(v[0] * sc, v[1] * sc); ov.y = pg8::cvt_pk_bf16(v[2] * sc, v[3] * sc); ov.z = pg8::cvt_pk_bf16(v[4] * sc, v[5] * sc); ov.w = pg8::cvt_pk_bf16(v[6] * sc, v[7] * sc);
            *(u32x4*)((bf16_t*)(p.ws + WS_KVCMPB) + (size_t)kv * 4 * 128 * 128 + ((size_t)b * 128 + jrow) * 128 + ng * 8) = ov;
        }
        __syncthreads();
    }
    __syncthreads();
}

__device__ __forceinline__ float gelu_tanh(float x) {
    const float u = 0.7978845608028654f * (x + 0.044715f * x * x * x);
    const float e = __expf(2.f * u);
    const float th = 1.f - 2.f / (e + 1.f);
    return 0.5f * x * (1.f + th);
}
__device__ void phase_s5v2(const Params& p, unsigned char* lds, int L) {
    const int tid = opaque_tid(), lane = tid & 63, wave = __builtin_amdgcn_readfirstlane(tid >> 6);
    const int r32 = lane & 31, hi = lane >> 5, l15 = lane & 15, q4 = lane >> 4;
    float* bub = (float*)lds;
    unsigned char* s16 = lds + 65536;
    float2* xch = (float2*)(lds + 65536 + 2 * 17408);
    const bf16_t* proj = (const bf16_t*)(p.ws + WS_PROJ);
    bf16_t* s5y = (bf16_t*)(p.ws + WS_S5Y);
    const unsigned char* pre = p.ws + WS_S5PRE + L * S5PRE_LAYER;
    const float2* lbp = (const float2*)pre;
    const bf16_t* bb16 = (const bf16_t*)(pre + 16384);
    const bf16_t* cm16 = (const bf16_t*)(pre + 16384 + 131072);
    typedef float f32x2 __attribute__((ext_vector_type(2)));
#define S5_CMA(A_, X_, Y_) (((f32x2){-(A_).y, (A_).y}) * ((f32x2){(X_).y, (X_).x}) + (((f32x2){(A_).x, (A_).x}) * (X_) + (Y_)))
    for (int it = blockIdx.x; it < NB * 32; it += gridDim.x) {
        const int b = it >> 5, g = it & 31;
        const size_t m0 = (size_t)b * SEQ;
        f32x2 lam[8];
        { const float2 lb = lbp[g * 64 + lane]; lam[0] = (f32x2){lb.x, lb.y};
#pragma unroll
          for (int k = 1; k < 8; ++k) lam[k] = (f32x2){lam[k - 1].x * lam[0].x - lam[k - 1].y * lam[0].y, lam[k - 1].x * lam[0].y + lam[k - 1].y * lam[0].x}; }
        f32x2 S = (f32x2){0.f, 0.f};
        const int a_tb = wave & 1, a_pb = wave >> 1;
        const bf16x8 bfa = *(const bf16x8*)(bb16 + ((size_t)(g * 128 + 32 * a_pb + r32)) * 16 + 8 * hi);
        bf16x8 cm[4]; float dsk = 0.f;
        if (wave < 4) {
#pragma unroll
            for (int ks = 0; ks < 4; ++ks) cm[ks] = *(const bf16x8*)(cm16 + ((size_t)(g * 16 + l15)) * 128 + 32 * ks + 8 * q4);
            dsk = p.in[11][((size_t)L * 32 + g) * 16 + l15];
        }
        const bf16_t* urow = proj + (m0 + 32 * a_tb + r32) * NP + C_U + g * 16 + 8 * hi;
        const bf16_t* yrow = proj + (m0 + 16 * wave + 4 * q4) * NP + C_U + g * 16 + l15;
        bf16x8 af0 = *(const bf16x8*)(urow), af1 = *(const bf16x8*)(urow + (size_t)64 * NP);
        bf16_t uy0[4], uy1[4];
#pragma unroll
        for (int r = 0; r < 4; ++r) { uy0[r] = 0; uy1[r] = 0; }
        if (wave < 4) {
#pragma unroll
            for (int r = 0; r < 4; ++r) { uy0[r] = yrow[(size_t)r * NP]; uy1[r] = yrow[(size_t)(64 + r) * NP]; }
        }
        __syncthreads();
        f32x2 ccA[8], ccB[8];
#pragma unroll
        for (int k = 0; k < 8; ++k) { ccA[k] = (f32x2){0.f, 0.f}; ccB[k] = (f32x2){0.f, 0.f}; }
#pragma unroll 1
        for (int i = -1; i <= SEQ / 64 + 1; ++i) {
            if (i + 1 < SEQ / 64) {
                const int c1 = i + 1;
                float* bw = bub + (c1 & 1) * 8192;
                att::f32x16 d;
#pragma unroll
                for (int r = 0; r < 16; ++r) d[r] = 0.f;
                d = __builtin_amdgcn_mfma_f32_32x32x16_bf16(af0, bfa, d, 0, 0, 0);
#pragma unroll
                for (int r = 0; r < 16; ++r) bw[(32 * a_tb + att::crow(r, hi)) * 128 + 32 * a_pb + r32] = d[r];
                af0 = af1;
                if (c1 + 2 < SEQ / 64) af1 = *(const bf16x8*)(urow + (size_t)(64 * (c1 + 2)) * NP);
            }
#pragma unroll
            for (int k = 0; k < 8; ++k) ccB[k] = ccA[k];
            if (i >= 0 && i < SEQ / 64) {
                const f32x2* bc = (const f32x2*)(bub + (i & 1) * 8192) + (8 * wave) * 64 + lane;
                f32x2 bu[8];
#pragma unroll
                for (int k = 0; k < 8; ++k) bu[k] = bc[k * 64];
                ccA[0] = bu[0];
#pragma unroll
                for (int k = 1; k < 8; ++k) ccA[k] = S5_CMA(lam[0], ccA[k - 1], bu[k]);
                xch[((i & 1) * 8 + wave) * 64 + lane] = make_float2(ccA[7].x, ccA[7].y);
            }
            if (i >= 1 && i <= SEQ / 64) {
                const int c = i - 1;
                f32x2 Sin = S;
#pragma unroll
                for (int j = 0; j < 8; ++j) {
                    const float2 t = xch[((c & 1) * 8 + j) * 64 + lane];
                    if (j == wave) Sin = S;
                    S = S5_CMA(lam[7], S, ((f32x2){t.x, t.y}));
                }
                unsigned* sc = (unsigned*)(s16 + (c & 1) * 17408) + (8 * wave) * 68 + lane;
#pragma unroll
                for (int k = 0; k < 8; ++k) { const f32x2 s = S5_CMA(lam[k], Sin, ccB[k]); sc[k * 68] = pg8::cvt_pk_bf16(s.x, s.y); }
            }
            if (i >= 2 && wave < 4) {
                const int c0 = i - 2;
                const unsigned char* sb = s16 + (c0 & 1) * 17408;
                f32x4 acc = (f32x4){0.f, 0.f, 0.f, 0.f};
#pragma unroll
                for (int ks = 0; ks < 4; ++ks) {
                    const bf16x8 af = *(const bf16x8*)(sb + (16 * wave + l15) * 272 + 64 * ks + 16 * q4);
                    acc = __builtin_amdgcn_mfma_f32_16x16x32_bf16(af, cm[ks], acc, 0, 0, 0);
                }
#pragma unroll
                for (int r = 0; r < 4; ++r) {
                    const size_t m = m0 + 64 * c0 + 16 * wave + 4 * q4 + r;
                    s5y[m * 512 + g * 16 + l15] = (bf16_t)f2bf(gelu_tanh(acc[r] + dsk * bf2f(uy0[r])));
                }
#pragma unroll
                for (int r = 0; r < 4; ++r) { uy0[r] = uy1[r]; if (c0 + 2 < SEQ / 64) uy1[r] = yrow[(size_t)(64 * (c0 + 2) + r) * NP]; }
            }
            __syncthreads();
        }
    }
#undef S5_CMA
}

struct OneUnit {
    pg8::Unit u;
    __device__ __forceinline__ bool next(int i, pg8::Unit& o) const { if (i) return false; o = u; return true; }
    __device__ __forceinline__ void a_ready(const pg8::Unit&) const {}
    __device__ __forceinline__ void done(const pg8::Unit&) const {}
};
constexpr int P3_NSA = NB * 32, P3_DIFF = NB * 4 * 16, P3_RET = NB * 4 * 8, P3_GLU = (MTOK / 256) * 2, P3_ITEMS = P3_NSA + P3_DIFF + P3_RET + P3_GLU;
__device__ __forceinline__ int p3_key(int e) {
    int c;
    if (e < P3_NSA) c = 4 * ((31 - (e & 31)) + 9);
    else if (e < P3_NSA + P3_DIFF) c = 3 * (2 * (15 - ((e - P3_NSA) & 15)) + 2);
    else if (e < P3_NSA + P3_DIFF + P3_RET) c = 4 * (4 * (7 - ((e - P3_NSA - P3_DIFF) & 7)) + 4);
    else c = 8;
    return c * 1024 + e;
}
__device__ void phase_p3(const Params& p, unsigned char* lds, int L) {
    const int tid = opaque_tid(), lane = tid & 63;
    unsigned short* order = (unsigned short*)(lds + 131072 + 64);
    volatile int* slot = (volatile int*)(lds + 131072 + 48);
    int* keys = (int*)lds;
    for (int e = tid; e < P3_ITEMS; e += NTHREADS) keys[e] = p3_key(e);
    __syncthreads();
    for (int e = tid; e < P3_ITEMS; e += NTHREADS) {
        const int ke = keys[e]; int rank = 0;
#pragma unroll 8
        for (int f = 0; f < P3_ITEMS; ++f) rank += keys[f] > ke ? 1 : 0;
        order[rank] = (unsigned short)e;
    }
    const float* lamw = (const float*)(p.ws + WS_LAM) + 2 * L;
    unsigned* qctr = (unsigned*)(p.ws + WS_QUEUE) + L * 64;
    __syncthreads();
    for (;;) {
        if (tid == 0) *slot = (int)atomicAdd(qctr, 1u);
        __syncthreads();
        const int q = *slot;
        __syncthreads();
        if (q >= P3_ITEMS) break;
        const int e = order[q];
        if (e < P3_NSA) nsa_unit(p, lds, e);
        else if (e < P3_NSA + P3_DIFF) diff_unit(p, lds, e - P3_NSA, lamw[0], lamw[1]);
        else if (e < P3_NSA + P3_DIFF + P3_RET) ret_unit(p, lds, e - P3_NSA - P3_DIFF);
        else {
            const int g = e - P3_NSA - P3_DIFF - P3_RET;
            pg8::Gemm gm{(const bf16_t*)(p.ws + WS_S5Y), (const bf16_t*)(p.ws + WS_WGLU + (size_t)L * 512 * 512 * 2), MTOK, 512, 512};
            OneUnit S{pg8::Unit{g >> 1, g & 1}};
            EpiGlu E{(const bf16_t*)(p.ws + WS_S5Y), (bf16_t*)(p.ws + WS_MIXED)};
            pg8::gemm_phase<EpiGlu, OneUnit, true, true>((PG8_LAS unsigned char*)lds, gm, S, E);
            __syncthreads();
        }
    }
    if (L == 0) conv_fill(p, lds, CONV_B_BLK);
}

#define LAS __attribute__((address_space(3)))
#define XB_TMO      128
#define XB_XCNT(j)  (256  + 64 * (j))
#define XB_XSUB(j)  (1280 + 64 * (j))
#define XB_XGEN(j)  (2304 + 64 * (j))
#define XB_TOP      3328
#define XB_TOPGEN   3392
#define XCD_BAR_WORDS 3456
#define XB_SPIN_CAP (1u << 18)

__device__ __forceinline__ unsigned xb_ld(unsigned* p)              { return __hip_atomic_load(p, __ATOMIC_RELAXED, __HIP_MEMORY_SCOPE_AGENT); }
__device__ __forceinline__ unsigned xb_add(unsigned* p, unsigned v) { return __hip_atomic_fetch_add(p, v, __ATOMIC_RELAXED, __HIP_MEMORY_SCOPE_AGENT); }
__device__ __forceinline__ unsigned xb_xcc_id() { return (unsigned)__builtin_amdgcn_s_getreg((3 << 11) | 20) & 0xFu; }
#define XB_SPIN(cond, bar) do { unsigned _sp = 0; while (cond) { __builtin_amdgcn_s_sleep(1); \
    if ((++_sp & 255u) == 0u) { if (xb_ld(&(bar)[XB_TMO])) break; if (_sp > XB_SPIN_CAP) { atomicAdd(&(bar)[XB_TMO], 1u); break; } } } } while (0)

struct XcdBarrier {
    unsigned* bar; unsigned x;
    volatile LAS unsigned* st;
};

__device__ __forceinline__ XcdBarrier xcd_barrier_post(unsigned* bar, volatile LAS unsigned* st) {
    XcdBarrier b; b.bar = bar; b.x = xb_xcc_id(); b.st = st;
    if (threadIdx.x == 0) (void)xb_add(&bar[XB_XCNT(b.x)], 1u);
    return b;
}
__device__ __forceinline__ void xcd_barrier_complete(unsigned* bar, unsigned x, unsigned& nloc, unsigned& nx) {
    const unsigned G = gridDim.x * gridDim.y * gridDim.z;
    unsigned sum, cnt, mine, sp = 0u;
    for (;;) {
        sum = 0u; cnt = 0u; mine = 0u;
#pragma unroll
        for (unsigned j = 0; j < 16; ++j) { const unsigned c = xb_ld(&bar[XB_XCNT(j)]); sum += c; cnt += (c > 0u) ? 1u : 0u; mine = (j == x) ? c : mine; }
        if (sum == G) break;
        __builtin_amdgcn_s_sleep(1);
        if ((++sp & 255u) == 0u) { if (xb_ld(&bar[XB_TMO])) break; if (sp > XB_SPIN_CAP) { atomicAdd(&bar[XB_TMO], 1u); break; } }
    }
    nloc = mine > 0u ? mine : 1u; nx = cnt > 0u ? cnt : 1u;
}

__device__ __forceinline__ void xcd_barrier(const XcdBarrier& b) {
    asm volatile("s_waitcnt vmcnt(0)" ::: "memory");
    __syncthreads();
    if (threadIdx.x == 0) {
        unsigned* bar = b.bar;
        __builtin_amdgcn_s_waitcnt(0);
        unsigned nloc = b.st[0], nx = b.st[1];
        if (nloc == 0u) { xcd_barrier_complete(bar, b.x, nloc, nx); b.st[0] = nloc; b.st[1] = nx; }
        const unsigned old = xb_add(&bar[XB_XSUB(b.x)], 1u);
        const unsigned gen = old / nloc;
        if (old + 1u == (gen + 1u) * nloc) {
            __builtin_amdgcn_fence(__ATOMIC_RELEASE, "agent");
            asm volatile("s_waitcnt vmcnt(0)" ::: "memory");
            const unsigned og = xb_add(&bar[XB_TOP], 1u);
            const unsigned tg = og / nx;
            if (og + 1u == (tg + 1u) * nx) xb_add(&bar[XB_TOPGEN], 1u);
            else XB_SPIN(xb_ld(&bar[XB_TOPGEN]) == tg, bar);
            __builtin_amdgcn_fence(__ATOMIC_ACQUIRE, "agent");
            xb_add(&bar[XB_XGEN(b.x)], 1u);
            asm volatile("s_waitcnt vmcnt(0)" ::: "memory");
        } else {
            XB_SPIN(xb_ld(&bar[XB_XGEN(b.x)]) == gen, bar);
            __builtin_amdgcn_fence(__ATOMIC_ACQUIRE, "agent");
            asm volatile("s_waitcnt vmcnt(0)" ::: "memory");
        }
    }
    __syncthreads();
}

__global__ void __launch_bounds__(NTHREADS, 2) fwd_megakernel(Params p) {
    extern __shared__ __attribute__((aligned(16))) unsigned char lds[];
    cg::grid_group grid = cg::this_grid();
    unsigned char* ws = p.ws;
    bf16_t* xb = (bf16_t*)(ws + WS_XB);
    bf16_t* proj = (bf16_t*)(ws + WS_PROJ);
    bf16_t* mixed = (bf16_t*)(ws + WS_MIXED);
    bf16_t* hid = (bf16_t*)(ws + WS_HID);
    float* sumsq = (float*)(ws + WS_SUMSQ);

    volatile LAS unsigned* misc = (volatile LAS unsigned*)((LAS unsigned char*)lds + 131072);
    if (threadIdx.x < 16) misc[threadIdx.x] = 0u;
    __syncthreads();
    XcdBarrier bar = xcd_barrier_post((unsigned*)(ws + WS_BAR), misc + 8);
    phase_prologue(p, lds);
    grid.sync();
#pragma unroll 1
    for (int L = 0; L < DEPTH; ++L) {
        const float* xin = (L == 0) ? p.in[0] : p.out;
        float* ss1 = sumsq + (2 * L) * MTOK;
        float* ss2 = sumsq + (2 * L + 1) * MTOK;
        float* ss3 = (L + 1 < DEPTH) ? sumsq + (2 * L + 2) * MTOK : nullptr;
        run_gemm(lds, xb, (const bf16_t*)(ws + WS_WIN + L * WIN_LAYER), MTOK, NP, DM, EpiScale{proj, NP, ss1, 0});
        xcd_barrier(bar);
        phase_prep(p);
        phase_cmp_mfma(p, lds, L);
        phase_s5v2(p, lds, L);
        xcd_barrier(bar);
        phase_p3(p, lds, L);
        xcd_barrier(bar);
        run_gemm(lds, mixed, (const bf16_t*)(ws + WS_WOUT + L * WOUT_LAYER), MTOK, DM, DM, EpiResid{xin, p.out, xb, ss2});
        xcd_barrier(bar);
        run_gemm(lds, xb, (const bf16_t*)(ws + WS_W1 + L * W1_LAYER), MTOK, DFF, DM, EpiScale{hid, DFF, ss2, 1});
        xcd_barrier(bar);
        run_gemm(lds, hid, (const bf16_t*)(ws + WS_W2 + L * W2_LAYER), MTOK, DM, DFF, EpiResid{p.out, p.out, (L + 1 < DEPTH) ? xb : nullptr, ss3});
        if (L + 1 < DEPTH) xcd_barrier(bar);
    }
}

extern "C" void kernel_launch(void* const* d_in, const int* in_sizes, int n_in, void* d_out, int out_size, void* d_ws, size_t ws_size, hipStream_t stream) {
    static int grid = 0;
    if (grid == 0) {
        if (n_in != 25 || out_size != MTOK * DM || ws_size < WS_END) { fprintf(stderr, "kernel_launch: unexpected problem (n_in %d out %d ws %zu)\n", n_in, out_size, ws_size); grid = -1; return; }
        int dev = 0, cus = 0, per_cu = 0;
        (void)hipGetDevice(&dev);
        (void)hipDeviceGetAttribute(&cus, hipDeviceAttributeMultiprocessorCount, dev);
        (void)hipFuncSetAttribute((const void*)fwd_megakernel, hipFuncAttributeMaxDynamicSharedMemorySize, LDS_BYTES);
        (void)hipOccupancyMaxActiveBlocksPerMultiprocessor(&per_cu, (const void*)fwd_megakernel, NTHREADS, LDS_BYTES);
        if (per_cu < 1) { fprintf(stderr, "kernel_launch: occupancy query says %d blocks/CU\n", per_cu); grid = -1; return; }
        grid = cus;
    }
    if (grid < 0) return;
    (void)hipMemsetAsync((char*)d_ws + WS_CTL, 0, CTL_BYTES, stream);
    Params p{};
    for (int i = 0; i < 25; ++i) p.in[i] = (const float*)d_in[i];
    p.out = (float*)d_out; p.ws = (unsigned char*)d_ws;
    for (int j = 0; j < 64; ++j) p.inv128[j] = (float)pow(10000.0, -(double)(2 * j) / 128.0);
    for (int j = 0; j < 32; ++j) p.inv64[j] = (float)pow(10000.0, -(double)(2 * j) / 64.0);
    void* args[] = {&p};
    hipError_t e = hipLaunchCooperativeKernel((const void*)fwd_megakernel, dim3(grid), dim3(NTHREADS), args, LDS_BYTES, stream);
    if (e != hipSuccess) fprintf(stderr, "cooperative launch failed: %s (grid %d)\n", hipGetErrorString(e), grid);
}
```

```cpp
#include <hip/hip_runtime.h>
#include <hip/hip_cooperative_groups.h>
#include <cstdio>
#include <cstdint>
#include <cmath>
namespace cg = cooperative_groups;

typedef unsigned short bf16_t;
typedef short bf16x8 __attribute__((ext_vector_type(8)));
typedef float f32x4 __attribute__((ext_vector_type(4)));
typedef unsigned u32x2 __attribute__((ext_vector_type(2)));
typedef unsigned u32x4 __attribute__((ext_vector_type(4)));

constexpr int DM = 2048, NB = 4, SEQ = 2048, DEPTH = 2, MTOK = NB * SEQ;
constexpr int DFF = 8192, NIN = 5388, NP = 5632;
constexpr float EPS = 1e-6f;
constexpr int C_U = 0, C_RQ = 512, C_RK = 1024, C_RV = 1536, C_RG = 2048, C_NQ = 2560, C_NKC = 3072, C_NVC = 3200, C_NKS = 3328, C_NVS = 3456,
              C_NKW = 3584, C_NVW = 3712, C_DQ = 3840, C_DK = 4352, C_DV = 4864, C_GATE = 5376;
__host__ __device__ inline int orig_col(int c) { if (c < 3840) return c; if (c < 5376) return c + 12; if (c < 5388) return 3840 + (c - 5376); return -1; }

constexpr size_t MiB = 1u << 20;
constexpr size_t WS_CTL = 0, CTL_BYTES = 1 * MiB;
constexpr size_t WS_QUEUE = 8 * 1024;
constexpr size_t WS_CMPCNT = 10 * 1024;
constexpr size_t WS_LAM = 12 * 1024;
constexpr size_t WS_BAR = 16 * 1024;
constexpr size_t WS_SUMSQ = 64 * 1024;
constexpr size_t WS_ROPE128 = 1 * MiB;
constexpr size_t WS_ROPE64 = 5 * MiB;
constexpr size_t WS_S5PRE = 7 * MiB;
constexpr size_t S5PRE_LAYER = 32 * 64 * 8 + 32 * 64 * 16 * 8;
constexpr size_t WS_KVCMP = 8 * MiB;
constexpr size_t WS_KVCMPB = 9 * MiB;
constexpr size_t WS_WGLU = 10 * MiB;
constexpr size_t WS_WIN = 12 * MiB, WIN_LAYER = (size_t)NP * DM * 2;
constexpr size_t WS_WOUT = 56 * MiB, WOUT_LAYER = (size_t)DM * DM * 2;
constexpr size_t WS_W1 = 72 * MiB, W1_LAYER = (size_t)DFF * DM * 2;
constexpr size_t WS_W2 = 136 * MiB, W2_LAYER = (size_t)DM * DFF * 2;
constexpr size_t WS_XB = 200 * MiB;
constexpr size_t WS_MIXED = 232 * MiB;
constexpr size_t WS_S5Y = 264 * MiB;
constexpr size_t WS_HID = 272 * MiB;
constexpr size_t WS_PROJ = 272 * MiB;
constexpr size_t WS_WCMP = 400 * MiB;
constexpr size_t WS_KPART = 404 * MiB;
constexpr size_t WS_END = 406 * MiB;

constexpr int NTHREADS = 512, NWAVES = 8;
constexpr int LDS_BYTES = 147456;

struct Params {
    const float* in[25];
    float* out;
    unsigned char* ws;
    float inv128[64];
    float inv64[32];
    unsigned short order[576];
};

__device__ __forceinline__ float bf2f(bf16_t v) { return __uint_as_float((unsigned)v << 16); }
__device__ __forceinline__ unsigned f2bf(float f) { unsigned u = __float_as_uint(f); return (u + 0x7fffu + ((u >> 16) & 1u)) >> 16; }
__device__ __forceinline__ unsigned pk2(float lo, float hi) { return f2bf(lo) | (f2bf(hi) << 16); }
__device__ __forceinline__ float shx(float v, int o, int lane) { return __int_as_float(__builtin_amdgcn_ds_bpermute((lane ^ o) << 2, __float_as_int(v))); }
__device__ __forceinline__ float shl(float v, int src, int lane) { (void)lane; return __int_as_float(__builtin_amdgcn_ds_bpermute(src << 2, __float_as_int(v))); }
__device__ __forceinline__ float wave_sum(float v, int lane) {
#pragma unroll
    for (int o = 1; o < 64; o <<= 1) v += shx(v, o, lane);
    return v;
}
__device__ __forceinline__ float wave_max(float v, int lane) {
#pragma unroll
    for (int o = 1; o < 64; o <<= 1) v = fmaxf(v, shx(v, o, lane));
    return v;
}
__device__ __forceinline__ float half_sum(float v) { auto r = __builtin_amdgcn_permlane32_swap(__float_as_uint(v), __float_as_uint(v), false, false); return __uint_as_float(r[0]) + __uint_as_float(r[1]); }
__device__ __forceinline__ float half_max(float v) { auto r = __builtin_amdgcn_permlane32_swap(__float_as_uint(v), __float_as_uint(v), false, false); return fmaxf(__uint_as_float(r[0]), __uint_as_float(r[1])); }
#define LDS_WAIT() asm volatile("s_waitcnt lgkmcnt(0)" ::: "memory")
__device__ __forceinline__ int opaque_tid() { int t = (int)threadIdx.x; asm volatile("" : "+v"(t)); return t; }

__device__ __forceinline__ void transpose_item(const float* W, int K, int N, const float* gk, bf16_t* WT, bool winmap, float* scr, int item, int nblk, int lane) {
    const int kb = item / nblk, nb = item % nblk, k0 = 64 * kb, n0 = 32 * nb;
    const int c4 = (lane & 7) * 4, rr = lane >> 3;
    const int oc = winmap ? orig_col(n0 + c4) : n0 + c4;
    f32x4 v[8];
#pragma unroll
    for (int i = 0; i < 8; ++i) v[i] = (oc >= 0) ? *(const f32x4*)(W + (size_t)(k0 + 8 * i + rr) * N + oc) : (f32x4){0.f, 0.f, 0.f, 0.f};
#pragma unroll
    for (int i = 0; i < 8; ++i) {
        const int kk = 8 * i + rr;
        f32x4 t = v[i];
        if (gk) t = t * gk[k0 + kk];
        float* d = scr + kk * 33 + c4;
        d[0] = t.x; d[1] = t.y; d[2] = t.z; d[3] = t.w;
    }
    LDS_WAIT();
    const int c = lane & 7;
#pragma unroll
    for (int j = 0; j < 4; ++j) {
        const int nn = (lane >> 3) + 8 * j;
        const float* s = scr + (8 * c) * 33 + nn;
        u32x4 o;
        o.x = pk2(s[0 * 33], s[1 * 33]); o.y = pk2(s[2 * 33], s[3 * 33]); o.z = pk2(s[4 * 33], s[5 * 33]); o.w = pk2(s[6 * 33], s[7 * 33]);
        *(u32x4*)(WT + (size_t)(n0 + nn) * K + k0 + 8 * c) = o;
    }
    LDS_WAIT();
}

constexpr int I_IN = (DM / 64) * (NP / 32), I_OUT = (DM / 64) * (DM / 32), I_1 = (DM / 64) * (DFF / 32), I_2 = (DFF / 64) * (DM / 32), I_G = (512 / 64) * (512 / 32), I_C = (4096 / 64) * (128 / 32);
constexpr int I_LAYER = I_IN + I_OUT + I_1 + I_2 + I_G + 2 * I_C;
__device__ __forceinline__ void conv_wave_item(const Params& p, float* scr, int L, int r, int lane) {
    unsigned char* ws = p.ws;
    if (r < I_IN) { transpose_item(p.in[3] + (size_t)L * DM * NIN, DM, NIN, p.in[2] + L * DM, (bf16_t*)(ws + WS_WIN + L * WIN_LAYER), true, scr, r, NP / 32, lane); return; } r -= I_IN;
    if (r < I_OUT) { transpose_item(p.in[21] + (size_t)L * DM * DM, DM, DM, nullptr, (bf16_t*)(ws + WS_WOUT + L * WOUT_LAYER), false, scr, r, DM / 32, lane); return; } r -= I_OUT;
    if (r < I_1) { transpose_item(p.in[23] + (size_t)L * DM * DFF, DM, DFF, p.in[22] + L * DM, (bf16_t*)(ws + WS_W1 + L * W1_LAYER), false, scr, r, DFF / 32, lane); return; } r -= I_1;
    if (r < I_2) { transpose_item(p.in[24] + (size_t)L * DFF * DM, DFF, DM, nullptr, (bf16_t*)(ws + WS_W2 + L * W2_LAYER), false, scr, r, DM / 32, lane); return; } r -= I_2;
    if (r < I_G) { transpose_item(p.in[12] + (size_t)L * 512 * 512, 512, 512, nullptr, (bf16_t*)(ws + WS_WGLU + (size_t)L * 512 * 512 * 2), false, scr, r, 512 / 32, lane); return; } r -= I_G;
    { const int kv = r / I_C; r -= kv * I_C;
      transpose_item(p.in[15 + kv] + (size_t)L * 4096 * 128, 4096, 128, nullptr, (bf16_t*)(ws + WS_WCMP) + ((size_t)(L * 2 + kv)) * 128 * 4096, false, scr, r, 128 / 32, lane); }
}
constexpr int CONV_A = I_IN + I_G + 2 * I_C, CONV_B0 = I_OUT + I_1 + I_2, CONV_B = CONV_B0 + I_LAYER;
constexpr int CONV_A_BLK = CONV_A / 32, CONV_B_BLK = CONV_B / 32;
static_assert(CONV_A % 32 == 0 && CONV_B % 32 == 0, "conversion block-items");
__device__ __forceinline__ void conv_block_item(const Params& p, unsigned char* lds, int blk, int tid) {
    const int lane = tid & 63, wave = tid >> 6;
    float* scr = (float*)(lds + wave * 8448);
#pragma unroll 1
    for (int i = 0; i < 4; ++i) {
        int L = 0, r;
        if (blk < CONV_A_BLK) {
            const int a = blk * 32 + i * 8 + wave;
            r = a < I_IN ? a : (a < I_IN + I_G ? I_IN + I_OUT + I_1 + I_2 + (a - I_IN) : I_IN + I_OUT + I_1 + I_2 + I_G + (a - I_IN - I_G));
        } else {
            const int bidx = (blk - CONV_A_BLK) * 32 + i * 8 + wave;
            if (bidx < CONV_B0) r = I_IN + bidx; else { L = 1; r = bidx - CONV_B0; }
        }
        conv_wave_item(p, scr, L, r, lane);
    }
}
__device__ __forceinline__ void conv_fill(const Params& p, unsigned char* lds, int max_items) {
    const int tid = opaque_tid();
    volatile int* slot = (volatile int*)(lds + 131072 + 60);
    unsigned* qc = (unsigned*)(p.ws + WS_QUEUE) + 2 * 64;
    for (int n = 0; n < max_items; ++n) {
        if (tid == 0) *slot = (int)atomicAdd(qc, 1u);
        __syncthreads();
        const int q = *slot;
        __syncthreads();
        if (q >= CONV_B_BLK) break;
        conv_block_item(p, lds, CONV_A_BLK + q, tid);
    }
    __syncthreads();
}

__device__ void phase_prologue(const Params& p, unsigned char* lds) {
    const int tid = opaque_tid(), lane = tid & 63, wave = tid >> 6;
    const int gw = blockIdx.x * NWAVES + wave, NGW = gridDim.x * NWAVES;
    unsigned char* ws = p.ws;
    for (int blk = blockIdx.x; blk < CONV_A_BLK; blk += gridDim.x) conv_block_item(p, lds, blk, tid);
    if (blockIdx.x == gridDim.x - 1 && wave == 0) {
        for (int L = 0; L < DEPTH; ++L) {
            const float lam_init = 0.8f - 0.6f * expf(-0.3f * (float)L);
            const float a = p.in[17][L * 64 + lane] * p.in[18][L * 64 + lane];
            const float c = p.in[19][L * 64 + lane] * p.in[20][L * 64 + lane];
            const float lamv = expf(wave_sum(a, lane)) - expf(wave_sum(c, lane)) + lam_init;
            if (lane == 0) { float* lw = (float*)(ws + WS_LAM) + 2 * L; lw[0] = lamv; lw[1] = lam_init; }
        }
    }
    const float* x = p.in[0];
    bf16_t* xb = (bf16_t*)(ws + WS_XB);
    float* sumsq = (float*)(ws + WS_SUMSQ);
    const int* pos = (const int*)p.in[1];
    float2* r128 = (float2*)(ws + WS_ROPE128);
    float2* r64 = (float2*)(ws + WS_ROPE64);
    for (int m = gw; m < MTOK; m += NGW) {
        const f32x4* xr = (const f32x4*)(x + (size_t)m * DM);
        float ss = 0.f;
#pragma unroll
        for (int j = 0; j < 8; ++j) {
            const f32x4 v = xr[64 * j + lane];
            ss += v.x * v.x + v.y * v.y + v.z * v.z + v.w * v.w;
            u32x2 o; o.x = pk2(v.x, v.y); o.y = pk2(v.z, v.w);
            *(u32x2*)(xb + (size_t)m * DM + 4 * (64 * j + lane)) = o;
        }
        ss = wave_sum(ss, lane);
        if (lane == 0) sumsq[m] = ss;
        const float fp = (float)pos[m];
        { const float ang = fp * p.inv128[lane]; float s, c; sincosf(ang, &s, &c); r128[(size_t)m * 64 + lane] = make_float2(c, s); }
        if (lane < 32) { const float ang = fp * p.inv64[lane]; float s, c; sincosf(ang, &s, &c); r64[(size_t)m * 32 + lane] = make_float2(c, s); }
    }
    for (int it = (tid < 16 ? (int)blockIdx.x * 16 + tid : DEPTH * 32 * 64); it < DEPTH * 32 * 64; it += gridDim.x * 16) {
        const int L = it / (32 * 64), gp = it % (32 * 64), g = gp / 64;
        const float lr = p.in[4][(size_t)L * 2048 + gp], li = p.in[5][(size_t)L * 2048 + gp];
        const float dt = expf(p.in[6][L * 32 + g]);
        const float mag = expf(lr * dt);
        float sn, cs; sincosf(li * dt, &sn, &cs);
        const float lbr = mag * cs, lbi = mag * sn;
        const float den = lr * lr + li * li;
        const float fr = ((lbr - 1.0f) * lr + lbi * li) / den;
        const float fi = (lbi * lr - (lbr - 1.0f) * li) / den;
        unsigned char* pre = ws + WS_S5PRE + L * S5PRE_LAYER;
        float2* lb = (float2*)pre;
        bf16_t* bb16 = (bf16_t*)(pre + 16384);
        bf16_t* cm16 = (bf16_t*)(pre + 16384 + 131072);
        lb[gp] = make_float2(lbr, lbi);
        const int pst = gp & 63;
        const float* bre = p.in[7] + ((size_t)L * 2048 + gp) * 16;
        const float* bim = p.in[8] + ((size_t)L * 2048 + gp) * 16;
#pragma unroll
        for (int h = 0; h < 16; ++h) {
            bb16[((size_t)(g * 128 + 2 * pst)) * 16 + h] = (bf16_t)f2bf(fr * bre[h] - fi * bim[h]);
            bb16[((size_t)(g * 128 + 2 * pst + 1)) * 16 + h] = (bf16_t)f2bf(fr * bim[h] + fi * bre[h]);
        }
#pragma unroll
        for (int n = 0; n < 16; ++n) {
            const float cr = p.in[9][(((size_t)L * 32 + g) * 16 + n) * 64 + pst], ci = p.in[10][(((size_t)L * 32 + g) * 16 + n) * 64 + pst];
            *(unsigned*)(cm16 + ((size_t)(g * 16 + n)) * 128 + 2 * pst) = pk2(cr, -ci);
        }
    }
}

namespace pg8 {
#define PG8_LAS __attribute__((address_space(3)))
typedef unsigned short bf16_t;
typedef short bf16x8 __attribute__((ext_vector_type(8)));
typedef float f32x4 __attribute__((ext_vector_type(4)));
typedef unsigned u32x4 __attribute__((ext_vector_type(4)));
constexpr int BM = 256, BK = 64, HALF = 128, HTB = HALF * BK * 2  , STAGE_BYTES = 8 * HTB, NXCD = 8, WGM = 8;

__host__ __device__ __forceinline__ int lds_byte(int r, int c) { const int st = (r >> 4) * 2 + (c >> 5), rr = r & 15, cc = c & 31, ob = rr * 64 + cc * 2; return st * 1024 + (ob ^ (((ob >> 9) & 1) << 5)); }
__host__ __device__ __forceinline__ void stage_rc(int b, int& R, int& C) { const int st = b / 1024, sb = b % 1024, swz = sb ^ (((sb >> 9) & 1) << 5); R = (st >> 1) * 16 + swz / 64; C = (st & 1) * 32 + (swz % 64) / 2; }
__host__ __device__ __forceinline__ int perm32(int rho) { const int n = rho >> 4, i = rho & 15; return 8 * (i >> 2) + 4 * n + (i & 3); }

struct Unit { int pm, pn; };
struct Gemm { const bf16_t* A; const bf16_t* Bt; int M, N, K; };

struct StaticOrder {
    int nM, nN, nwg, G, c;
    __host__ __device__ void init(int M, int N, int G_, int c_) { nM = M / BM; nN = N / BM; nwg = nM * nN; G = G_; c = c_; }
    __host__ __device__ bool next(int i, Unit& u) const {
        const long L = (long)i * G + c; if (L >= nwg) return false;
        int wgid = (int)L; { const int q = nwg / NXCD, r = nwg % NXCD, xcd = wgid % NXCD, off = wgid / NXCD; wgid = (xcd < r ? xcd * (q + 1) : r * (q + 1) + (xcd - r) * q) + off; }
        const int nig = WGM * nN, gid = wgid / nig, fm = gid * WGM, gsz = (nM - fm) < WGM ? (nM - fm) : WGM;
        u.pm = fm + ((wgid % nig) % gsz); u.pn = (wgid % nig) / gsz; return true;
    }
    __device__ __forceinline__ void a_ready(const Unit&) const {}
    __device__ __forceinline__ void done(const Unit&) const {}
};

__device__ __forceinline__ unsigned cvt_pk_bf16(float lo, float hi) { unsigned r; asm volatile("v_cvt_pk_bf16_f32 %0, %1, %2" : "=v"(r) : "v"(lo), "v"(hi)); return r; }
template <class Epi, class Sched, bool ALIGN_EPI = false, bool SP2 = false>
__device__ __forceinline__ void gemm_phase(PG8_LAS unsigned char* lds, const Gemm g, const Sched& S, const Epi& E) {
    const int tid = opaque_tid(), wid = __builtin_amdgcn_readfirstlane(tid >> 6), lane = tid & 63, wr = wid >> 2, wc = wid & 3, fr = lane & 15, fq = lane >> 4;
    const int K = g.K, nt = K / BK;
    unsigned voffA[2], voffB[2];
#pragma unroll
    for (int i = 0; i < 2; ++i) { int R, C; stage_rc(tid * 16 + i * 8192, R, C); const int Rb = Epi::PERM ? ((R & ~31) + perm32(R & 31)) : R;
        voffA[i] = (unsigned)(R * K + C) * 2u; voffB[i] = (unsigned)(Rb * K + C) * 2u; }
    const size_t kstep = (size_t)(BK * 2);
    const size_t hstep = (size_t)HALF * K * 2;
    const size_t tstep = 2 * hstep;
    const unsigned ldsw = (unsigned)wid * 1024u;
    const int aoff = lds_byte(wr * 64 + fr, fq * 8), boff = lds_byte(wc * 32 + fr, fq * 8);
#define PG8_SA(b, h) (((b) * 2 + (h)) * HTB)
#define PG8_SB(b, h) ((4 + (b) * 2 + (h)) * HTB)
#define PG8_STAGE(bufoff, gbase, voff) do { _Pragma("unroll") for (int _i = 0; _i < 2; ++_i) \
        __builtin_amdgcn_global_load_lds((const unsigned*)((const char*)(gbase) + (voff)[_i]), (PG8_LAS unsigned*)(lds + (bufoff) + ldsw + _i * 8192), 16, 0, 0); } while (0)
#define PG8_LDA(dst, b, h) do { _Pragma("unroll") for (int m = 0; m < 4; ++m) _Pragma("unroll") for (int k = 0; k < 2; ++k) dst[m][k] = *(const PG8_LAS bf16x8*)(lds + PG8_SA(b, h) + aoff + m * 2048 + k * 1024); } while (0)
#define PG8_LDB(dst, b, h) do { _Pragma("unroll") for (int n = 0; n < 2; ++n) _Pragma("unroll") for (int k = 0; k < 2; ++k) dst[n][k] = *(const PG8_LAS bf16x8*)(lds + PG8_SB(b, h) + boff + n * 2048 + k * 1024); } while (0)
#define PG8_MMA(ai, bj, At, Bt) do { __builtin_amdgcn_s_setprio(1); _Pragma("unroll") for (int m = 0; m < 4; ++m) _Pragma("unroll") for (int n = 0; n < 2; ++n) _Pragma("unroll") for (int k = 0; k < 2; ++k) \
        acc[ai][bj][m][n] = __builtin_amdgcn_mfma_f32_16x16x32_bf16(Bt[n][k], At[m][k], acc[ai][bj][m][n], 0, 0, 0); __builtin_amdgcn_s_setprio(0); } while (0)
#define PG8_WAIT_V(n) asm volatile("s_waitcnt vmcnt(" #n ")" ::: "memory")
#define PG8_WAIT_L(n) asm volatile("s_waitcnt lgkmcnt(" #n ")" ::: "memory")
#define PG8_BAR __builtin_amdgcn_s_barrier()
#define PG8_SCHED __builtin_amdgcn_sched_barrier(0)
    Unit cur, nxt; int ui = 0;
    if (!S.next(0, cur)) return;
    f32x4 acc[2][2][4][2];
#pragma unroll
    for (int a = 0; a < 2; ++a)
#pragma unroll
        for (int b = 0; b < 2; ++b)
#pragma unroll
            for (int m = 0; m < 4; ++m)
#pragma unroll
                for (int n = 0; n < 2; ++n) acc[a][b][m][n] = (f32x4){0.f, 0.f, 0.f, 0.f};
    bf16x8 At[4][2], B0[2][2], B1[2][2];
    const char* cA = (const char*)g.A + (size_t)cur.pm * tstep; const char* cB = (const char*)g.Bt + (size_t)cur.pn * tstep;
    S.a_ready(cur);
    if constexpr (SP2) {
        PG8_STAGE(PG8_SB(0, 0), cB, voffB); PG8_STAGE(PG8_SB(0, 1), cB + hstep, voffB); PG8_STAGE(PG8_SA(0, 0), cA, voffA); PG8_STAGE(PG8_SA(0, 1), cA + hstep, voffA);
        if (wr == 1) PG8_BAR;
        PG8_WAIT_V(2); PG8_BAR;
        PG8_STAGE(PG8_SB(1, 0), cB + kstep, voffB); PG8_STAGE(PG8_SA(1, 0), cA + kstep, voffA); PG8_STAGE(PG8_SB(1, 1), cB + hstep + kstep, voffB);
        PG8_WAIT_V(6); PG8_BAR;
    } else {
        PG8_STAGE(PG8_SB(0, 0), cB, voffB); PG8_STAGE(PG8_SA(0, 0), cA, voffA); PG8_STAGE(PG8_SB(0, 1), cB + hstep, voffB); PG8_STAGE(PG8_SA(0, 1), cA + hstep, voffA);
        if (wr == 1) PG8_BAR;
        PG8_WAIT_V(4); PG8_BAR;
        PG8_STAGE(PG8_SB(1, 0), cB + kstep, voffB); PG8_STAGE(PG8_SA(1, 0), cA + kstep, voffA); PG8_STAGE(PG8_SB(1, 1), cB + hstep + kstep, voffB);
        PG8_WAIT_V(6); PG8_BAR;
    }
    for (;;) {
        const bool has_next = S.next(ui + 1, nxt);
        const char* nA = has_next ? (const char*)g.A + (size_t)nxt.pm * tstep : cA; const char* nB = has_next ? (const char*)g.Bt + (size_t)nxt.pn * tstep : cB;
        for (int t = 0; t < nt; t += 2) {
            const bool last = (t == nt - 2);
            const char* a1 = cA + (size_t)(t + 1) * kstep;
            const char* a2 = last ? nA : cA + (size_t)(t + 2) * kstep; const char* b2 = last ? nB : cB + (size_t)(t + 2) * kstep;
            const char* a3 = a2 + kstep; const char* b3 = b2 + kstep;
            if (last && has_next) S.a_ready(nxt);
            if constexpr (SP2) {
            PG8_LDB(B0, 0, 0); PG8_LDB(B1, 0, 1); PG8_SCHED; PG8_LDA(At, 0, 0); PG8_STAGE(PG8_SA(1, 1), a1 + hstep, voffA);
            PG8_WAIT_V(8); PG8_WAIT_L(0); PG8_BAR; PG8_MMA(0, 0, At, B0); PG8_MMA(0, 1, At, B1); PG8_BAR; PG8_SCHED;
            PG8_LDA(At, 0, 1); PG8_STAGE(PG8_SB(0, 0), b2, voffB); PG8_STAGE(PG8_SB(0, 1), b2 + hstep, voffB); PG8_STAGE(PG8_SA(0, 0), a2, voffA);
            PG8_WAIT_V(8); PG8_WAIT_L(0); PG8_BAR; PG8_MMA(1, 0, At, B0); PG8_MMA(1, 1, At, B1); PG8_BAR; PG8_SCHED;
            PG8_LDB(B0, 1, 0); PG8_LDB(B1, 1, 1); PG8_SCHED; PG8_LDA(At, 1, 0); PG8_STAGE(PG8_SA(0, 1), a2 + hstep, voffA);
            PG8_WAIT_V(8); PG8_WAIT_L(0); PG8_BAR; PG8_MMA(0, 0, At, B0); PG8_MMA(0, 1, At, B1); PG8_BAR; PG8_SCHED;
            PG8_LDA(At, 1, 1); PG8_STAGE(PG8_SB(1, 0), b3, voffB); PG8_STAGE(PG8_SB(1, 1), b3 + hstep, voffB); PG8_STAGE(PG8_SA(1, 0), a3, voffA);
            PG8_WAIT_V(8); PG8_WAIT_L(0); PG8_BAR; PG8_MMA(1, 0, At, B0); PG8_MMA(1, 1, At, B1); PG8_BAR; PG8_SCHED;
            } else {
            PG8_LDB(B0, 0, 0); PG8_SCHED; PG8_LDA(At, 0, 0); PG8_STAGE(PG8_SA(1, 1), a1 + hstep, voffA);
            PG8_WAIT_L(8); PG8_BAR; PG8_WAIT_L(0); PG8_MMA(0, 0, At, B0); PG8_BAR; PG8_SCHED;
            PG8_LDB(B1, 0, 1); PG8_STAGE(PG8_SB(0, 0), b2, voffB);
            PG8_BAR; PG8_WAIT_L(0); PG8_MMA(0, 1, At, B1); PG8_BAR;
            PG8_LDA(At, 0, 1); PG8_STAGE(PG8_SA(0, 0), a2, voffA);
            PG8_BAR; PG8_WAIT_L(0); PG8_MMA(1, 0, At, B0); PG8_BAR; PG8_SCHED;
            PG8_STAGE(PG8_SB(0, 1), b2 + hstep, voffB);
            PG8_WAIT_V(6); PG8_BAR; PG8_MMA(1, 1, At, B1); PG8_BAR;
            PG8_LDB(B0, 1, 0); PG8_SCHED; PG8_LDA(At, 1, 0); PG8_STAGE(PG8_SA(0, 1), a2 + hstep, voffA);
            PG8_WAIT_L(8); PG8_BAR; PG8_WAIT_L(0); PG8_MMA(0, 0, At, B0); PG8_BAR; PG8_SCHED;
            PG8_LDB(B1, 1, 1); PG8_STAGE(PG8_SB(1, 0), b3, voffB);
            PG8_BAR; PG8_WAIT_L(0); PG8_MMA(0, 1, At, B1); PG8_BAR;
            PG8_LDA(At, 1, 1); PG8_STAGE(PG8_SA(1, 0), a3, voffA);
            PG8_BAR; PG8_WAIT_L(0); PG8_MMA(1, 0, At, B0); PG8_BAR; PG8_SCHED;
            PG8_STAGE(PG8_SB(1, 1), b3 + hstep, voffB);
            PG8_WAIT_V(6); PG8_BAR; PG8_MMA(1, 1, At, B1); PG8_BAR;
            }
        }
        if constexpr (ALIGN_EPI) { if (wr == 0) PG8_BAR; }
        if constexpr (!Epi::AFTER_DRAIN) { E(acc, cur, wr, wc, fr, fq); S.done(cur); }
        if (!has_next) break;
#pragma unroll
        for (int a = 0; a < 2; ++a)
#pragma unroll
            for (int b = 0; b < 2; ++b)
#pragma unroll
                for (int m = 0; m < 4; ++m)
#pragma unroll
                    for (int n = 0; n < 2; ++n) acc[a][b][m][n] = (f32x4){0.f, 0.f, 0.f, 0.f};
        cur = nxt; cA = nA; cB = nB; ++ui;
        if constexpr (ALIGN_EPI) { if (wr == 1) PG8_BAR; }
    }
    PG8_WAIT_V(0);
    if constexpr (!ALIGN_EPI) { if (wr == 0) PG8_BAR; }
    PG8_BAR;
    if constexpr (Epi::AFTER_DRAIN) { E.fused(acc, cur, wr, wc, fr, fq, lds, wid, lane); S.done(cur); }
#undef PG8_SA
#undef PG8_SB
#undef PG8_STAGE
#undef PG8_LDA
#undef PG8_LDB
#undef PG8_MMA
#undef PG8_WAIT_V
#undef PG8_WAIT_L
#undef PG8_BAR
#undef PG8_SCHED
}
}

struct EpiScale {
    static constexpr bool PERM = true, AFTER_DRAIN = false;
    bf16_t* O; int ldc; const float* sumsq; int relu2;
    __device__ __forceinline__ void operator()(const f32x4 (&acc)[2][2][4][2], const pg8::Unit& u, int wr, int wc, int fr, int fq) const {
        const int row0 = u.pm * 256 + wr * 64 + fr, col0 = u.pn * 256 + wc * 32 + 8 * fq;
        float rs[2][4];
#pragma unroll
        for (int ai = 0; ai < 2; ++ai)
#pragma unroll
            for (int m = 0; m < 4; ++m) rs[ai][m] = sumsq[row0 + ai * 128 + m * 16];
#pragma unroll
        for (int ai = 0; ai < 2; ++ai)
#pragma unroll
            for (int m = 0; m < 4; ++m) {
                const int row = row0 + ai * 128 + m * 16;
                const float rstd = rsqrtf(rs[ai][m] * (1.0f / DM) + EPS);
                bf16_t* rowp = O + (size_t)row * ldc + col0;
#pragma unroll
                for (int bj = 0; bj < 2; ++bj) {
                    f32x4 v0 = acc[ai][bj][m][0] * rstd, v1 = acc[ai][bj][m][1] * rstd;
                    if (relu2) {
                        v0.x = fmaxf(v0.x, 0.f); v0.y = fmaxf(v0.y, 0.f); v0.z = fmaxf(v0.z, 0.f); v0.w = fmaxf(v0.w, 0.f);
                        v1.x = fmaxf(v1.x, 0.f); v1.y = fmaxf(v1.y, 0.f); v1.z = fmaxf(v1.z, 0.f); v1.w = fmaxf(v1.w, 0.f);
                        v0 = v0 * v0; v1 = v1 * v1;
                    }
                    u32x4 w; w.x = pg8::cvt_pk_bf16(v0[0], v0[1]); w.y = pg8::cvt_pk_bf16(v0[2], v0[3]); w.z = pg8::cvt_pk_bf16(v1[0], v1[1]); w.w = pg8::cvt_pk_bf16(v1[2], v1[3]);
                    *(u32x4*)(rowp + bj * 128) = w;
                }
                asm volatile("" ::: "memory");
            }
    }
};
struct EpiResid {
    static constexpr bool PERM = false, AFTER_DRAIN = false;
    bf16_t* xb; float* xout; int write_xb; float* sumsq_next;
    __device__ __forceinline__ void operator()(const f32x4 (&acc)[2][2][4][2], const pg8::Unit& u, int wr, int wc, int fr, int fq) const {
        const int row0 = u.pm * 256 + wr * 64 + fr, col0 = u.pn * 256 + wc * 32 + 4 * fq;
        u32x2 res[4][2][2];
#define EPR_LOAD(slot, g) do { const int row_ = row0 + ((g) >> 2) * 128 + ((g) & 3) * 16; _Pragma("unroll") for (int bj = 0; bj < 2; ++bj) _Pragma("unroll") for (int n = 0; n < 2; ++n) \
        res[slot][bj][n] = *(const u32x2*)(xb + (size_t)row_ * DM + col0 + bj * 128 + n * 16); } while (0)
        EPR_LOAD(0, 0); EPR_LOAD(1, 1); EPR_LOAD(2, 2);
#pragma unroll
        for (int g = 0; g < 8; ++g) {
            const int ai = g >> 2, m = g & 3, row = row0 + ai * 128 + m * 16;
            if (g + 3 < 8) { if (((g + 3) & 3) == 0) EPR_LOAD(0, g + 3); else if (((g + 3) & 3) == 1) EPR_LOAD(1, g + 3); else if (((g + 3) & 3) == 2) EPR_LOAD(2, g + 3); else EPR_LOAD(3, g + 3); }
            float ss = 0.f;
#pragma unroll
            for (int bj = 0; bj < 2; ++bj)
#pragma unroll
                for (int n = 0; n < 2; ++n) {
                    const size_t off = (size_t)row * DM + col0 + bj * 128 + n * 16;
                    const u32x2 rb = res[g & 3][bj][n];
                    f32x4 v = acc[ai][bj][m][n];
                    v[0] += __uint_as_float(rb.x << 16); v[1] += __uint_as_float(rb.x & 0xffff0000u); v[2] += __uint_as_float(rb.y << 16); v[3] += __uint_as_float(rb.y & 0xffff0000u);
                    if (xout) *(f32x4*)(xout + off) = v;
                    if (write_xb) { u32x2 o; o.x = pg8::cvt_pk_bf16(v[0], v[1]); o.y = pg8::cvt_pk_bf16(v[2], v[3]); *(u32x2*)(xb + off) = o; }
                    ss += (v[0] * v[0] + v[1] * v[1]) + (v[2] * v[2] + v[3] * v[3]);
                }
            if (sumsq_next) {
                ss += shx(ss, 16, fq * 16 + fr); ss += shx(ss, 32, fq * 16 + fr);
                if (fq == 0) atomicAdd(sumsq_next + row, ss);
            }
            asm volatile("" ::: "memory");
        }
#undef EPR_LOAD
    }
};
struct EpiGlu {
    static constexpr bool PERM = true, AFTER_DRAIN = false;
    const bf16_t* y; bf16_t* mixed;
    __device__ __forceinline__ void operator()(const f32x4 (&acc)[2][2][4][2], const pg8::Unit& u, int wr, int wc, int fr, int fq) const {
        const int row0 = u.pm * 256 + wr * 64 + fr, col0 = u.pn * 256 + wc * 32 + 8 * fq;
#pragma unroll
        for (int ai = 0; ai < 2; ++ai)
#pragma unroll
            for (int m = 0; m < 4; ++m) {
                const int row = row0 + ai * 128 + m * 16;
#pragma unroll
                for (int bj = 0; bj < 2; ++bj) {
                    const int col = col0 + bj * 128;
                    const u32x4 yv = *(const u32x4*)(y + (size_t)row * 512 + col);
                    const f32x4 a0 = acc[ai][bj][m][0], a1 = acc[ai][bj][m][1];
                    float r[8];
#pragma unroll
                    for (int e = 0; e < 4; ++e) {
                        const unsigned w = yv[e];
                        const float ylo = __uint_as_float(w << 16), yhi = __uint_as_float(w & 0xffff0000u);
                        const float alo = e < 2 ? a0[2 * e] : a1[2 * (e - 2)], ahi = e < 2 ? a0[2 * e + 1] : a1[2 * (e - 2) + 1];
                        r[2 * e] = ylo / (1.f + __expf(-alo)); r[2 * e + 1] = yhi / (1.f + __expf(-ahi));
                    }
                    u32x4 w; w.x = pg8::cvt_pk_bf16(r[0], r[1]); w.y = pg8::cvt_pk_bf16(r[2], r[3]); w.z = pg8::cvt_pk_bf16(r[4], r[5]); w.w = pg8::cvt_pk_bf16(r[6], r[7]);
                    *(u32x4*)(mixed + (size_t)row * DM + col) = w;
                }
                asm volatile("" ::: "memory");
            }
    }
};
template <class Epi>
__device__ __forceinline__ void run_gemm(unsigned char* lds, const bf16_t* A, const bf16_t* Bt, int M, int N, int K, const Epi& E) {
    pg8::Gemm g{A, Bt, M, N, K};
    pg8::StaticOrder S; S.init(M, N, (int)gridDim.x, (int)blockIdx.x);
    pg8::gemm_phase<Epi, pg8::StaticOrder, true, true>((PG8_LAS unsigned char*)lds, g, S, E);
}

namespace att {
#define ATT_LAS __attribute__((address_space(3)))
typedef float f32x16 __attribute__((ext_vector_type(16)));
typedef short s16x4 __attribute__((ext_vector_type(4)));
typedef ATT_LAS const unsigned char* ldscp;
typedef ATT_LAS unsigned char* ldsp;
constexpr int TILE = 16384, BUFB = 32768;
constexpr float NEG = -1e30f;
__device__ __forceinline__ unsigned off_b(unsigned row, unsigned ch) { return 256u * row + 16u * (ch ^ (((row & 3u) << 2) | ((row >> 2) & 3u))); }
__device__ __forceinline__ int crow(int r, int hi) { return (r & 3) + 8 * (r >> 2) + 4 * hi; }

struct Stage { int dummy; };
__device__ __forceinline__ void stage_dma(const bf16_t* K, int kpitch, const bf16_t* V, int vpitch, int key0, int kmax, ldsp buf, int tid) {
    const int lane = tid & 63, wv = __builtin_amdgcn_readfirstlane(tid >> 6);
#pragma unroll
    for (int h = 0; h < 2; ++h) {
        const int i = wv + 8 * h;
        const int r = 4 * i + (lane >> 4), s = lane & 15;
        const int ch = s ^ (((r & 3) << 2) | ((r >> 2) & 3));
        int kr = key0 + r; kr = kr < 0 ? 0 : (kr > kmax ? kmax : kr);
        __builtin_amdgcn_global_load_lds((const unsigned*)(K + (size_t)kr * kpitch + 8 * ch), (ATT_LAS unsigned*)(buf + i * 1024), 16, 0, 0);
        __builtin_amdgcn_global_load_lds((const unsigned*)(V + (size_t)kr * vpitch + 8 * ch), (ATT_LAS unsigned*)(buf + TILE + i * 1024), 16, 0, 0);
    }
}
#define ATT_DMA_WAIT() asm volatile("s_waitcnt vmcnt(0)" ::: "memory")
constexpr int NRING = 4;
__device__ __forceinline__ void ring_wait(int rem) {
    if (rem >= 2) asm volatile("s_waitcnt vmcnt(8)" ::: "memory");
    else if (rem == 1) asm volatile("s_waitcnt vmcnt(4)" ::: "memory");
    else asm volatile("s_waitcnt vmcnt(0)" ::: "memory");
}
struct WaveCtx { int lane, r32, hi, kch0; };
__device__ __forceinline__ void ctx_init(WaveCtx& w, int lane, int kch0) { w.lane = lane; w.r32 = lane & 31; w.hi = lane >> 5; w.kch0 = kch0; }
#define ATT_SB() __builtin_amdgcn_sched_barrier(0)
template <int NKS>
__device__ __forceinline__ void qk(ldscp Kt, const WaveCtx& w, const bf16x8 (&qf)[NKS], f32x16& p0, f32x16& p1) {
#pragma unroll
    for (int r = 0; r < 16; ++r) { p0[r] = 0.f; p1[r] = 0.f; }
    int ln = w.lane; asm volatile("" : "+v"(ln));
    const unsigned r32 = ln & 31, hi = ln >> 5;
    bf16x8 ka[3][2];
#define ATT_KLOAD(buf, b) do { const unsigned ko = off_b(r32, (w.kch0 + 2 * (b) + hi) & 15); \
        ka[buf][0] = *(const ATT_LAS bf16x8*)(Kt + ko); ka[buf][1] = *(const ATT_LAS bf16x8*)(Kt + ko + 8192); } while (0)
#define ATT_KMMA(buf, b) do { \
        p0 = __builtin_amdgcn_mfma_f32_32x32x16_bf16(ka[buf][0], qf[b], p0, 0, 0, 0); \
        p1 = __builtin_amdgcn_mfma_f32_32x32x16_bf16(ka[buf][1], qf[b], p1, 0, 0, 0); } while (0)
    ATT_KLOAD(0, 0); ATT_KLOAD(1, 1); ATT_SB();
#pragma unroll
    for (int b = 0; b < NKS; ++b) {
        if (b + 2 < NKS) { if (b % 3 == 0) ATT_KLOAD(2, b + 2); else if (b % 3 == 1) ATT_KLOAD(0, b + 2); else ATT_KLOAD(1, b + 2); }
        if (b % 3 == 0) ATT_KMMA(0, b); else if (b % 3 == 1) ATT_KMMA(1, b); else ATT_KMMA(2, b);
        if (b + 2 < NKS) __builtin_amdgcn_sched_group_barrier(0x100, 2, 0);
        __builtin_amdgcn_sched_group_barrier(0x008, 2, 0);
        ATT_SB();
    }
#undef ATT_KLOAD
#undef ATT_KMMA
}
__device__ __forceinline__ s16x4 trd(unsigned addr, int off) { s16x4 r; asm volatile("ds_read_b64_tr_b16 %0, %1 offset:%c2" : "=v"(r) : "v"(addr), "i"(off)); return r; }
__device__ __forceinline__ void pv(ldscp Vt, const WaveCtx& w, const bf16x8 (&pf)[2][2], f32x16 (&o)[4]) {
    int ln = w.lane; asm volatile("" : "+v"(ln));
    const unsigned hh = ln >> 5, blk = (ln >> 4) & 1, q = (ln & 15) >> 2, pp = ln & 3;
    const unsigned vbase = (unsigned)(uintptr_t)Vt;
    s16x4 vl[2][4], vh[2][4];
#define ATT_VLOAD(buf, c) do { const unsigned vo0 = vbase + off_b(4 * hh + q, 4 * (c) + 2 * blk + (pp >> 1)) + 8 * (pp & 1), vo1 = vbase + off_b(8 + 4 * hh + q, 4 * (c) + 2 * blk + (pp >> 1)) + 8 * (pp & 1); \
        vl[buf][0] = trd(vo0, 0); vh[buf][0] = trd(vo1, 0); vl[buf][1] = trd(vo0, 4096); vh[buf][1] = trd(vo1, 4096); \
        vl[buf][2] = trd(vo0, 8192); vh[buf][2] = trd(vo1, 8192); vl[buf][3] = trd(vo0, 12288); vh[buf][3] = trd(vo1, 12288); } while (0)
#define ATT_VMMA(buf, c) do { _Pragma("unroll") for (int kb = 0; kb < 2; ++kb) _Pragma("unroll") for (int s = 0; s < 2; ++s) { \
            const s16x4 lo = vl[buf][2 * kb + s], hi4 = vh[buf][2 * kb + s]; \
            const bf16x8 vf = (bf16x8){lo[0], lo[1], lo[2], lo[3], hi4[0], hi4[1], hi4[2], hi4[3]}; \
            o[c] = __builtin_amdgcn_mfma_f32_32x32x16_bf16(vf, pf[kb][s], o[c], 0, 0, 0); } } while (0)
#define ATT_LWAIT(n) do { asm volatile("s_waitcnt lgkmcnt(" #n ")" ::: "memory"); ATT_SB(); } while (0)
    asm volatile("s_waitcnt lgkmcnt(0)" ::: "memory"); ATT_SB();
    ATT_VLOAD(0, 0); ATT_SB();
    ATT_VLOAD(1, 1); ATT_LWAIT(8); ATT_VMMA(0, 0); ATT_SB();
    ATT_VLOAD(0, 2); ATT_LWAIT(8); ATT_VMMA(1, 1); ATT_SB();
    ATT_VLOAD(1, 3); ATT_LWAIT(8); ATT_VMMA(0, 2); ATT_SB();
    ATT_LWAIT(0); ATT_VMMA(1, 3); ATT_SB();
#undef ATT_VLOAD
#undef ATT_VMMA
#undef ATT_LWAIT
}
__device__ __forceinline__ void pack_p(const f32x16& p0, const f32x16& p1, bf16x8 (&pf)[2][2]) {
#pragma unroll
    for (int s = 0; s < 2; ++s) {
        u32x4 a, b;
#pragma unroll
        for (int i = 0; i < 4; ++i) { a[i] = pg8::cvt_pk_bf16(p0[8 * s + 2 * i], p0[8 * s + 2 * i + 1]); b[i] = pg8::cvt_pk_bf16(p1[8 * s + 2 * i], p1[8 * s + 2 * i + 1]); }
        pf[0][s] = __builtin_bit_cast(bf16x8, a); pf[1][s] = __builtin_bit_cast(bf16x8, b);
    }
}
__device__ __forceinline__ void apply_bounds(f32x16& p0, f32x16& p1, int klo, int khi, int hi) {
#pragma unroll
    for (int r = 0; r < 16; ++r) {
        const int k = crow(r, hi);
        if (k < klo || k > khi) p0[r] = NEG;
        if (k + 32 < klo || k + 32 > khi) p1[r] = NEG;
    }
}
__device__ __forceinline__ float ex2(float x) { return __builtin_amdgcn_exp2f(x); }
template <int NKS>
__device__ __forceinline__ void tile_softmax(ldscp Kt, ldscp Vt, const WaveCtx& w, const bf16x8 (&qf)[NKS], f32x16 (&o)[4], float& m, float& l, float c, bool need_mask, int klo, int khi) {
    f32x16 p0, p1;
    qk<NKS>(Kt, w, qf, p0, p1);
    if (need_mask) apply_bounds(p0, p1, klo, khi, w.hi);
    float mx = fmaxf(p0[0], p1[0]);
#pragma unroll
    for (int r = 1; r < 16; ++r) mx = fmaxf(mx, fmaxf(p0[r], p1[r]));
    mx = half_max(mx);
    const float mnew = fmaxf(m, mx * c);
    const float alpha = ex2(m - mnew);
    m = mnew;
    float ls = 0.f;
#pragma unroll
    for (int r = 0; r < 16; ++r) { p0[r] = ex2(fmaf(p0[r], c, -mnew)); p1[r] = ex2(fmaf(p1[r], c, -mnew)); ls += p0[r] + p1[r]; }
    l = l * alpha + ls;
    if (__any(alpha != 1.f)) {
#pragma unroll
        for (int cc = 0; cc < 4; ++cc)
#pragma unroll
            for (int r = 0; r < 16; ++r) o[cc][r] *= alpha;
    }
    bf16x8 pf[2][2];
    pack_p(p0, p1, pf);
    pv(Vt, w, pf, o);
}
}

__device__ __forceinline__ float row16_sum(float v) {
    v += __int_as_float(__builtin_amdgcn_mov_dpp(__float_as_int(v), 0xB1, 0xF, 0xF, true));
    v += __int_as_float(__builtin_amdgcn_mov_dpp(__float_as_int(v), 0x4E, 0xF, 0xF, true));
    v += __int_as_float(__builtin_amdgcn_mov_dpp(__float_as_int(v), 0x141, 0xF, 0xF, true));
    v += __int_as_float(__builtin_amdgcn_mov_dpp(__float_as_int(v), 0x140, 0xF, 0xF, true));
    return v;
}
__device__ void phase_prep(const Params& p) {
    const int tid = opaque_tid(), lane = tid & 63, wave = tid >> 6;
    if ((int)blockIdx.x < (int)gridDim.x / 2) return;
    const int gw = ((int)blockIdx.x - (int)gridDim.x / 2) * NWAVES + wave, NGW = ((int)gridDim.x - (int)gridDim.x / 2) * NWAVES;
    bf16_t* proj = (bf16_t*)(p.ws + WS_PROJ);
    const float2* r128 = (const float2*)(p.ws + WS_ROPE128);
    const float2* r64 = (const float2*)(p.ws + WS_ROPE64);
    const bool up32 = lane >= 32, up16 = (lane & 16) != 0;
    for (int m0 = 2 * gw; m0 < MTOK; m0 += 2 * NGW) {
        unsigned xa[2][14], ya[2][8]; f32x4 ca[2], cb[2];
#pragma unroll
        for (int t = 0; t < 2; ++t) {
            const bf16_t* row = proj + (size_t)(m0 + t) * NP;
            ca[t] = *(const f32x4*)(r128 + (size_t)(m0 + t) * 64 + 2 * (lane & 31));
            cb[t] = *(const f32x4*)(r64 + (size_t)(m0 + t) * 32 + 2 * (lane & 15));
#pragma unroll
            for (int hh = 0; hh < 14; ++hh) {
                const int col = hh < 4 ? C_RQ + hh * 128 : (hh < 8 ? C_RK + (hh - 4) * 128 : (hh < 12 ? C_NQ + (hh - 8) * 128 : (hh == 12 ? C_NKS : C_NKW)));
                xa[t][hh] = *(const unsigned*)(row + col + 2 * lane);
            }
#pragma unroll
            for (int hp = 0; hp < 8; ++hp) {
                const int col = hp < 4 ? C_DQ + hp * 128 : C_DK + (hp - 4) * 128;
                ya[t][hp] = *(const unsigned*)(row + col + 2 * lane);
            }
        }
#pragma unroll
        for (int t = 0; t < 2; ++t) {
            bf16_t* row = proj + (size_t)(m0 + t) * NP;
#pragma unroll
            for (int hh = 0; hh < 14; ++hh) {
                const int col = hh < 4 ? C_RQ + hh * 128 : (hh < 8 ? C_RK + (hh - 4) * 128 : (hh < 12 ? C_NQ + (hh - 8) * 128 : (hh == 12 ? C_NKS : C_NKW)));
                const unsigned v = xa[t][hh];
                const auto sw = __builtin_amdgcn_permlane32_swap(v, v, false, false);
                const unsigned pv_ = sw[0] ^ sw[1] ^ v;
                float o0 = __uint_as_float(v << 16), o1 = __uint_as_float(v & 0xffff0000u), q0 = __uint_as_float(pv_ << 16), q1 = __uint_as_float(pv_ & 0xffff0000u);
                float mul = (hh >= 4 && hh < 8) ? 0.08838834764831845f : 1.f;
                if (hh >= 8) {
                    const float rsum = row16_sum(o0 * o0 + o1 * o1);
                    const float tot = (__int_as_float(__builtin_amdgcn_readlane(__float_as_int(rsum), 0)) + __int_as_float(__builtin_amdgcn_readlane(__float_as_int(rsum), 16)))
                                    + (__int_as_float(__builtin_amdgcn_readlane(__float_as_int(rsum), 32)) + __int_as_float(__builtin_amdgcn_readlane(__float_as_int(rsum), 48)));
                    mul = rsqrtf(tot * (1.f / 128.f) + EPS);
                }
                o0 *= mul; o1 *= mul; q0 *= mul; q1 *= mul;
                const float sg = up32 ? 1.f : -1.f;
                const float r0 = o0 * ca[t].x + sg * q0 * ca[t].y, r1 = o1 * ca[t].z + sg * q1 * ca[t].w;
                *(unsigned*)(row + col + 2 * lane) = pg8::cvt_pk_bf16(r0, r1);
            }
#pragma unroll
            for (int hp = 0; hp < 8; ++hp) {
                const int col = hp < 4 ? C_DQ + hp * 128 : C_DK + (hp - 4) * 128;
                const unsigned v = ya[t][hp];
                const auto sw = __builtin_amdgcn_permlane16_swap(v, v, false, false);
                const unsigned pv_ = sw[0] ^ sw[1] ^ v;
                float o0 = __uint_as_float(v << 16), o1 = __uint_as_float(v & 0xffff0000u), q0 = __uint_as_float(pv_ << 16), q1 = __uint_as_float(pv_ & 0xffff0000u);
                const float rsum = row16_sum(o0 * o0 + o1 * o1);
                const float h0 = __int_as_float(__builtin_amdgcn_readlane(__float_as_int(rsum), 0)) + __int_as_float(__builtin_amdgcn_readlane(__float_as_int(rsum), 16));
                const float h1 = __int_as_float(__builtin_amdgcn_readlane(__float_as_int(rsum), 32)) + __int_as_float(__builtin_amdgcn_readlane(__float_as_int(rsum), 48));
                const float mul = rsqrtf((up32 ? h1 : h0) * (1.f / 64.f) + EPS);
                o0 *= mul; o1 *= mul; q0 *= mul; q1 *= mul;
                const float sg = up16 ? 1.f : -1.f;
                const float r0 = o0 * cb[t].x + sg * q0 * cb[t].y, r1 = o1 * cb[t].z + sg * q1 * cb[t].w;
                *(unsigned*)(row + col + 2 * lane) = pg8::cvt_pk_bf16(r0, r1);
            }
        }
    }
}

__device__ __forceinline__ void diff_unit(const Params& p, unsigned char* lds, int unit, float lam, float lam_init) {
    const int tid = opaque_tid(), lane = tid & 63, wave = __builtin_amdgcn_readfirstlane(tid >> 6);
    const int qb = 15 - (unit & 15), bh = unit >> 4, h = bh & 3, b = bh >> 2;
    const int comp = wave >> 2, qsub = wave & 3, q0 = qb * 128 + qsub * 32;
    att::WaveCtx w; att::ctx_init(w, lane, 8 * comp);
    const int tq = q0 + w.r32;
    const bf16_t* base = (const bf16_t*)(p.ws + WS_PROJ) + (size_t)b * SEQ * NP;
    bf16x8 qf[4];
#pragma unroll
    for (int ks = 0; ks < 4; ++ks) qf[ks] = *(const bf16x8*)(base + (size_t)tq * NP + C_DQ + h * 128 + comp * 64 + 16 * ks + 8 * w.hi);
    att::f32x16 o[4];
#pragma unroll
    for (int c = 0; c < 4; ++c)
#pragma unroll
        for (int r = 0; r < 16; ++r) o[c][r] = 0.f;
    float m = att::NEG, l = 0.f;
    const float csc = 0.125f * 1.4426950408889634f;
    const bf16_t* Kg = base + C_DK + h * 128; const bf16_t* Vg = base + C_DV + h * 128;
    const int nt = 2 * qb + 2;
    att::ldsp L3 = (att::ldsp)lds;
    ATT_DMA_WAIT();
#pragma unroll
    for (int ks = 0; ks < 4; ++ks) asm volatile("" : "+v"(qf[ks]));
    int issued = 0;
    for (; issued < nt && issued < att::NRING - 1; ++issued) att::stage_dma(Kg, NP, Vg, NP, issued * 64, SEQ - 1, L3 + issued * att::BUFB, tid);
    for (int kt = 0; kt < nt; ++kt) {
        att::ring_wait(issued - 1 - kt);
        __syncthreads();
        if (issued < nt) { att::stage_dma(Kg, NP, Vg, NP, issued * 64, SEQ - 1, L3 + (issued & (att::NRING - 1)) * att::BUFB, tid); ++issued; }
        const int cur = kt & (att::NRING - 1);
        const int key0 = kt * 64;
        if (key0 <= q0 + 31)
            att::tile_softmax<4>((att::ldscp)(L3 + cur * att::BUFB), (att::ldscp)(L3 + cur * att::BUFB + att::TILE), w, qf, o, m, l, csc, key0 + 63 > q0, 0, tq - key0);
    }
    __syncthreads();
    const float linv = 1.f / half_sum(l);
    float* cb = (float*)lds;
    if (comp == 1) {
#pragma unroll
        for (int c = 0; c < 4; ++c)
#pragma unroll
            for (int r = 0; r < 16; ++r) cb[(qsub * 128 + 32 * c + att::crow(r, w.hi)) * 32 + w.r32] = o[c][r] * linv * lam;
    }
    __syncthreads();
    if (comp == 0) {
        float ss = 0.f;
#pragma unroll
        for (int c = 0; c < 4; ++c)
#pragma unroll
            for (int r = 0; r < 16; ++r) { const float v = o[c][r] * linv - cb[(qsub * 128 + 32 * c + att::crow(r, w.hi)) * 32 + w.r32]; o[c][r] = v; ss += v * v; }
        ss = half_sum(ss);
        const float sc = rsqrtf(ss * (1.f / 128.f) + EPS) * (1.f - lam_init);
        bf16_t* orow = (bf16_t*)(p.ws + WS_MIXED) + ((size_t)b * SEQ + tq) * DM + 1536 + h * 128;
#pragma unroll
        for (int c = 0; c < 4; ++c)
#pragma unroll
            for (int g = 0; g < 4; ++g) {
                u32x2 v; v.x = pg8::cvt_pk_bf16(o[c][4 * g] * sc, o[c][4 * g + 1] * sc); v.y = pg8::cvt_pk_bf16(o[c][4 * g + 2] * sc, o[c][4 * g + 3] * sc);
                *(u32x2*)(orow + 32 * c + 8 * g + 4 * w.hi) = v;
            }
    }
    __syncthreads();
}
__device__ void phase_diff_mfma(const Params& p, unsigned char* lds, int L) {
    const int lane = opaque_tid() & 63;
    const float lam_init = 0.8f - 0.6f * expf(-0.3f * (float)L);
    const float a = p.in[17][L * 64 + lane] * p.in[18][L * 64 + lane];
    const float c = p.in[19][L * 64 + lane] * p.in[20][L * 64 + lane];
    const float lam = expf(wave_sum(a, lane)) - expf(wave_sum(c, lane)) + lam_init;
    for (int unit = blockIdx.x; unit < NB * 4 * 16; unit += gridDim.x) diff_unit(p, lds, unit, lam, lam_init);
}

template <int NKS>
__device__ __forceinline__ void tile_decay(att::ldscp Kt, att::ldscp Vt, const att::WaveCtx& w, const bf16x8 (&qf)[NKS], att::f32x16 (&o)[4], float log2g, int dq, bool need_mask) {
    att::f32x16 p0, p1;
    att::qk<NKS>(Kt, w, qf, p0, p1);
#pragma unroll
    for (int r = 0; r < 16; ++r) {
        const int d0 = dq - att::crow(r, w.hi), d1 = d0 - 32;
        const float f0 = att::ex2(log2g * (float)d0), f1 = att::ex2(log2g * (float)d1);
        p0[r] = (need_mask && d0 < 0) ? 0.f : p0[r] * f0;
        p1[r] = (need_mask && d1 < 0) ? 0.f : p1[r] * f1;
    }
    bf16x8 pf[2][2];
    att::pack_p(p0, p1, pf);
    att::pv(Vt, w, pf, o);
}
__device__ __forceinline__ void ret_unit(const Params& p, unsigned char* lds, int unit) {
    const int tid = opaque_tid(), lane = tid & 63, wave = __builtin_amdgcn_readfirstlane(tid >> 6);
    const int qb = 7 - (unit & 7), bh = unit >> 3, h = bh & 3, b = bh >> 2;
    const int q0 = qb * 256 + wave * 32;
    att::WaveCtx w; att::ctx_init(w, lane, 0);
    const int tq = q0 + w.r32;
    const bf16_t* base = (const bf16_t*)(p.ws + WS_PROJ) + (size_t)b * SEQ * NP;
    bf16x8 qf[8];
#pragma unroll
    for (int ks = 0; ks < 8; ++ks) qf[ks] = *(const bf16x8*)(base + (size_t)tq * NP + C_RQ + h * 128 + 16 * ks + 8 * w.hi);
    att::f32x16 o[4];
#pragma unroll
    for (int c = 0; c < 4; ++c)
#pragma unroll
        for (int r = 0; r < 16; ++r) o[c][r] = 0.f;
    const float log2g = log2f(1.0f - exp2f(-5.0f - (float)h));
    const bf16_t* Kg = base + C_RK + h * 128; const bf16_t* Vg = base + C_RV + h * 128;
    const int nt = 4 * qb + 4;
    att::ldsp L3 = (att::ldsp)lds;
    ATT_DMA_WAIT();
#pragma unroll
    for (int ks = 0; ks < 8; ++ks) asm volatile("" : "+v"(qf[ks]));
    int issued = 0;
    for (; issued < nt && issued < att::NRING - 1; ++issued) att::stage_dma(Kg, NP, Vg, NP, issued * 64, SEQ - 1, L3 + issued * att::BUFB, tid);
    for (int kt = 0; kt < nt; ++kt) {
        att::ring_wait(issued - 1 - kt);
        __syncthreads();
        if (issued < nt) { att::stage_dma(Kg, NP, Vg, NP, issued * 64, SEQ - 1, L3 + (issued & (att::NRING - 1)) * att::BUFB, tid); ++issued; }
        const int cur = kt & (att::NRING - 1);
        const int key0 = kt * 64;
        if (key0 <= q0 + 31)
            tile_decay<8>((att::ldscp)(L3 + cur * att::BUFB), (att::ldscp)(L3 + cur * att::BUFB + att::TILE), w, qf, o, log2g, tq - key0, key0 + 63 > q0);
    }
    __syncthreads();
    float s1 = 0.f;
#pragma unroll
    for (int c = 0; c < 4; ++c)
#pragma unroll
        for (int r = 0; r < 16; ++r) s1 += o[c][r];
    s1 = half_sum(s1);
    const float mu = s1 * (1.f / 128.f);
    float s2 = 0.f;
#pragma unroll
    for (int c = 0; c < 4; ++c)
#pragma unroll
        for (int r = 0; r < 16; ++r) { const float d = o[c][r] - mu; o[c][r] = d; s2 += d * d; }
    s2 = half_sum(s2);
    const float rs = rsqrtf(s2 * (1.f / 128.f) + EPS);
    const size_t mrow = (size_t)b * SEQ + tq;
    const bf16_t* grow = (const bf16_t*)(p.ws + WS_PROJ) + mrow * NP + C_RG + h * 128;
    bf16_t* orow = (bf16_t*)(p.ws + WS_MIXED) + mrow * DM + 512 + h * 128;
#pragma unroll
    for (int c = 0; c < 4; ++c)
#pragma unroll
        for (int g = 0; g < 4; ++g) {
            const int e0 = 32 * c + 8 * g + 4 * w.hi;
            const u32x2 gv = *(const u32x2*)(grow + e0);
            const float g0 = __uint_as_float(gv.x << 16), g1 = __uint_as_float(gv.x & 0xffff0000u), g2 = __uint_as_float(gv.y << 16), g3 = __uint_as_float(gv.y & 0xffff0000u);
            u32x2 v;
            v.x = pg8::cvt_pk_bf16(g0 / (1.f + __expf(-g0)) * o[c][4 * g] * rs, g1 / (1.f + __expf(-g1)) * o[c][4 * g + 1] * rs);
            v.y = pg8::cvt_pk_bf16(g2 / (1.f + __expf(-g2)) * o[c][4 * g + 2] * rs, g3 / (1.f + __expf(-g3)) * o[c][4 * g + 3] * rs);
            *(u32x2*)(orow + e0) = v;
        }
    __syncthreads();
}
__device__ void phase_ret_mfma(const Params& p, unsigned char* lds) {
    for (int unit = (blockIdx.x + gridDim.x / 2) % gridDim.x; unit < NB * 4 * 8; unit += gridDim.x) ret_unit(p, lds, unit);
}

__device__ __forceinline__ void nsa_unit(const Params& p, unsigned char* lds, int unit) {
    const int tid = opaque_tid(), lane = tid & 63, wave = __builtin_amdgcn_readfirstlane(tid >> 6);
    const int tb = 31 - (unit & 31), b = unit >> 5;
    const int head = wave >> 1, thalf = wave & 1, t0w = tb * 64 + thalf * 32;
    att::WaveCtx w; att::ctx_init(w, lane, 0);
    const int tq = t0w + w.r32, tloc = thalf * 32 + w.r32;
    const bf16_t* base = (const bf16_t*)(p.ws + WS_PROJ) + (size_t)b * SEQ * NP;
    bf16x8 qf[8];
#pragma unroll
    for (int ks = 0; ks < 8; ++ks) qf[ks] = *(const bf16x8*)(base + (size_t)tq * NP + C_NQ + head * 128 + 16 * ks + 8 * w.hi);
#define NSA_GATE(br) (1.f / (1.f + __expf(-bf2f(base[(size_t)tq * NP + C_GATE + head * 3 + (br)]))))
    const float csc = 0.08838834764831845f * 1.4426950408889634f;
    float* impQ = (float*)(lds + 65536);
    float* impE = (float*)(lds + 65536 + 32768);
    float* scb = (float*)lds;
    unsigned* selm = (unsigned*)(lds + 8192);
    att::ldsp L3 = (att::ldsp)lds;
    att::f32x16 o[4];
#pragma unroll
    for (int c = 0; c < 4; ++c)
#pragma unroll
        for (int r = 0; r < 16; ++r) o[c][r] = 0.f;
    {
        const bf16_t* Kc = (const bf16_t*)(p.ws + WS_KVCMPB) + (size_t)b * 128 * 128; const bf16_t* Vc = Kc + 4 * 128 * 128;
        att::stage_dma(Kc, 128, Vc, 128, 0, 127, L3, tid);
        att::stage_dma(Kc, 128, Vc, 128, 64, 127, L3 + att::BUFB, tid);
        ATT_DMA_WAIT();
        __syncthreads();
        const int jmax = tq >= 31 ? ((tq - 31) >> 4) : -1;
        float m = att::NEG, l = 0.f;
#pragma unroll 1
        for (int kt = 0; kt < 2; ++kt) {
            att::f32x16 p0, p1;
            att::qk<8>((att::ldscp)(L3 + kt * att::BUFB), w, qf, p0, p1);
            att::apply_bounds(p0, p1, 0, jmax - 64 * kt, w.hi);
            float mx = fmaxf(p0[0], p1[0]);
#pragma unroll
            for (int r = 1; r < 16; ++r) mx = fmaxf(mx, fmaxf(p0[r], p1[r]));
            mx = half_max(mx);
            const float mnew = fmaxf(m, mx * csc);
            float ls = 0.f;
#pragma unroll
            for (int r = 0; r < 16; ++r) ls += att::ex2(fmaf(p0[r], csc, -mnew)) + att::ex2(fmaf(p1[r], csc, -mnew));
            l = l * att::ex2(m - mnew) + ls; m = mnew;
        }
        l = half_sum(l);
        const float inv = (jmax >= 0) ? 1.f / l : 0.f;
#pragma unroll 1
        for (int kt = 0; kt < 2; ++kt) {
            att::f32x16 p0, p1;
            att::qk<8>((att::ldscp)(L3 + kt * att::BUFB), w, qf, p0, p1);
            att::apply_bounds(p0, p1, 0, jmax - 64 * kt, w.hi);
#pragma unroll
            for (int r = 0; r < 16; ++r) { p0[r] = att::ex2(fmaf(p0[r], csc, -m)) * inv; p1[r] = att::ex2(fmaf(p1[r], csc, -m)) * inv; }
#pragma unroll
            for (int g = 0; g < 4; ++g) {
                const int ia = ((head * 32 + 16 * kt + 2 * g + w.hi) * 64) + tloc, ib = ia + 8 * 64;
                impQ[ia] = (p0[4 * g] + p0[4 * g + 1]) + (p0[4 * g + 2] + p0[4 * g + 3]); impE[ia] = p0[4 * g + 3];
                impQ[ib] = (p1[4 * g] + p1[4 * g + 1]) + (p1[4 * g + 2] + p1[4 * g + 3]); impE[ib] = p1[4 * g + 3];
            }
            bf16x8 pf[2][2];
            att::pack_p(p0, p1, pf);
            att::pv((att::ldscp)(L3 + kt * att::BUFB + att::TILE), w, pf, o);
        }
    }
    __syncthreads();
    unsigned mymask, tmask;
    {
        const int token = tid >> 3, js0 = (tid & 7) * 4;
        if (tid < 65) selm[tid] = 0u;
#pragma unroll
        for (int i = 0; i < 4; ++i) {
            const int js = js0 + i;
            float s = 0.f;
#pragma unroll
            for (int h = 0; h < 4; ++h) { s += impQ[(h * 32 + js) * 64 + token]; if (js > 0) s += impE[(h * 32 + js - 1) * 64 + token]; }
            const bool valid = js <= tb, forced = (js == 0) || (js == tb) || (js == tb - 1);
            scb[token * 32 + js] = valid ? s + (forced ? 1e4f : 0.f) : -1e30f;
        }
        __syncthreads();
        unsigned mine = 0u;
#pragma unroll
        for (int i = 0; i < 4; ++i) {
            const int js = js0 + i;
            const float my = scb[token * 32 + js];
            int rank = 0;
            for (int jj = 0; jj < 32; ++jj) { const float sj = scb[token * 32 + jj]; rank += (sj > my || (sj == my && jj < js)) ? 1 : 0; }
            if (js <= tb && rank < 8) mine |= 1u << js;
        }
        if (mine) { atomicOr(&selm[token], mine); atomicOr(&selm[64], mine); }
        __syncthreads();
        mymask = selm[tloc]; tmask = selm[64];
        __syncthreads();
    }
    bf16_t* orow = (bf16_t*)(p.ws + WS_MIXED) + ((size_t)b * SEQ + tq) * DM + 1024 + head * 128 + 4 * w.hi;
    {
        const float g0 = NSA_GATE(0);
#pragma unroll
        for (int c = 0; c < 4; ++c)
#pragma unroll
            for (int g = 0; g < 4; ++g) {
                u32x2 v; v.x = pg8::cvt_pk_bf16(g0 * o[c][4 * g], g0 * o[c][4 * g + 1]); v.y = pg8::cvt_pk_bf16(g0 * o[c][4 * g + 2], g0 * o[c][4 * g + 3]);
                *(u32x2*)(orow + 32 * c + 8 * g) = v;
                o[c][4 * g] = 0.f; o[c][4 * g + 1] = 0.f; o[c][4 * g + 2] = 0.f; o[c][4 * g + 3] = 0.f;
            }
    }
#define NSA_ACCUM(f) do { _Pragma("unroll") for (int c = 0; c < 4; ++c) _Pragma("unroll") for (int g = 0; g < 4; ++g) { \
        const u32x2 u = *(const u32x2*)(orow + 32 * c + 8 * g); u32x2 v; \
        v.x = pg8::cvt_pk_bf16(__uint_as_float(u.x << 16) + (f) * o[c][4 * g], __uint_as_float(u.x & 0xffff0000u) + (f) * o[c][4 * g + 1]); \
        v.y = pg8::cvt_pk_bf16(__uint_as_float(u.y << 16) + (f) * o[c][4 * g + 2], __uint_as_float(u.y & 0xffff0000u) + (f) * o[c][4 * g + 3]); \
        *(u32x2*)(orow + 32 * c + 8 * g) = v; \
        o[c][4 * g] = 0.f; o[c][4 * g + 1] = 0.f; o[c][4 * g + 2] = 0.f; o[c][4 * g + 3] = 0.f; } } while (0)
    {
        const bf16_t* Kg = base + C_NKS; const bf16_t* Vg = base + C_NVS;
        float m = att::NEG, l = 0.f;
        const unsigned tm = (unsigned)__builtin_amdgcn_readfirstlane((int)tmask);
        const int nt = __builtin_popcount(tm);
        unsigned mi = tm, mc = tm;
        ATT_DMA_WAIT();
#pragma unroll
        for (int ks = 0; ks < 8; ++ks) asm volatile("" : "+v"(qf[ks]));
        int issued = 0;
        for (; issued < nt && issued < att::NRING - 1; ++issued) { const int j = __builtin_ctz(mi); mi &= mi - 1; att::stage_dma(Kg, NP, Vg, NP, j * 64, SEQ - 1, L3 + issued * att::BUFB, tid); }
        for (int i = 0; i < nt; ++i) {
            att::ring_wait(issued - 1 - i);
            __syncthreads();
            if (issued < nt) { const int j = __builtin_ctz(mi); mi &= mi - 1; att::stage_dma(Kg, NP, Vg, NP, j * 64, SEQ - 1, L3 + (issued & (att::NRING - 1)) * att::BUFB, tid); ++issued; }
            const int cur = i & (att::NRING - 1);
            const int curj = __builtin_ctz(mc); mc &= mc - 1;
            const bool allowed = (mymask >> curj) & 1u;
            if (__any(allowed))
                att::tile_softmax<8>((att::ldscp)(L3 + cur * att::BUFB), (att::ldscp)(L3 + cur * att::BUFB + att::TILE), w, qf, o, m, l, csc, (curj == tb) || __any(!allowed), 0, allowed ? tq - curj * 64 : -1);
        }
        __syncthreads();
        l = half_sum(l);
        const float f = NSA_GATE(1) / l;
        NSA_ACCUM(f);
    }
    {
        const bf16_t* Kg = base + C_NKW; const bf16_t* Vg = base + C_NVW;
        float m = att::NEG, l = 0.f;
        const int kt0 = tb >= 4 ? tb - 4 : 0, nt = tb - kt0 + 1;
        ATT_DMA_WAIT();
        int issued = 0;
        for (; issued < nt && issued < att::NRING - 1; ++issued) att::stage_dma(Kg, NP, Vg, NP, (kt0 + issued) * 64, SEQ - 1, L3 + issued * att::BUFB, tid);
        for (int i = 0; i < nt; ++i) {
            att::ring_wait(issued - 1 - i);
            __syncthreads();
            if (issued < nt) { att::stage_dma(Kg, NP, Vg, NP, (kt0 + issued) * 64, SEQ - 1, L3 + (issued & (att::NRING - 1)) * att::BUFB, tid); ++issued; }
            const int kt = kt0 + i, cur = i & (att::NRING - 1);
            const int key0 = kt * 64;
            att::tile_softmax<8>((att::ldscp)(L3 + cur * att::BUFB), (att::ldscp)(L3 + cur * att::BUFB + att::TILE), w, qf, o, m, l, csc, (kt == tb) || (kt == tb - 4), tq - 255 - key0, tq - key0);
        }
        l = half_sum(l);
        const float f = NSA_GATE(2) / l;
        NSA_ACCUM(f);
    }
    __syncthreads();
#undef NSA_ACCUM
#undef NSA_GATE
}
__device__ void phase_nsa_mfma(const Params& p, unsigned char* lds) {
    for (int unit = blockIdx.x; unit < NB * 32; unit += gridDim.x) nsa_unit(p, lds, unit);
}

__device__ void phase_cmp_mfma(const Params& p, unsigned char* lds, int L) {
    const int tid = opaque_tid(), lane = tid & 63, wave = __builtin_amdgcn_readfirstlane(tid >> 6);
    const int r32 = lane & 31, hi = lane >> 5;
    const bf16_t* proj = (const bf16_t*)(p.ws + WS_PROJ);
    const float2* r128 = (const float2*)(p.ws + WS_ROPE128);
    float* part = (float*)lds;
    float* slabs = (float*)(p.ws + WS_KPART);
    unsigned* cnt = (unsigned*)(p.ws + WS_CMPCNT) + L * 32;
    volatile int* slot = (volatile int*)(lds + 131072 + 56);
    for (int item = (blockIdx.x + gridDim.x / 2) % gridDim.x; item < NB * 2 * 4 * 4; item += gridDim.x) {
        const int lq = item & 3, jb = (item >> 2) & 3, kv = (item >> 4) & 1, b = item >> 5;
        const bf16_t* Wt = (const bf16_t*)(p.ws + WS_WCMP) + ((size_t)(L * 2 + kv)) * 128 * 4096;
        const float* pe = p.in[kv ? 14 : 13] + (size_t)L * 32 * 128;
        const int col = kv ? C_NVC : C_NKC;
        int j = jb * 32 + r32; if (j > 126) j = 126;
        att::f32x16 acc[4];
#pragma unroll
        for (int nb = 0; nb < 4; ++nb)
#pragma unroll
            for (int r = 0; r < 16; ++r) acc[nb][r] = 0.f;
        {
            const int l = lq * 8 + wave;
            const size_t m = (size_t)b * SEQ + 16 * j + l;
            const bf16_t* xrow = proj + m * NP + col;
#pragma unroll 4
            for (int ks = 0; ks < 8; ++ks) {
                const int d0 = 16 * ks + 8 * hi;
                const bf16x8 xv = *(const bf16x8*)(xrow + d0);
                float xf[8];
#pragma unroll
                for (int e = 0; e < 8; ++e) xf[e] = bf2f((bf16_t)xv[e]);
                if (!kv) {
                    const bf16x8 xp = *(const bf16x8*)(xrow + (d0 ^ 64));
                    const f32x4* cs4 = (const f32x4*)(r128 + m * 64 + (d0 & 63));
#pragma unroll
                    for (int e2 = 0; e2 < 4; ++e2) {
                        const f32x4 t = cs4[e2];
                        const float o0 = bf2f((bf16_t)xp[2 * e2]), o1 = bf2f((bf16_t)xp[2 * e2 + 1]);
                        xf[2 * e2] = (d0 < 64) ? xf[2 * e2] * t.x - o0 * t.y : xf[2 * e2] * t.x + o0 * t.y;
                        xf[2 * e2 + 1] = (d0 < 64) ? xf[2 * e2 + 1] * t.z - o1 * t.w : xf[2 * e2 + 1] * t.z + o1 * t.w;
                    }
                }
                const f32x4 pe0 = *(const f32x4*)(pe + l * 128 + d0), pe1 = *(const f32x4*)(pe + l * 128 + d0 + 4);
                u32x4 xa;
                xa.x = pg8::cvt_pk_bf16(xf[0] + pe0.x, xf[1] + pe0.y); xa.y = pg8::cvt_pk_bf16(xf[2] + pe0.z, xf[3] + pe0.w);
                xa.z = pg8::cvt_pk_bf16(xf[4] + pe1.x, xf[5] + pe1.y); xa.w = pg8::cvt_pk_bf16(xf[6] + pe1.z, xf[7] + pe1.w);
                const bf16x8 xfr = __builtin_bit_cast(bf16x8, xa);
#pragma unroll
                for (int nb = 0; nb < 4; ++nb) {
                    const bf16x8 wf = *(const bf16x8*)(Wt + (size_t)(nb * 32 + r32) * 4096 + l * 128 + d0);
                    acc[nb] = __builtin_amdgcn_mfma_f32_32x32x16_bf16(wf, xfr, acc[nb], 0, 0, 0);
                }
            }
        }
        __syncthreads();
#pragma unroll
        for (int nb = 0; nb < 4; ++nb)
#pragma unroll
            for (int r = 0; r < 16; ++r) part[(wave * 128 + nb * 32 + att::crow(r, hi)) * 32 + r32] = acc[nb][r];
        __syncthreads();
        const int jj = tid & 31, ng = tid >> 5;
        const int jrow = jb * 32 + jj;
        float v[8];
#pragma unroll
        for (int i = 0; i < 8; ++i) {
            float s = 0.f;
#pragma unroll
            for (int w8 = 0; w8 < 8; ++w8) s += part[(w8 * 128 + ng * 8 + i) * 32 + jj];
            v[i] = s;
        }
        {
            float* my = slabs + ((size_t)((lq * 2 + kv) * 4 + b) * 128 + jrow) * 128 + ng * 8;
            *(f32x4*)my = (f32x4){v[0], v[1], v[2], v[3]}; *(f32x4*)(my + 4) = (f32x4){v[4], v[5], v[6], v[7]};
        }
        asm volatile("s_waitcnt vmcnt(0)" ::: "memory");
        __syncthreads();
        if (tid == 0) {
            __builtin_amdgcn_fence(__ATOMIC_RELEASE, "agent");
            asm volatile("s_waitcnt vmcnt(0)" ::: "memory");
            *slot = (int)__hip_atomic_fetch_add(cnt + (item >> 2), 1u, __ATOMIC_RELAXED, __HIP_MEMORY_SCOPE_AGENT);
        }
        __syncthreads();
        const int ticket = *slot;
        if (ticket == 3) {
            if (tid == 0) { __builtin_amdgcn_fence(__ATOMIC_ACQUIRE, "agent"); asm volatile("s_waitcnt vmcnt(0)" ::: "memory"); }
            __syncthreads();
            float ss = 0.f;
#pragma unroll
            for (int i = 0; i < 8; ++i) v[i] = 0.f;
#pragma unroll
            for (int q4 = 0; q4 < 4; ++q4) {
                const float* sp = slabs + ((size_t)((q4 * 2 + kv) * 4 + b) * 128 + jrow) * 128 + ng * 8;
                const f32x4 a0 = *(const f32x4*)sp, a1 = *(const f32x4*)(sp + 4);
                v[0] += a0.x; v[1] += a0.y; v[2] += a0.z; v[3] += a0.w; v[4] += a1.x; v[5] += a1.y; v[6] += a1.z; v[7] += a1.w;
            }
#pragma unroll
            for (int i = 0; i < 8; ++i) ss += v[i] * v[i];
            float sc = 1.f;
            if (!kv) {
                part[ng * 32 + jj] = ss;
                __syncthreads();
                float tot = 0.f;
#pragma unroll
                for (int g2 = 0; g2 < 16; ++g2) tot += part[g2 * 32 + jj];
                sc = rsqrtf(tot * (1.f / 128.f) + EPS);
            }
            if (jrow > 126) sc = 0.f;
            u32x4 ov;
            ov.x = pg8::cvt_pk_bf16(v[0] * sc, v[1] * sc); ov.y = pg8::cvt_pk_bf16(v[2] * sc, v[3] * sc); ov.z = pg8::cvt_pk_bf16(v[4] * sc, v[5] * sc); ov.w = pg8::cvt_pk_bf16(v[6] * sc, v[7] * sc);
            *(u32x4*)((bf16_t*)(p.ws + WS_KVCMPB) + (size_t)kv * 4 * 128 * 128 + ((size_t)b * 128 + jrow) * 128 + ng * 8) = ov;
        }
        __syncthreads();
    }
    __syncthreads();
}

__device__ __forceinline__ float gelu_tanh(float x) {
    const float u = 0.7978845608028654f * (x + 0.044715f * x * x * x);
    const float e = __expf(2.f * u);
    const float th = 1.f - 2.f / (e + 1.f);
    return 0.5f * x * (1.f + th);
}
__device__ void phase_s5v2(const Params& p, unsigned char* lds, int L) {
    const int tid = opaque_tid(), lane = tid & 63, wave = __builtin_amdgcn_readfirstlane(tid >> 6);
    const int r32 = lane & 31, hi = lane >> 5, l15 = lane & 15, q4 = lane >> 4;
    float* bub = (float*)lds;
    unsigned char* s16 = lds + 65536;
    float2* xch = (float2*)(lds + 65536 + 2 * 17408);
    const bf16_t* proj = (const bf16_t*)(p.ws + WS_PROJ);
    bf16_t* s5y = (bf16_t*)(p.ws + WS_S5Y);
    const unsigned char* pre = p.ws + WS_S5PRE + L * S5PRE_LAYER;
    const float2* lbp = (const float2*)pre;
    const bf16_t* bb16 = (const bf16_t*)(pre + 16384);
    const bf16_t* cm16 = (const bf16_t*)(pre + 16384 + 131072);
    typedef float f32x2 __attribute__((ext_vector_type(2)));
#define S5_CMA(A_, X_, Y_) (((f32x2){-(A_).y, (A_).y}) * ((f32x2){(X_).y, (X_).x}) + (((f32x2){(A_).x, (A_).x}) * (X_) + (Y_)))
    for (int it = blockIdx.x; it < NB * 32; it += gridDim.x) {
        const int b = it >> 5, g = it & 31;
        const size_t m0 = (size_t)b * SEQ;
        f32x2 lam[8];
        { const float2 lb = lbp[g * 64 + lane]; lam[0] = (f32x2){lb.x, lb.y};
#pragma unroll
          for (int k = 1; k < 8; ++k) lam[k] = (f32x2){lam[k - 1].x * lam[0].x - lam[k - 1].y * lam[0].y, lam[k - 1].x * lam[0].y + lam[k - 1].y * lam[0].x}; }
        f32x2 S = (f32x2){0.f, 0.f};
        const int a_tb = wave & 1, a_pb = wave >> 1;
        const bf16x8 bfa = *(const bf16x8*)(bb16 + ((size_t)(g * 128 + 32 * a_pb + r32)) * 16 + 8 * hi);
        bf16x8 cm[4]; float dsk = 0.f;
        if (wave < 4) {
#pragma unroll
            for (int ks = 0; ks < 4; ++ks) cm[ks] = *(const bf16x8*)(cm16 + ((size_t)(g * 16 + l15)) * 128 + 32 * ks + 8 * q4);
            dsk = p.in[11][((size_t)L * 32 + g) * 16 + l15];
        }
        const bf16_t* urow = proj + (m0 + 32 * a_tb + r32) * NP + C_U + g * 16 + 8 * hi;
        const bf16_t* yrow = proj + (m0 + 16 * wave + 4 * q4) * NP + C_U + g * 16 + l15;
        bf16x8 af0 = *(const bf16x8*)(urow), af1 = *(const bf16x8*)(urow + (size_t)64 * NP);
        bf16_t uy0[4], uy1[4];
#pragma unroll
        for (int r = 0; r < 4; ++r) { uy0[r] = 0; uy1[r] = 0; }
        if (wave < 4) {
#pragma unroll
            for (int r = 0; r < 4; ++r) { uy0[r] = yrow[(size_t)r * NP]; uy1[r] = yrow[(size_t)(64 + r) * NP]; }
        }
        __syncthreads();
        f32x2 ccA[8], ccB[8];
#pragma unroll
        for (int k = 0; k < 8; ++k) { ccA[k] = (f32x2){0.f, 0.f}; ccB[k] = (f32x2){0.f, 0.f}; }
#pragma unroll 1
        for (int i = -1; i <= SEQ / 64 + 1; ++i) {
            if (i + 1 < SEQ / 64) {
                const int c1 = i + 1;
                float* bw = bub + (c1 & 1) * 8192;
                att::f32x16 d;
#pragma unroll
                for (int r = 0; r < 16; ++r) d[r] = 0.f;
                d = __builtin_amdgcn_mfma_f32_32x32x16_bf16(af0, bfa, d, 0, 0, 0);
#pragma unroll
                for (int r = 0; r < 16; ++r) bw[(32 * a_tb + att::crow(r, hi)) * 128 + 32 * a_pb + r32] = d[r];
                af0 = af1;
                if (c1 + 2 < SEQ / 64) af1 = *(const bf16x8*)(urow + (size_t)(64 * (c1 + 2)) * NP);
            }
#pragma unroll
            for (int k = 0; k < 8; ++k) ccB[k] = ccA[k];
            if (i >= 0 && i < SEQ / 64) {
                const f32x2* bc = (const f32x2*)(bub + (i & 1) * 8192) + (8 * wave) * 64 + lane;
                f32x2 bu[8];
#pragma unroll
                for (int k = 0; k < 8; ++k) bu[k] = bc[k * 64];
                ccA[0] = bu[0];
#pragma unroll
                for (int k = 1; k < 8; ++k) ccA[k] = S5_CMA(lam[0], ccA[k - 1], bu[k]);
                xch[((i & 1) * 8 + wave) * 64 + lane] = make_float2(ccA[7].x, ccA[7].y);
            }
            if (i >= 1 && i <= SEQ / 64) {
                const int c = i - 1;
                f32x2 Sin = S;
#pragma unroll
                for (int j = 0; j < 8; ++j) {
                    const float2 t = xch[((c & 1) * 8 + j) * 64 + lane];
                    if (j == wave) Sin = S;
                    S = S5_CMA(lam[7], S, ((f32x2){t.x, t.y}));
                }
                unsigned* sc = (unsigned*)(s16 + (c & 1) * 17408) + (8 * wave) * 68 + lane;
#pragma unroll
                for (int k = 0; k < 8; ++k) { const f32x2 s = S5_CMA(lam[k], Sin, ccB[k]); sc[k * 68] = pg8::cvt_pk_bf16(s.x, s.y); }
            }
            if (i >= 2 && wave < 4) {
                const int c0 = i - 2;
                const unsigned char* sb = s16 + (c0 & 1) * 17408;
                f32x4 acc = (f32x4){0.f, 0.f, 0.f, 0.f};
#pragma unroll
                for (int ks = 0; ks < 4; ++ks) {
                    const bf16x8 af = *(const bf16x8*)(sb + (16 * wave + l15) * 272 + 64 * ks + 16 * q4);
                    acc = __builtin_amdgcn_mfma_f32_16x16x32_bf16(af, cm[ks], acc, 0, 0, 0);
                }
#pragma unroll
                for (int r = 0; r < 4; ++r) {
                    const size_t m = m0 + 64 * c0 + 16 * wave + 4 * q4 + r;
                    s5y[m * 512 + g * 16 + l15] = (bf16_t)f2bf(gelu_tanh(acc[r] + dsk * bf2f(uy0[r])));
                }
#pragma unroll
                for (int r = 0; r < 4; ++r) { uy0[r] = uy1[r]; if (c0 + 2 < SEQ / 64) uy1[r] = yrow[(size_t)(64 * (c0 + 2) + r) * NP]; }
            }
            __syncthreads();
        }
    }
#undef S5_CMA
}

struct OneUnit {
    pg8::Unit u;
    __device__ __forceinline__ bool next(int i, pg8::Unit& o) const { if (i) return false; o = u; return true; }
    __device__ __forceinline__ void a_ready(const pg8::Unit&) const {}
    __device__ __forceinline__ void done(const pg8::Unit&) const {}
};
constexpr int P3_NSA = NB * 32, P3_DIFF = NB * 4 * 16, P3_RET = NB * 4 * 8, P3_GLU = (MTOK / 256) * 2, P3_ITEMS = P3_NSA + P3_DIFF + P3_RET + P3_GLU;
__host__ __device__ inline int p3_key(int e) {
    int c;
    if (e < P3_NSA) c = 4 * ((31 - (e & 31)) + 9);
    else if (e < P3_NSA + P3_DIFF) c = 3 * (2 * (15 - ((e - P3_NSA) & 15)) + 2);
    else if (e < P3_NSA + P3_DIFF + P3_RET) c = 4 * (4 * (7 - ((e - P3_NSA - P3_DIFF) & 7)) + 4);
    else c = 8;
    return c * 1024 + e;
}
__device__ void phase_p3(const Params& p, unsigned char* lds, int L) {
    const int tid = opaque_tid(), lane = tid & 63;
    unsigned short* order = (unsigned short*)(lds + 131072 + 64);
    volatile int* slot = (volatile int*)(lds + 131072 + 48);
    static_assert(P3_ITEMS == 576, "order table size");
    for (int e = tid; e < P3_ITEMS; e += NTHREADS) order[e] = p.order[e];
    const float* lamw = (const float*)(p.ws + WS_LAM) + 2 * L;
    unsigned* qctr = (unsigned*)(p.ws + WS_QUEUE) + L * 64;
    __syncthreads();
    for (;;) {
        if (tid == 0) *slot = (int)atomicAdd(qctr, 1u);
        __syncthreads();
        const int q = *slot;
        __syncthreads();
        if (q >= P3_ITEMS) break;
        const int e = order[q];
        if (e < P3_NSA) nsa_unit(p, lds, e);
        else if (e < P3_NSA + P3_DIFF) diff_unit(p, lds, e - P3_NSA, lamw[0], lamw[1]);
        else if (e < P3_NSA + P3_DIFF + P3_RET) ret_unit(p, lds, e - P3_NSA - P3_DIFF);
        else {
            const int g = e - P3_NSA - P3_DIFF - P3_RET;
            pg8::Gemm gm{(const bf16_t*)(p.ws + WS_S5Y), (const bf16_t*)(p.ws + WS_WGLU + (size_t)L * 512 * 512 * 2), MTOK, 512, 512};
            OneUnit S{pg8::Unit{g >> 1, g & 1}};
            EpiGlu E{(const bf16_t*)(p.ws + WS_S5Y), (bf16_t*)(p.ws + WS_MIXED)};
            pg8::gemm_phase<EpiGlu, OneUnit, true, true>((PG8_LAS unsigned char*)lds, gm, S, E);
            __syncthreads();
        }
    }
    if (L == 0) conv_fill(p, lds, CONV_B_BLK);
}

#define LAS __attribute__((address_space(3)))
#define XB_TMO      128
#define XB_XCNT(j)  (256  + 64 * (j))
#define XB_XSUB(j)  (1280 + 64 * (j))
#define XB_XGEN(j)  (2304 + 64 * (j))
#define XB_TOP      3328
#define XB_TOPGEN   3392
#define XCD_BAR_WORDS 3456
#define XB_SPIN_CAP (1u << 18)

__device__ __forceinline__ unsigned xb_ld(unsigned* p)              { return __hip_atomic_load(p, __ATOMIC_RELAXED, __HIP_MEMORY_SCOPE_AGENT); }
__device__ __forceinline__ unsigned xb_add(unsigned* p, unsigned v) { return __hip_atomic_fetch_add(p, v, __ATOMIC_RELAXED, __HIP_MEMORY_SCOPE_AGENT); }
__device__ __forceinline__ unsigned xb_xcc_id() { return (unsigned)__builtin_amdgcn_s_getreg((3 << 11) | 20) & 0xFu; }
#define XB_SPIN(cond, bar) do { unsigned _sp = 0; while (cond) { __builtin_amdgcn_s_sleep(1); \
    if ((++_sp & 255u) == 0u) { if (xb_ld(&(bar)[XB_TMO])) break; if (_sp > XB_SPIN_CAP) { atomicAdd(&(bar)[XB_TMO], 1u); break; } } } } while (0)

struct XcdBarrier {
    unsigned* bar; unsigned x;
    volatile LAS unsigned* st;
};

__device__ __forceinline__ XcdBarrier xcd_barrier_post(unsigned* bar, volatile LAS unsigned* st) {
    XcdBarrier b; b.bar = bar; b.x = xb_xcc_id(); b.st = st;
    if (threadIdx.x == 0) (void)xb_add(&bar[XB_XCNT(b.x)], 1u);
    return b;
}
__device__ __forceinline__ void xcd_barrier_complete(unsigned* bar, unsigned x, unsigned& nloc, unsigned& nx) {
    const unsigned G = gridDim.x * gridDim.y * gridDim.z;
    unsigned sum, cnt, mine, sp = 0u;
    for (;;) {
        sum = 0u; cnt = 0u; mine = 0u;
#pragma unroll
        for (unsigned j = 0; j < 16; ++j) { const unsigned c = xb_ld(&bar[XB_XCNT(j)]); sum += c; cnt += (c > 0u) ? 1u : 0u; mine = (j == x) ? c : mine; }
        if (sum == G) break;
        __builtin_amdgcn_s_sleep(1);
        if ((++sp & 255u) == 0u) { if (xb_ld(&bar[XB_TMO])) break; if (sp > XB_SPIN_CAP) { atomicAdd(&bar[XB_TMO], 1u); break; } }
    }
    nloc = mine > 0u ? mine : 1u; nx = cnt > 0u ? cnt : 1u;
}

__device__ __forceinline__ void xcd_barrier(const XcdBarrier& b) {
    asm volatile("s_waitcnt vmcnt(0)" ::: "memory");
    __syncthreads();
    if (threadIdx.x == 0) {
        unsigned* bar = b.bar;
        __builtin_amdgcn_s_waitcnt(0);
        unsigned nloc = b.st[0], nx = b.st[1];
        if (nloc == 0u) { xcd_barrier_complete(bar, b.x, nloc, nx); b.st[0] = nloc; b.st[1] = nx; }
        const unsigned old = xb_add(&bar[XB_XSUB(b.x)], 1u);
        const unsigned gen = old / nloc;
        if (old + 1u == (gen + 1u) * nloc) {
            __builtin_amdgcn_fence(__ATOMIC_RELEASE, "agent");
            asm volatile("s_waitcnt vmcnt(0)" ::: "memory");
            const unsigned og = xb_add(&bar[XB_TOP], 1u);
            const unsigned tg = og / nx;
            if (og + 1u == (tg + 1u) * nx) xb_add(&bar[XB_TOPGEN], 1u);
            else XB_SPIN(xb_ld(&bar[XB_TOPGEN]) == tg, bar);
            __builtin_amdgcn_fence(__ATOMIC_ACQUIRE, "agent");
            xb_add(&bar[XB_XGEN(b.x)], 1u);
            asm volatile("s_waitcnt vmcnt(0)" ::: "memory");
        } else {
            XB_SPIN(xb_ld(&bar[XB_XGEN(b.x)]) == gen, bar);
            __builtin_amdgcn_fence(__ATOMIC_ACQUIRE, "agent");
            asm volatile("s_waitcnt vmcnt(0)" ::: "memory");
        }
    }
    __syncthreads();
}

__global__ void __launch_bounds__(NTHREADS, 2) fwd_megakernel(Params p) {
    extern __shared__ __attribute__((aligned(16))) unsigned char lds[];
    unsigned char* ws = p.ws;
    bf16_t* xb = (bf16_t*)(ws + WS_XB);
    bf16_t* proj = (bf16_t*)(ws + WS_PROJ);
    bf16_t* mixed = (bf16_t*)(ws + WS_MIXED);
    bf16_t* hid = (bf16_t*)(ws + WS_HID);
    float* sumsq = (float*)(ws + WS_SUMSQ);

    volatile LAS unsigned* misc = (volatile LAS unsigned*)((LAS unsigned char*)lds + 131072);
    if (threadIdx.x < 16) misc[threadIdx.x] = 0u;
    __syncthreads();
    XcdBarrier bar = xcd_barrier_post((unsigned*)(ws + WS_BAR), misc + 8);
    phase_prologue(p, lds);
#pragma unroll 1
    for (int L = 0; L < DEPTH; ++L) {
        float* ss1 = sumsq + (2 * L) * MTOK;
        float* ss2 = sumsq + (2 * L + 1) * MTOK;
        float* ss3 = (L + 1 < DEPTH) ? sumsq + (2 * L + 2) * MTOK : nullptr;
        xcd_barrier(bar);
        run_gemm(lds, xb, (const bf16_t*)(ws + WS_WIN + L * WIN_LAYER), MTOK, NP, DM, EpiScale{proj, NP, ss1, 0});
        xcd_barrier(bar);
        phase_prep(p);
        phase_cmp_mfma(p, lds, L);
        phase_s5v2(p, lds, L);
        xcd_barrier(bar);
        phase_p3(p, lds, L);
        xcd_barrier(bar);
        run_gemm(lds, mixed, (const bf16_t*)(ws + WS_WOUT + L * WOUT_LAYER), MTOK, DM, DM, EpiResid{xb, nullptr, 1, ss2});
        xcd_barrier(bar);
        run_gemm(lds, xb, (const bf16_t*)(ws + WS_W1 + L * W1_LAYER), MTOK, DFF, DM, EpiScale{hid, DFF, ss2, 1});
        xcd_barrier(bar);
        run_gemm(lds, hid, (const bf16_t*)(ws + WS_W2 + L * W2_LAYER), MTOK, DM, DFF, EpiResid{xb, (L + 1 < DEPTH) ? nullptr : p.out, (L + 1 < DEPTH) ? 1 : 0, ss3});
    }
    if (p.ws == nullptr) { cg::grid_group grid = cg::this_grid(); grid.sync(); }
}

extern "C" void kernel_launch(void* const* d_in, const int* in_sizes, int n_in, void* d_out, int out_size, void* d_ws, size_t ws_size, hipStream_t stream) {
    static int grid = 0;
    if (grid == 0) {
        if (n_in != 25 || out_size != MTOK * DM || ws_size < WS_END) { fprintf(stderr, "kernel_launch: unexpected problem (n_in %d out %d ws %zu)\n", n_in, out_size, ws_size); grid = -1; return; }
        int dev = 0, cus = 0, per_cu = 0;
        (void)hipGetDevice(&dev);
        (void)hipDeviceGetAttribute(&cus, hipDeviceAttributeMultiprocessorCount, dev);
        (void)hipFuncSetAttribute((const void*)fwd_megakernel, hipFuncAttributeMaxDynamicSharedMemorySize, LDS_BYTES);
        (void)hipOccupancyMaxActiveBlocksPerMultiprocessor(&per_cu, (const void*)fwd_megakernel, NTHREADS, LDS_BYTES);
        if (per_cu < 1) { fprintf(stderr, "kernel_launch: occupancy query says %d blocks/CU\n", per_cu); grid = -1; return; }
        grid = cus;
    }
    if (grid < 0) return;
    (void)hipMemsetAsync((char*)d_ws + WS_CTL, 0, CTL_BYTES, stream);
    Params p{};
    for (int i = 0; i < 25; ++i) p.in[i] = (const float*)d_in[i];
    p.out = (float*)d_out; p.ws = (unsigned char*)d_ws;
    for (int j = 0; j < 64; ++j) p.inv128[j] = (float)pow(10000.0, -(double)(2 * j) / 128.0);
    for (int j = 0; j < 32; ++j) p.inv64[j] = (float)pow(10000.0, -(double)(2 * j) / 64.0);
    for (int e = 0; e < P3_ITEMS; ++e) { int rank = 0; for (int f = 0; f < P3_ITEMS; ++f) rank += p3_key(f) > p3_key(e) ? 1 : 0; p.order[rank] = (unsigned short)e; }
    void* args[] = {&p};
    hipError_t e = hipLaunchCooperativeKernel((const void*)fwd_megakernel, dim3(grid), dim3(NTHREADS), args, LDS_BYTES, stream);
    if (e != hipSuccess) fprintf(stderr, "cooperative launch failed: %s (grid %d)\n", hipGetErrorString(e), grid);
}
```

```cpp
#include <hip/hip_runtime.h>
#include <hip/hip_cooperative_groups.h>
#include <cstdio>
#include <cstdint>
#include <cmath>
namespace cg = cooperative_groups;

typedef unsigned short bf16_t;
typedef short bf16x8 __attribute__((ext_vector_type(8)));
typedef float f32x4 __attribute__((ext_vector_type(4)));
typedef unsigned u32x2 __attribute__((ext_vector_type(2)));
typedef unsigned u32x4 __attribute__((ext_vector_type(4)));

constexpr int DM = 2048, NB = 4, SEQ = 2048, DEPTH = 2, MTOK = NB * SEQ;
constexpr int DFF = 8192, NIN = 5388, NP = 5632;
constexpr int PP = 8192;
constexpr float EPS = 1e-6f;
constexpr int C_U = 0, C_RQ = 512, C_RK = 1024, C_RV = 1536, C_RG = 2048, C_NQ = 2560, C_NKC = 3072, C_NVC = 3200, C_NKS = 3328, C_NVS = 3456,
              C_NKW = 3584, C_NVW = 3712, C_DQ = 3840, C_DK = 4352, C_DV = 4864, C_GATE = 5376;
__host__ __device__ inline int orig_col(int c) { if (c < 3840) return c; if (c < 5376) return c + 12; if (c < 5388) return 3840 + (c - 5376); return -1; }

constexpr size_t MiB = 1u << 20;
constexpr size_t WS_CTL = 0, CTL_BYTES = 192 * 1024;
constexpr size_t WS_QUEUE = 8 * 1024;
constexpr size_t WS_CMPCNT = 10 * 1024;
constexpr size_t WS_LAM = 12 * 1024;
constexpr size_t WS_BAR = 16 * 1024;
constexpr size_t WS_SGB = 32 * 1024;
constexpr size_t WS_SUMSQ = 64 * 1024;
constexpr size_t WS_ROPE128 = 1 * MiB;
constexpr size_t WS_ROPE64 = 5 * MiB;
constexpr size_t WS_S5PRE = 7 * MiB;
constexpr size_t S5PRE_LAYER = 32 * 64 * 8 + 32 * 64 * 16 * 8;
constexpr size_t WS_KVCMP = 8 * MiB;
constexpr size_t WS_KVCMPB = 9 * MiB;
constexpr size_t WS_WGLU = 10 * MiB;
constexpr size_t WS_WIN = 12 * MiB, WIN_LAYER = (size_t)NP * DM * 2;
constexpr size_t WS_WOUT = 56 * MiB, WOUT_LAYER = (size_t)DM * DM * 2;
constexpr size_t WS_W1 = 72 * MiB, W1_LAYER = (size_t)DFF * DM * 2;
constexpr size_t WS_W2 = 136 * MiB, W2_LAYER = (size_t)DM * DFF * 2;
constexpr size_t WS_XB = 200 * MiB;
constexpr size_t WS_MIXED = 232 * MiB;
constexpr size_t WS_S5Y = 264 * MiB;
constexpr size_t WS_HID = 272 * MiB;
constexpr size_t WS_PROJ = 272 * MiB;
constexpr size_t WS_WCMP = 400 * MiB;
constexpr size_t WS_KPART = 404 * MiB;
constexpr size_t WS_END = 406 * MiB;

constexpr int NTHREADS = 512, NWAVES = 8;
constexpr int LDS_BYTES = 147456;

struct Params {
    const float* in[25];
    float* out;
    unsigned char* ws;
    float inv128[64];
    float inv64[32];
    unsigned short order[576];
};

__device__ __forceinline__ float bf2f(bf16_t v) { return __uint_as_float((unsigned)v << 16); }
__device__ __forceinline__ unsigned f2bf(float f) { unsigned u = __float_as_uint(f); return (u + 0x7fffu + ((u >> 16) & 1u)) >> 16; }
__device__ __forceinline__ unsigned pk2(float lo, float hi) { return f2bf(lo) | (f2bf(hi) << 16); }
__device__ __forceinline__ float shx(float v, int o, int lane) { return __int_as_float(__builtin_amdgcn_ds_bpermute((lane ^ o) << 2, __float_as_int(v))); }
__device__ __forceinline__ float shl(float v, int src, int lane) { (void)lane; return __int_as_float(__builtin_amdgcn_ds_bpermute(src << 2, __float_as_int(v))); }
__device__ __forceinline__ float wave_sum(float v, int lane) {
#pragma unroll
    for (int o = 1; o < 64; o <<= 1) v += shx(v, o, lane);
    return v;
}
__device__ __forceinline__ float wave_max(float v, int lane) {
#pragma unroll
    for (int o = 1; o < 64; o <<= 1) v = fmaxf(v, shx(v, o, lane));
    return v;
}
__device__ __forceinline__ float half_sum(float v) { auto r = __builtin_amdgcn_permlane32_swap(__float_as_uint(v), __float_as_uint(v), false, false); return __uint_as_float(r[0]) + __uint_as_float(r[1]); }
__device__ __forceinline__ float half_max(float v) { auto r = __builtin_amdgcn_permlane32_swap(__float_as_uint(v), __float_as_uint(v), false, false); return fmaxf(__uint_as_float(r[0]), __uint_as_float(r[1])); }
#define LDS_WAIT() asm volatile("s_waitcnt lgkmcnt(0)" ::: "memory")
__device__ __forceinline__ int opaque_tid() { int t = (int)threadIdx.x; asm volatile("" : "+v"(t)); return t; }

__device__ __forceinline__ void transpose_item(const float* W, int K, int N, const float* gk, bf16_t* WT, bool winmap, float* scr, int item, int nblk, int lane) {
    const int c4 = (lane & 7) * 4, rr = lane >> 3;
    f32x4 v[2][8];
#pragma unroll
    for (int h = 0; h < 2; ++h) {
        const int it = item + 8 * h, kb = it / nblk, nb = it % nblk, k0 = 64 * kb, n0 = 32 * nb;
        const int oc = winmap ? orig_col(n0 + c4) : n0 + c4;
#pragma unroll
        for (int i = 0; i < 8; ++i) v[h][i] = (oc >= 0) ? *(const f32x4*)(W + (size_t)(k0 + 8 * i + rr) * N + oc) : (f32x4){0.f, 0.f, 0.f, 0.f};
    }
#pragma unroll
    for (int h = 0; h < 2; ++h) {
        const int it = item + 8 * h, kb = it / nblk, nb = it % nblk, k0 = 64 * kb, n0 = 32 * nb;
#pragma unroll
        for (int i = 0; i < 8; ++i) {
            const int kk = 8 * i + rr;
            f32x4 t = v[h][i];
            if (gk) t = t * gk[k0 + kk];
            float* d = scr + kk * 33 + c4;
            d[0] = t.x; d[1] = t.y; d[2] = t.z; d[3] = t.w;
        }
        LDS_WAIT();
        const int c = lane & 7;
#pragma unroll
        for (int j = 0; j < 4; ++j) {
            const int nn = (lane >> 3) + 8 * j;
            const float* sp = scr + (8 * c) * 33 + nn;
            u32x4 o;
            o.x = pk2(sp[0 * 33], sp[1 * 33]); o.y = pk2(sp[2 * 33], sp[3 * 33]); o.z = pk2(sp[4 * 33], sp[5 * 33]); o.w = pk2(sp[6 * 33], sp[7 * 33]);
            *(u32x4*)(WT + (size_t)(n0 + nn) * K + k0 + 8 * c) = o;
        }
        LDS_WAIT();
    }
}

constexpr int I_IN = (DM / 64) * (NP / 32), I_OUT = (DM / 64) * (DM / 32), I_1 = (DM / 64) * (DFF / 32), I_2 = (DFF / 64) * (DM / 32), I_G = (512 / 64) * (512 / 32), I_C = (4096 / 64) * (128 / 32);
constexpr int I_LAYER = I_IN + I_OUT + I_1 + I_2 + I_G + 2 * I_C;
__device__ __forceinline__ void conv_wave_item(const Params& p, float* scr, int L, int r, int lane) {
    unsigned char* ws = p.ws;
    if (r < I_IN) { transpose_item(p.in[3] + (size_t)L * DM * NIN, DM, NIN, p.in[2] + L * DM, (bf16_t*)(ws + WS_WIN + L * WIN_LAYER), true, scr, r, NP / 32, lane); return; } r -= I_IN;
    if (r < I_OUT) { transpose_item(p.in[21] + (size_t)L * DM * DM, DM, DM, nullptr, (bf16_t*)(ws + WS_WOUT + L * WOUT_LAYER), false, scr, r, DM / 32, lane); return; } r -= I_OUT;
    if (r < I_1) { transpose_item(p.in[23] + (size_t)L * DM * DFF, DM, DFF, p.in[22] + L * DM, (bf16_t*)(ws + WS_W1 + L * W1_LAYER), false, scr, r, DFF / 32, lane); return; } r -= I_1;
    if (r < I_2) { transpose_item(p.in[24] + (size_t)L * DFF * DM, DFF, DM, nullptr, (bf16_t*)(ws + WS_W2 + L * W2_LAYER), false, scr, r, DM / 32, lane); return; } r -= I_2;
    if (r < I_G) { transpose_item(p.in[12] + (size_t)L * 512 * 512, 512, 512, nullptr, (bf16_t*)(ws + WS_WGLU + (size_t)L * 512 * 512 * 2), false, scr, r, 512 / 32, lane); return; } r -= I_G;
    { const int kv = r / I_C; r -= kv * I_C;
      transpose_item(p.in[15 + kv] + (size_t)L * 4096 * 128, 4096, 128, nullptr, (bf16_t*)(ws + WS_WCMP) + ((size_t)(L * 2 + kv)) * 128 * 4096, false, scr, r, 128 / 32, lane); }
}
constexpr int CONV_A = I_IN + I_G + 2 * I_C, CONV_B0 = I_OUT + I_1 + I_2, CONV_B = CONV_B0 + I_LAYER;
constexpr int CONV_A_BLK = CONV_A / 32;
constexpr int CONV_GRAN = 16, CONV_B_BLK = CONV_B / CONV_GRAN;
static_assert(CONV_A % 32 == 0 && CONV_B % CONV_GRAN == 0, "conversion block-items");
__device__ __forceinline__ void conv_block_item(const Params& p, unsigned char* lds, int first, int n, bool isA, int tid) {
    const int lane = tid & 63, wave = tid >> 6;
    float* scr = (float*)(lds + wave * 8448);
#pragma unroll 1
    for (int i = 0; i < n; i += 2) {
        int L = 0, r;
        const int a = first + i * 8 + wave;
        if (isA) r = a < I_IN ? a : (a < I_IN + I_G ? I_IN + I_OUT + I_1 + I_2 + (a - I_IN) : I_IN + I_OUT + I_1 + I_2 + I_G + (a - I_IN - I_G));
        else if (a < CONV_B0) r = I_IN + a;
        else { L = 1; const int b1 = a - CONV_B0;
               r = b1 < I_IN ? b1 : (b1 < I_IN + I_G + 2 * I_C ? b1 - I_IN + (I_IN + I_OUT + I_1 + I_2) : b1 - (I_G + 2 * I_C)); }
        conv_wave_item(p, scr, L, r, lane);
    }
}
constexpr int CONV_B_SPLIT = (CONV_B0 + I_IN + I_G + 2 * I_C) / CONV_GRAN;
static_assert((CONV_B0 + I_IN + I_G + 2 * I_C) % CONV_GRAN == 0, "split on a block-item");
__device__ __forceinline__ void conv_fill(const Params& p, unsigned char* lds, int L, int max_items = 1 << 30) {
    const int tid = opaque_tid();
    volatile int* slot = (volatile int*)(lds + 131072 + 56);
    unsigned* qc = (unsigned*)(p.ws + WS_QUEUE) + (2 + L) * 64;
    const int first = L == 0 ? 0 : CONV_B_SPLIT, end = L == 0 ? CONV_B_SPLIT : CONV_B_BLK;
    if (tid == 0) slot[0] = first + (int)atomicAdd(qc, 1u);
    __syncthreads();
    int q = slot[0];
    for (int n = 0; q < end; ++n) {
        if (tid == 0) slot[(n + 1) & 1] = (n + 1 < max_items) ? first + (int)atomicAdd(qc, 1u) : end;
        conv_block_item(p, lds, q * CONV_GRAN, CONV_GRAN / 8, false, tid);
        __syncthreads();
        q = slot[(n + 1) & 1];
    }
    __syncthreads();
}

__device__ __forceinline__ void s5_precompute(const Params& p, int bi, int nb) {
    const int tid = opaque_tid();
    unsigned char* ws = p.ws;
    for (int it = (tid < 64 ? bi * 64 + tid : DEPTH * 32 * 64); it < DEPTH * 32 * 64; it += nb * 64) {
        const int L = it / (32 * 64), gp = it % (32 * 64), g = gp / 64;
        const float lr = p.in[4][(size_t)L * 2048 + gp], li = p.in[5][(size_t)L * 2048 + gp];
        const float dt = expf(p.in[6][L * 32 + g]);
        const float mag = expf(lr * dt);
        float sn, cs; sincosf(li * dt, &sn, &cs);
        const float lbr = mag * cs, lbi = mag * sn;
        const float den = lr * lr + li * li;
        const float fr = ((lbr - 1.0f) * lr + lbi * li) / den;
        const float fi = (lbi * lr - (lbr - 1.0f) * li) / den;
        unsigned char* pre = ws + WS_S5PRE + L * S5PRE_LAYER;
        float2* lb = (float2*)pre;
        bf16_t* bb16 = (bf16_t*)(pre + 16384);
        bf16_t* cm16 = (bf16_t*)(pre + 16384 + 131072);
        lb[gp] = make_float2(lbr, lbi);
        const int pst = gp & 63;
        const float* bre = p.in[7] + ((size_t)L * 2048 + gp) * 16;
        const float* bim = p.in[8] + ((size_t)L * 2048 + gp) * 16;
#pragma unroll
        for (int h = 0; h < 16; ++h) {
            bb16[((size_t)(g * 128 + 2 * pst)) * 16 + h] = (bf16_t)f2bf(fr * bre[h] - fi * bim[h]);
            bb16[((size_t)(g * 128 + 2 * pst + 1)) * 16 + h] = (bf16_t)f2bf(fr * bim[h] + fi * bre[h]);
        }
#pragma unroll
        for (int n = 0; n < 16; ++n) {
            const float cr = p.in[9][(((size_t)L * 32 + g) * 16 + n) * 64 + pst], ci = p.in[10][(((size_t)L * 32 + g) * 16 + n) * 64 + pst];
            *(unsigned*)(cm16 + ((size_t)(g * 16 + n)) * 128 + 2 * pst) = pk2(cr, -ci);
        }
    }
}

__device__ void phase_prologue(const Params& p, unsigned char* lds) {
    const int tid = opaque_tid(), lane = tid & 63, wave = tid >> 6;
    const int gw = blockIdx.x * NWAVES + wave, NGW = gridDim.x * NWAVES;
    unsigned char* ws = p.ws;
    for (int blk = blockIdx.x; blk < CONV_A_BLK; blk += gridDim.x) conv_block_item(p, lds, blk * 32, 4, true, tid);
    if (blockIdx.x == gridDim.x - 1 && wave == 0) {
        for (int L = 0; L < DEPTH; ++L) {
            const float lam_init = 0.8f - 0.6f * expf(-0.3f * (float)L);
            const float a = p.in[17][L * 64 + lane] * p.in[18][L * 64 + lane];
            const float c = p.in[19][L * 64 + lane] * p.in[20][L * 64 + lane];
            const float lamv = expf(wave_sum(a, lane)) - expf(wave_sum(c, lane)) + lam_init;
            if (lane == 0) { float* lw = (float*)(ws + WS_LAM) + 2 * L; lw[0] = lamv; lw[1] = lam_init; }
        }
    }
    const float* x = p.in[0];
    bf16_t* xb = (bf16_t*)(ws + WS_XB);
    float* sumsq = (float*)(ws + WS_SUMSQ);
    const int* pos = (const int*)p.in[1];
    float2* r128 = (float2*)(ws + WS_ROPE128);
    float2* r64 = (float2*)(ws + WS_ROPE64);
    for (int m0 = gw; m0 < MTOK; m0 += 2 * NGW) {
        const int m1 = m0 + NGW;
        f32x4 va[8], vb[8];
        const f32x4* xr0 = (const f32x4*)(x + (size_t)m0 * DM);
        const f32x4* xr1 = (const f32x4*)(x + (size_t)(m1 < MTOK ? m1 : m0) * DM);
#pragma unroll
        for (int j = 0; j < 8; ++j) va[j] = xr0[64 * j + lane];
#pragma unroll
        for (int j = 0; j < 8; ++j) vb[j] = xr1[64 * j + lane];
        const int pa = pos[m0], pb = pos[m1 < MTOK ? m1 : m0];
#pragma unroll
        for (int t = 0; t < 2; ++t) {
            const int m = t ? m1 : m0;
            if (m >= MTOK) break;
            float ss = 0.f;
#pragma unroll
            for (int j = 0; j < 8; ++j) {
                const f32x4 v = t ? vb[j] : va[j];
                ss += v.x * v.x + v.y * v.y + v.z * v.z + v.w * v.w;
                u32x2 o; o.x = pk2(v.x, v.y); o.y = pk2(v.z, v.w);
                *(u32x2*)(xb + (size_t)m * DM + 4 * (64 * j + lane)) = o;
            }
            ss = wave_sum(ss, lane);
            if (lane == 0) sumsq[m] = ss;
            const float fp = (float)(t ? pb : pa);
            { const float ang = fp * p.inv128[lane]; float s, c; sincosf(ang, &s, &c); r128[(size_t)m * 64 + lane] = make_float2(c, s); }
            if (lane < 32) { const float ang = fp * p.inv64[lane]; float s, c; sincosf(ang, &s, &c); r64[(size_t)m * 32 + lane] = make_float2(c, s); }
        }
    }
    if (gridDim.x != 256u) s5_precompute(p, (int)blockIdx.x, (int)gridDim.x);
}

namespace pg8 {
#define PG8_LAS __attribute__((address_space(3)))
typedef unsigned short bf16_t;
typedef short bf16x8 __attribute__((ext_vector_type(8)));
typedef float f32x4 __attribute__((ext_vector_type(4)));
typedef unsigned u32x4 __attribute__((ext_vector_type(4)));
constexpr int BM = 256, BK = 64, HALF = 128, HTB = HALF * BK * 2  , STAGE_BYTES = 8 * HTB, NXCD = 8, WGM = 4;

__host__ __device__ __forceinline__ int lds_byte(int r, int c) { const int st = (r >> 4) * 2 + (c >> 5), rr = r & 15, cc = c & 31, ob = rr * 64 + cc * 2; return st * 1024 + (ob ^ (((ob >> 9) & 1) << 5)); }
__host__ __device__ __forceinline__ void stage_rc(int b, int& R, int& C) { const int st = b / 1024, sb = b % 1024, swz = sb ^ (((sb >> 9) & 1) << 5); R = (st >> 1) * 16 + swz / 64; C = (st & 1) * 32 + (swz % 64) / 2; }
__host__ __device__ __forceinline__ int perm32(int rho) { const int n = rho >> 4, i = rho & 15; return 8 * (i >> 2) + 4 * n + (i & 3); }

struct Unit { int pm, pn; };
struct Gemm { const bf16_t* A; const bf16_t* Bt; int M, N, K; };

struct StaticOrder {
    int nM, nN, nwg, G, c;
    __host__ __device__ void init(int M, int N, int G_, int c_) { nM = M / BM; nN = N / BM; nwg = nM * nN; G = G_; c = c_; }
    __host__ __device__ bool next(int i, Unit& u) const {
        const long L = (long)i * G + c; if (L >= nwg) return false;
        int wgid = (int)L; { const int q = nwg / NXCD, r = nwg % NXCD, xcd = wgid % NXCD, off = wgid / NXCD; wgid = (xcd < r ? xcd * (q + 1) : r * (q + 1) + (xcd - r) * q) + off; }
        const int nig = WGM * nN, gid = wgid / nig, fm = gid * WGM, gsz = (nM - fm) < WGM ? (nM - fm) : WGM;
        u.pm = fm + ((wgid % nig) % gsz); u.pn = (wgid % nig) / gsz; return true;
    }
    __device__ __forceinline__ void a_ready(const Unit&) const {}
    __device__ __forceinline__ void done(const Unit&) const {}
};

__device__ __forceinline__ unsigned cvt_pk_bf16(float lo, float hi) { unsigned r; asm volatile("v_cvt_pk_bf16_f32 %0, %1, %2" : "=v"(r) : "v"(lo), "v"(hi)); return r; }
template <class Epi, class Sched, bool ALIGN_EPI = false, bool SP2 = false>
__device__ __forceinline__ void gemm_phase(PG8_LAS unsigned char* lds, const Gemm g, const Sched& S, const Epi& E) {
    const int tid = opaque_tid(), wid = __builtin_amdgcn_readfirstlane(tid >> 6), lane = tid & 63, wr = wid >> 2, wc = wid & 3, fr = lane & 15, fq = lane >> 4;
    const int K = g.K, nt = K / BK;
    unsigned voffA[2], voffB[2];
#pragma unroll
    for (int i = 0; i < 2; ++i) { int R, C; stage_rc(tid * 16 + i * 8192, R, C); const int Rb = Epi::PERM ? ((R & ~31) + perm32(R & 31)) : R;
        voffA[i] = (unsigned)(R * K + C) * 2u; voffB[i] = (unsigned)(Rb * K + C) * 2u; }
    const size_t kstep = (size_t)(BK * 2);
    const size_t hstep = (size_t)HALF * K * 2;
    const size_t tstep = 2 * hstep;
    const unsigned ldsw = (unsigned)wid * 1024u;
    const int aoff = lds_byte(wr * 64 + fr, fq * 8), boff = lds_byte(wc * 32 + fr, fq * 8);
#define PG8_SA(b, h) (((b) * 2 + (h)) * HTB)
#define PG8_SB(b, h) ((4 + (b) * 2 + (h)) * HTB)
#define PG8_STAGE(bufoff, gbase, voff) do { _Pragma("unroll") for (int _i = 0; _i < 2; ++_i) \
        __builtin_amdgcn_global_load_lds((const unsigned*)((const char*)(gbase) + (voff)[_i]), (PG8_LAS unsigned*)(lds + (bufoff) + ldsw + _i * 8192), 16, 0, 0); } while (0)
#define PG8_LDA(dst, b, h) do { _Pragma("unroll") for (int m = 0; m < 4; ++m) _Pragma("unroll") for (int k = 0; k < 2; ++k) dst[m][k] = *(const PG8_LAS bf16x8*)(lds + PG8_SA(b, h) + aoff + m * 2048 + k * 1024); } while (0)
#define PG8_LDB(dst, b, h) do { _Pragma("unroll") for (int n = 0; n < 2; ++n) _Pragma("unroll") for (int k = 0; k < 2; ++k) dst[n][k] = *(const PG8_LAS bf16x8*)(lds + PG8_SB(b, h) + boff + n * 2048 + k * 1024); } while (0)
#define PG8_MMA(ai, bj, At, Bt) do { __builtin_amdgcn_s_setprio(1); _Pragma("unroll") for (int m = 0; m < 4; ++m) _Pragma("unroll") for (int n = 0; n < 2; ++n) _Pragma("unroll") for (int k = 0; k < 2; ++k) \
        acc[ai][bj][m][n] = __builtin_amdgcn_mfma_f32_16x16x32_bf16(Bt[n][k], At[m][k], acc[ai][bj][m][n], 0, 0, 0); __builtin_amdgcn_s_setprio(0); } while (0)
#define PG8_WAIT_V(n) asm volatile("s_waitcnt vmcnt(" #n ")" ::: "memory")
#define PG8_WAIT_L(n) asm volatile("s_waitcnt lgkmcnt(" #n ")" ::: "memory")
#define PG8_BAR __builtin_amdgcn_s_barrier()
#define PG8_SCHED __builtin_amdgcn_sched_barrier(0)
    Unit cur, nxt; int ui = 0;
    if (!S.next(0, cur)) return;
    f32x4 acc[2][2][4][2];
#pragma unroll
    for (int a = 0; a < 2; ++a)
#pragma unroll
        for (int b = 0; b < 2; ++b)
#pragma unroll
            for (int m = 0; m < 4; ++m)
#pragma unroll
                for (int n = 0; n < 2; ++n) acc[a][b][m][n] = (f32x4){0.f, 0.f, 0.f, 0.f};
    bf16x8 At[4][2], B0[2][2], B1[2][2];
    const char* cA = (const char*)g.A + (size_t)cur.pm * tstep; const char* cB = (const char*)g.Bt + (size_t)cur.pn * tstep;
    S.a_ready(cur);
    if constexpr (SP2) {
        PG8_STAGE(PG8_SB(0, 0), cB, voffB); PG8_STAGE(PG8_SB(0, 1), cB + hstep, voffB); PG8_STAGE(PG8_SA(0, 0), cA, voffA); PG8_STAGE(PG8_SA(0, 1), cA + hstep, voffA);
        if (wr == 1) PG8_BAR;
        PG8_WAIT_V(2); PG8_BAR;
        PG8_STAGE(PG8_SB(1, 0), cB + kstep, voffB); PG8_STAGE(PG8_SA(1, 0), cA + kstep, voffA); PG8_STAGE(PG8_SB(1, 1), cB + hstep + kstep, voffB);
        PG8_WAIT_V(6); PG8_BAR;
    } else {
        PG8_STAGE(PG8_SB(0, 0), cB, voffB); PG8_STAGE(PG8_SA(0, 0), cA, voffA); PG8_STAGE(PG8_SB(0, 1), cB + hstep, voffB); PG8_STAGE(PG8_SA(0, 1), cA + hstep, voffA);
        if (wr == 1) PG8_BAR;
        PG8_WAIT_V(4); PG8_BAR;
        PG8_STAGE(PG8_SB(1, 0), cB + kstep, voffB); PG8_STAGE(PG8_SA(1, 0), cA + kstep, voffA); PG8_STAGE(PG8_SB(1, 1), cB + hstep + kstep, voffB);
        PG8_WAIT_V(6); PG8_BAR;
    }
    for (;;) {
        const bool has_next = S.next(ui + 1, nxt);
        const char* nA = has_next ? (const char*)g.A + (size_t)nxt.pm * tstep : cA; const char* nB = has_next ? (const char*)g.Bt + (size_t)nxt.pn * tstep : cB;
        for (int t = 0; t < nt; t += 2) {
            const bool last = (t == nt - 2);
            const char* a1 = cA + (size_t)(t + 1) * kstep;
            const char* a2 = last ? nA : cA + (size_t)(t + 2) * kstep; const char* b2 = last ? nB : cB + (size_t)(t + 2) * kstep;
            const char* a3 = a2 + kstep; const char* b3 = b2 + kstep;
            if (last && has_next) S.a_ready(nxt);
            if constexpr (SP2) {
            PG8_LDB(B0, 0, 0); PG8_LDB(B1, 0, 1); PG8_SCHED; PG8_LDA(At, 0, 0); PG8_STAGE(PG8_SA(1, 1), a1 + hstep, voffA);
            PG8_WAIT_V(8); PG8_WAIT_L(0); PG8_BAR; PG8_MMA(0, 0, At, B0); PG8_MMA(0, 1, At, B1); PG8_BAR; PG8_SCHED;
            PG8_LDA(At, 0, 1); PG8_STAGE(PG8_SB(0, 0), b2, voffB); PG8_STAGE(PG8_SB(0, 1), b2 + hstep, voffB); PG8_STAGE(PG8_SA(0, 0), a2, voffA);
            PG8_WAIT_V(8); PG8_WAIT_L(0); PG8_BAR; PG8_MMA(1, 0, At, B0); PG8_MMA(1, 1, At, B1); PG8_BAR; PG8_SCHED;
            PG8_LDB(B0, 1, 0); PG8_LDB(B1, 1, 1); PG8_SCHED; PG8_LDA(At, 1, 0); PG8_STAGE(PG8_SA(0, 1), a2 + hstep, voffA);
            PG8_WAIT_V(8); PG8_WAIT_L(0); PG8_BAR; PG8_MMA(0, 0, At, B0); PG8_MMA(0, 1, At, B1); PG8_BAR; PG8_SCHED;
            PG8_LDA(At, 1, 1); PG8_STAGE(PG8_SB(1, 0), b3, voffB); PG8_STAGE(PG8_SB(1, 1), b3 + hstep, voffB); PG8_STAGE(PG8_SA(1, 0), a3, voffA);
            PG8_WAIT_V(8); PG8_WAIT_L(0); PG8_BAR; PG8_MMA(1, 0, At, B0); PG8_MMA(1, 1, At, B1); PG8_BAR; PG8_SCHED;
            } else {
            PG8_LDB(B0, 0, 0); PG8_SCHED; PG8_LDA(At, 0, 0); PG8_STAGE(PG8_SA(1, 1), a1 + hstep, voffA);
            PG8_WAIT_L(8); PG8_BAR; PG8_WAIT_L(0); PG8_MMA(0, 0, At, B0); PG8_BAR; PG8_SCHED;
            PG8_LDB(B1, 0, 1); PG8_STAGE(PG8_SB(0, 0), b2, voffB);
            PG8_BAR; PG8_WAIT_L(0); PG8_MMA(0, 1, At, B1); PG8_BAR;
            PG8_LDA(At, 0, 1); PG8_STAGE(PG8_SA(0, 0), a2, voffA);
            PG8_BAR; PG8_WAIT_L(0); PG8_MMA(1, 0, At, B0); PG8_BAR; PG8_SCHED;
            PG8_STAGE(PG8_SB(0, 1), b2 + hstep, voffB);
            PG8_WAIT_V(6); PG8_BAR; PG8_MMA(1, 1, At, B1); PG8_BAR;
            PG8_LDB(B0, 1, 0); PG8_SCHED; PG8_LDA(At, 1, 0); PG8_STAGE(PG8_SA(0, 1), a2 + hstep, voffA);
            PG8_WAIT_L(8); PG8_BAR; PG8_WAIT_L(0); PG8_MMA(0, 0, At, B0); PG8_BAR; PG8_SCHED;
            PG8_LDB(B1, 1, 1); PG8_STAGE(PG8_SB(1, 0), b3, voffB);
            PG8_BAR; PG8_WAIT_L(0); PG8_MMA(0, 1, At, B1); PG8_BAR;
            PG8_LDA(At, 1, 1); PG8_STAGE(PG8_SA(1, 0), a3, voffA);
            PG8_BAR; PG8_WAIT_L(0); PG8_MMA(1, 0, At, B0); PG8_BAR; PG8_SCHED;
            PG8_STAGE(PG8_SB(1, 1), b3 + hstep, voffB);
            PG8_WAIT_V(6); PG8_BAR; PG8_MMA(1, 1, At, B1); PG8_BAR;
            }
        }
        if constexpr (ALIGN_EPI) { if (wr == 0) PG8_BAR; }
        if constexpr (!Epi::AFTER_DRAIN) { E(acc, cur, wr, wc, fr, fq); S.done(cur); }
        if (!has_next) break;
#pragma unroll
        for (int a = 0; a < 2; ++a)
#pragma unroll
            for (int b = 0; b < 2; ++b)
#pragma unroll
                for (int m = 0; m < 4; ++m)
#pragma unroll
                    for (int n = 0; n < 2; ++n) acc[a][b][m][n] = (f32x4){0.f, 0.f, 0.f, 0.f};
        cur = nxt; cA = nA; cB = nB; ++ui;
        if constexpr (ALIGN_EPI) { if (wr == 1) PG8_BAR; }
    }
    PG8_WAIT_V(0);
    if constexpr (!ALIGN_EPI) { if (wr == 0) PG8_BAR; }
    PG8_BAR;
    if constexpr (Epi::AFTER_DRAIN) { E.fused(acc, cur, wr, wc, fr, fq, lds, wid, lane); S.done(cur); }
#undef PG8_SA
#undef PG8_SB
#undef PG8_STAGE
#undef PG8_LDA
#undef PG8_LDB
#undef PG8_MMA
#undef PG8_WAIT_V
#undef PG8_WAIT_L
#undef PG8_BAR
#undef PG8_SCHED
}
}

struct EpiScale {
    static constexpr bool PERM = true, AFTER_DRAIN = false;
    bf16_t* O; int ldc; int relu2;
    const float* rbase; int rmask;
    __device__ __forceinline__ void operator()(const f32x4 (&acc)[2][2][4][2], const pg8::Unit& u, int wr, int wc, int fr, int fq) const {
        const int row0 = u.pm * 256 + wr * 64 + fr, col0 = u.pn * 256 + wc * 32 + 8 * fq;
        float rs[2][4];
        const float* rp = rbase + ((u.pm * 256) & rmask) + wr * 64 + fr;
#pragma unroll
        for (int ai = 0; ai < 2; ++ai)
#pragma unroll
            for (int m = 0; m < 4; ++m) rs[ai][m] = rp[ai * 128 + m * 16];
#pragma unroll
        for (int ai = 0; ai < 2; ++ai)
#pragma unroll
            for (int m = 0; m < 4; ++m) {
                const int row = row0 + ai * 128 + m * 16;
                const float rstd = rsqrtf(rs[ai][m] * (1.0f / DM) + EPS);
                bf16_t* rowp = O + (size_t)row * ldc + col0;
#pragma unroll
                for (int bj = 0; bj < 2; ++bj) {
                    f32x4 v0 = acc[ai][bj][m][0] * rstd, v1 = acc[ai][bj][m][1] * rstd;
                    if (relu2) {
                        v0.x = fmaxf(v0.x, 0.f); v0.y = fmaxf(v0.y, 0.f); v0.z = fmaxf(v0.z, 0.f); v0.w = fmaxf(v0.w, 0.f);
                        v1.x = fmaxf(v1.x, 0.f); v1.y = fmaxf(v1.y, 0.f); v1.z = fmaxf(v1.z, 0.f); v1.w = fmaxf(v1.w, 0.f);
                        v0 = v0 * v0; v1 = v1 * v1;
                    }
                    u32x4 w; w.x = pg8::cvt_pk_bf16(v0[0], v0[1]); w.y = pg8::cvt_pk_bf16(v0[2], v0[3]); w.z = pg8::cvt_pk_bf16(v1[0], v1[1]); w.w = pg8::cvt_pk_bf16(v1[2], v1[3]);
                    *(u32x4*)(rowp + bj * 128) = w;
                }
                asm volatile("" ::: "memory");
            }
    }
};
struct EpiResid {
    static constexpr bool PERM = true, AFTER_DRAIN = false;
    bf16_t* xb; float* xout; int write_xb; float* sumsq_next;
    __device__ __forceinline__ void operator()(const f32x4 (&acc)[2][2][4][2], const pg8::Unit& u, int wr, int wc, int fr, int fq) const {
        const int row0 = u.pm * 256 + wr * 64 + fr, col0 = u.pn * 256 + wc * 32 + 8 * fq;
        constexpr int DEPTH_R = 7;
        u32x4 res[DEPTH_R][2];
#define EPR_LOAD(slot, g) do { _Pragma("unroll") for (int bj = 0; bj < 2; ++bj) res[slot][bj] = *(const u32x4*)(xb + (size_t)(row0 + ((g) >> 2) * 128 + ((g) & 3) * 16) * DM + col0 + bj * 128); } while (0)
#pragma unroll
        for (int g = 0; g < DEPTH_R; ++g) EPR_LOAD(g, g);
#pragma unroll
        for (int g = 0; g < 8; ++g) {
            const int ai = g >> 2, m = g & 3, row = row0 + ai * 128 + m * 16;
            float ss = 0.f;
#pragma unroll
            for (int bj = 0; bj < 2; ++bj) {
                const size_t off = (size_t)row * DM + col0 + bj * 128;
                const u32x4 rb = res[g % DEPTH_R][bj];
                f32x4 v0 = acc[ai][bj][m][0], v1 = acc[ai][bj][m][1];
                v0[0] += __uint_as_float(rb.x << 16); v0[1] += __uint_as_float(rb.x & 0xffff0000u); v0[2] += __uint_as_float(rb.y << 16); v0[3] += __uint_as_float(rb.y & 0xffff0000u);
                v1[0] += __uint_as_float(rb.z << 16); v1[1] += __uint_as_float(rb.z & 0xffff0000u); v1[2] += __uint_as_float(rb.w << 16); v1[3] += __uint_as_float(rb.w & 0xffff0000u);
                if (xout) { *(f32x4*)(xout + off) = v0; *(f32x4*)(xout + off + 4) = v1; }
                if (write_xb) { u32x4 o; o.x = pg8::cvt_pk_bf16(v0[0], v0[1]); o.y = pg8::cvt_pk_bf16(v0[2], v0[3]); o.z = pg8::cvt_pk_bf16(v1[0], v1[1]); o.w = pg8::cvt_pk_bf16(v1[2], v1[3]); *(u32x4*)(xb + off) = o; }
                ss += ((v0[0] * v0[0] + v0[1] * v0[1]) + (v0[2] * v0[2] + v0[3] * v0[3])) + ((v1[0] * v1[0] + v1[1] * v1[1]) + (v1[2] * v1[2] + v1[3] * v1[3]));
            }
            if (sumsq_next) {
                ss += shx(ss, 16, fq * 16 + fr); ss += shx(ss, 32, fq * 16 + fr);
                if (fq == 0) atomicAdd(sumsq_next + row, ss);
            }
            if (g + DEPTH_R < 8) { asm volatile("" ::: "memory"); EPR_LOAD(g % DEPTH_R, g + DEPTH_R); }
        }
#undef EPR_LOAD
    }
};
struct EpiGlu {
    static constexpr bool PERM = true, AFTER_DRAIN = false;
    const bf16_t* y; bf16_t* mixed;
    __device__ __forceinline__ void operator()(const f32x4 (&acc)[2][2][4][2], const pg8::Unit& u, int wr, int wc, int fr, int fq) const {
        const int row0 = u.pm * 256 + wr * 64 + fr, col0 = u.pn * 256 + wc * 32 + 8 * fq;
        constexpr int DEPTH_Y = 6;
        u32x4 ys[DEPTH_Y][2];
#define EPG_LOAD(slot, g) do { _Pragma("unroll") for (int bj = 0; bj < 2; ++bj) ys[slot][bj] = *(const u32x4*)(y + (size_t)(row0 + ((g) >> 2) * 128 + ((g) & 3) * 16) * 512 + col0 + bj * 128); } while (0)
#pragma unroll
        for (int g = 0; g < DEPTH_Y; ++g) EPG_LOAD(g, g);
#pragma unroll
        for (int g = 0; g < 8; ++g) {
            const int ai = g >> 2, m = g & 3, row = row0 + ai * 128 + m * 16;
#pragma unroll
            for (int bj = 0; bj < 2; ++bj) {
                const int col = col0 + bj * 128;
                const u32x4 yv = ys[g % DEPTH_Y][bj];
                const f32x4 a0 = acc[ai][bj][m][0], a1 = acc[ai][bj][m][1];
                float r[8];
#pragma unroll
                for (int e = 0; e < 4; ++e) {
                    const unsigned w = yv[e];
                    const float ylo = __uint_as_float(w << 16), yhi = __uint_as_float(w & 0xffff0000u);
                    const float alo = e < 2 ? a0[2 * e] : a1[2 * (e - 2)], ahi = e < 2 ? a0[2 * e + 1] : a1[2 * (e - 2) + 1];
                    r[2 * e] = ylo * __builtin_amdgcn_rcpf(1.f + __expf(-alo)); r[2 * e + 1] = yhi * __builtin_amdgcn_rcpf(1.f + __expf(-ahi));
                }
                u32x4 w; w.x = pg8::cvt_pk_bf16(r[0], r[1]); w.y = pg8::cvt_pk_bf16(r[2], r[3]); w.z = pg8::cvt_pk_bf16(r[4], r[5]); w.w = pg8::cvt_pk_bf16(r[6], r[7]);
                *(u32x4*)(mixed + (size_t)row * DM + col) = w;
            }
            if (g + DEPTH_Y < 8) { asm volatile("" ::: "memory"); EPG_LOAD(g % DEPTH_Y, g + DEPTH_Y); }
        }
#undef EPG_LOAD
    }
};
template <class Epi>
__device__ __forceinline__ void run_gemm(unsigned char* lds, const bf16_t* A, const bf16_t* Bt, int M, int N, int K, const Epi& E) {
    pg8::Gemm g{A, Bt, M, N, K};
    pg8::StaticOrder S; S.init(M, N, (int)gridDim.x, (int)blockIdx.x);
    pg8::gemm_phase<Epi, pg8::StaticOrder, true, true>((PG8_LAS unsigned char*)lds, g, S, E);
}

namespace att {
#define ATT_LAS __attribute__((address_space(3)))
typedef float f32x16 __attribute__((ext_vector_type(16)));
typedef short s16x4 __attribute__((ext_vector_type(4)));
typedef ATT_LAS const unsigned char* ldscp;
typedef ATT_LAS unsigned char* ldsp;
constexpr int TILE = 16384, BUFB = 32768;
constexpr float NEG = -1e30f;
__device__ __forceinline__ unsigned off_b(unsigned row, unsigned ch) { return 256u * row + 16u * (ch ^ (((row & 3u) << 2) | ((row >> 2) & 3u))); }
__device__ __forceinline__ int crow(int r, int hi) { return (r & 3) + 8 * (r >> 2) + 4 * hi; }

struct Stage { int dummy; };
__device__ __forceinline__ void stage_dma(const bf16_t* K, int kpitch, const bf16_t* V, int vpitch, int key0, int kmax, ldsp buf, int tid) {
    const int lane = tid & 63, wv = __builtin_amdgcn_readfirstlane(tid >> 6);
#pragma unroll
    for (int h = 0; h < 2; ++h) {
        const int i = wv + 8 * h;
        const int r = 4 * i + (lane >> 4), s = lane & 15;
        const int ch = s ^ (((r & 3) << 2) | ((r >> 2) & 3));
        int kr = key0 + r; kr = kr < 0 ? 0 : (kr > kmax ? kmax : kr);
        __builtin_amdgcn_global_load_lds((const unsigned*)(K + (size_t)kr * kpitch + 8 * ch), (ATT_LAS unsigned*)(buf + i * 1024), 16, 0, 0);
        __builtin_amdgcn_global_load_lds((const unsigned*)(V + (size_t)kr * vpitch + 8 * ch), (ATT_LAS unsigned*)(buf + TILE + i * 1024), 16, 0, 0);
    }
}
#define ATT_DMA_WAIT() asm volatile("s_waitcnt vmcnt(0)" ::: "memory")
constexpr int NRING = 4;
__device__ __forceinline__ void ring_wait(int rem) {
    if (rem >= 2) asm volatile("s_waitcnt vmcnt(8)" ::: "memory");
    else if (rem == 1) asm volatile("s_waitcnt vmcnt(4)" ::: "memory");
    else asm volatile("s_waitcnt vmcnt(0)" ::: "memory");
}
struct WaveCtx { int lane, r32, hi, kch0; };
__device__ __forceinline__ void ctx_init(WaveCtx& w, int lane, int kch0) { w.lane = lane; w.r32 = lane & 31; w.hi = lane >> 5; w.kch0 = kch0; }
#define ATT_SB() __builtin_amdgcn_sched_barrier(0)
template <int NKS>
__device__ __forceinline__ void qk(ldscp Kt, const WaveCtx& w, const bf16x8 (&qf)[NKS], f32x16& p0, f32x16& p1) {
#pragma unroll
    for (int r = 0; r < 16; ++r) { p0[r] = 0.f; p1[r] = 0.f; }
    int ln = w.lane; asm volatile("" : "+v"(ln));
    const unsigned r32 = ln & 31, hi = ln >> 5;
    bf16x8 ka[3][2];
#define ATT_KLOAD(buf, b) do { const unsigned ko = off_b(r32, (w.kch0 + 2 * (b) + hi) & 15); \
        ka[buf][0] = *(const ATT_LAS bf16x8*)(Kt + ko); ka[buf][1] = *(const ATT_LAS bf16x8*)(Kt + ko + 8192); } while (0)
#define ATT_KMMA(buf, b) do { \
        p0 = __builtin_amdgcn_mfma_f32_32x32x16_bf16(ka[buf][0], qf[b], p0, 0, 0, 0); \
        p1 = __builtin_amdgcn_mfma_f32_32x32x16_bf16(ka[buf][1], qf[b], p1, 0, 0, 0); } while (0)
    ATT_KLOAD(0, 0); ATT_KLOAD(1, 1); ATT_SB();
#pragma unroll
    for (int b = 0; b < NKS; ++b) {
        if (b + 2 < NKS) { if (b % 3 == 0) ATT_KLOAD(2, b + 2); else if (b % 3 == 1) ATT_KLOAD(0, b + 2); else ATT_KLOAD(1, b + 2); }
        if (b % 3 == 0) ATT_KMMA(0, b); else if (b % 3 == 1) ATT_KMMA(1, b); else ATT_KMMA(2, b);
        if (b + 2 < NKS) __builtin_amdgcn_sched_group_barrier(0x100, 2, 0);
        __builtin_amdgcn_sched_group_barrier(0x008, 2, 0);
        ATT_SB();
    }
#undef ATT_KLOAD
#undef ATT_KMMA
}
__device__ __forceinline__ s16x4 trd(unsigned addr, int off) { s16x4 r; asm volatile("ds_read_b64_tr_b16 %0, %1 offset:%c2" : "=v"(r) : "v"(addr), "i"(off)); return r; }
__device__ __forceinline__ void pv(ldscp Vt, const WaveCtx& w, const bf16x8 (&pf)[2][2], f32x16 (&o)[4]) {
    int ln = w.lane; asm volatile("" : "+v"(ln));
    const unsigned hh = ln >> 5, blk = (ln >> 4) & 1, q = (ln & 15) >> 2, pp = ln & 3;
    const unsigned vbase = (unsigned)(uintptr_t)Vt;
    s16x4 vl[2][4], vh[2][4];
#define ATT_VLOAD(buf, c) do { const unsigned vo0 = vbase + off_b(4 * hh + q, 4 * (c) + 2 * blk + (pp >> 1)) + 8 * (pp & 1), vo1 = vbase + off_b(8 + 4 * hh + q, 4 * (c) + 2 * blk + (pp >> 1)) + 8 * (pp & 1); \
        vl[buf][0] = trd(vo0, 0); vh[buf][0] = trd(vo1, 0); vl[buf][1] = trd(vo0, 4096); vh[buf][1] = trd(vo1, 4096); \
        vl[buf][2] = trd(vo0, 8192); vh[buf][2] = trd(vo1, 8192); vl[buf][3] = trd(vo0, 12288); vh[buf][3] = trd(vo1, 12288); } while (0)
#define ATT_VMMA(buf, c) do { _Pragma("unroll") for (int kb = 0; kb < 2; ++kb) _Pragma("unroll") for (int s = 0; s < 2; ++s) { \
            const s16x4 lo = vl[buf][2 * kb + s], hi4 = vh[buf][2 * kb + s]; \
            const bf16x8 vf = (bf16x8){lo[0], lo[1], lo[2], lo[3], hi4[0], hi4[1], hi4[2], hi4[3]}; \
            o[c] = __builtin_amdgcn_mfma_f32_32x32x16_bf16(vf, pf[kb][s], o[c], 0, 0, 0); } } while (0)
#define ATT_LWAIT(n) do { asm volatile("s_waitcnt lgkmcnt(" #n ")" ::: "memory"); ATT_SB(); } while (0)
    asm volatile("s_waitcnt lgkmcnt(0)" ::: "memory"); ATT_SB();
    ATT_VLOAD(0, 0); ATT_SB();
    ATT_VLOAD(1, 1); ATT_LWAIT(8); ATT_VMMA(0, 0); ATT_SB();
    ATT_VLOAD(0, 2); ATT_LWAIT(8); ATT_VMMA(1, 1); ATT_SB();
    ATT_VLOAD(1, 3); ATT_LWAIT(8); ATT_VMMA(0, 2); ATT_SB();
    ATT_LWAIT(0); ATT_VMMA(1, 3); ATT_SB();
#undef ATT_VLOAD
#undef ATT_VMMA
#undef ATT_LWAIT
}
__device__ __forceinline__ void pack_p(const f32x16& p0, const f32x16& p1, bf16x8 (&pf)[2][2]) {
#pragma unroll
    for (int s = 0; s < 2; ++s) {
        u32x4 a, b;
#pragma unroll
        for (int i = 0; i < 4; ++i) { a[i] = pg8::cvt_pk_bf16(p0[8 * s + 2 * i], p0[8 * s + 2 * i + 1]); b[i] = pg8::cvt_pk_bf16(p1[8 * s + 2 * i], p1[8 * s + 2 * i + 1]); }
        pf[0][s] = __builtin_bit_cast(bf16x8, a); pf[1][s] = __builtin_bit_cast(bf16x8, b);
    }
}
__device__ __forceinline__ void apply_bounds(f32x16& p0, f32x16& p1, int klo, int khi, int hi) {
#pragma unroll
    for (int r = 0; r < 16; ++r) {
        const int k = crow(r, hi);
        if (k < klo || k > khi) p0[r] = NEG;
        if (k + 32 < klo || k + 32 > khi) p1[r] = NEG;
    }
}
__device__ __forceinline__ float ex2(float x) { return __builtin_amdgcn_exp2f(x); }
template <int NKS>
__device__ __forceinline__ void tile_softmax(ldscp Kt, ldscp Vt, const WaveCtx& w, const bf16x8 (&qf)[NKS], f32x16 (&o)[4], float& m, float& l, float c, bool need_mask, int klo, int khi, bool use_rowmask = false, bool row_ok = true) {
    f32x16 p0, p1;
    qk<NKS>(Kt, w, qf, p0, p1);
    if (need_mask) apply_bounds(p0, p1, klo, khi, w.hi);
    float mx = fmaxf(p0[0], p1[0]);
#pragma unroll
    for (int r = 1; r < 16; ++r) mx = fmaxf(mx, fmaxf(p0[r], p1[r]));
    if (use_rowmask && !row_ok) mx = NEG;
    mx = half_max(mx);
    const float mnew = fmaxf(m, mx * c);
    const float alpha = ex2(m - mnew);
    m = mnew;
    float ls = 0.f;
#pragma unroll
    for (int r = 0; r < 16; ++r) { p0[r] = ex2(fmaf(p0[r], c, -mnew)); p1[r] = ex2(fmaf(p1[r], c, -mnew)); ls += p0[r] + p1[r]; }
    if (use_rowmask && !row_ok) ls = 0.f;
    l = l * alpha + ls;
    if (__any(alpha != 1.f)) {
#pragma unroll
        for (int cc = 0; cc < 4; ++cc)
#pragma unroll
            for (int r = 0; r < 16; ++r) o[cc][r] *= alpha;
    }
    bf16x8 pf[2][2];
    pack_p(p0, p1, pf);
    if (use_rowmask) {
        const unsigned keep = row_ok ? 0xffffffffu : 0u;
#pragma unroll
        for (int a = 0; a < 2; ++a)
#pragma unroll
            for (int b2 = 0; b2 < 2; ++b2) { u32x4 t = __builtin_bit_cast(u32x4, pf[a][b2]); t.x &= keep; t.y &= keep; t.z &= keep; t.w &= keep; pf[a][b2] = __builtin_bit_cast(bf16x8, t); }
    }
    pv(Vt, w, pf, o);
}
}

__device__ __forceinline__ float row16_sum(float v) {
    v += __int_as_float(__builtin_amdgcn_mov_dpp(__float_as_int(v), 0xB1, 0xF, 0xF, true));
    v += __int_as_float(__builtin_amdgcn_mov_dpp(__float_as_int(v), 0x4E, 0xF, 0xF, true));
    v += __int_as_float(__builtin_amdgcn_mov_dpp(__float_as_int(v), 0x141, 0xF, 0xF, true));
    v += __int_as_float(__builtin_amdgcn_mov_dpp(__float_as_int(v), 0x140, 0xF, 0xF, true));
    return v;
}
typedef float f32x2p __attribute__((ext_vector_type(2)));
__device__ void phase_prep(const Params& p) {
    const int tid = opaque_tid(), lane = tid & 63, wave = tid >> 6;
    if ((int)blockIdx.x < (int)gridDim.x / 2) return;
    const int gw = ((int)blockIdx.x - (int)gridDim.x / 2) * NWAVES + wave, NGW = ((int)gridDim.x - (int)gridDim.x / 2) * NWAVES;
    bf16_t* proj = (bf16_t*)(p.ws + WS_PROJ);
    const float2* r128 = (const float2*)(p.ws + WS_ROPE128);
    const float2* r64 = (const float2*)(p.ws + WS_ROPE64);
    const bool up32 = lane >= 32, up16 = (lane & 16) != 0;
    for (int m0 = 2 * gw; m0 < MTOK; m0 += 2 * NGW) {
        unsigned xa[2][14], ya[2][8]; f32x4 ca[2], cb[2];
#pragma unroll
        for (int t = 0; t < 2; ++t) {
            const bf16_t* row = proj + (size_t)(m0 + t) * PP;
            ca[t] = *(const f32x4*)(r128 + (size_t)(m0 + t) * 64 + 2 * (lane & 31));
            cb[t] = *(const f32x4*)(r64 + (size_t)(m0 + t) * 32 + 2 * (lane & 15));
#pragma unroll
            for (int hh = 0; hh < 14; ++hh) {
                const int col = hh < 4 ? C_RQ + hh * 128 : (hh < 8 ? C_RK + (hh - 4) * 128 : (hh < 12 ? C_NQ + (hh - 8) * 128 : (hh == 12 ? C_NKS : C_NKW)));
                xa[t][hh] = *(const unsigned*)(row + col + 2 * lane);
            }
#pragma unroll
            for (int hp = 0; hp < 8; ++hp) {
                const int col = hp < 4 ? C_DQ + hp * 128 : C_DK + (hp - 4) * 128;
                ya[t][hp] = *(const unsigned*)(row + col + 2 * lane);
            }
        }
#pragma unroll
        for (int t = 0; t < 2; ++t) {
            bf16_t* row = proj + (size_t)(m0 + t) * PP;
            const f32x2p C1 = (f32x2p){ca[t].x, ca[t].z}, S1 = up32 ? (f32x2p){ca[t].y, ca[t].w} : (f32x2p){-ca[t].y, -ca[t].w};
#pragma unroll
            for (int hh = 0; hh < 14; ++hh) {
                const int col = hh < 4 ? C_RQ + hh * 128 : (hh < 8 ? C_RK + (hh - 4) * 128 : (hh < 12 ? C_NQ + (hh - 8) * 128 : (hh == 12 ? C_NKS : C_NKW)));
                const unsigned v = xa[t][hh];
                const auto sw = __builtin_amdgcn_permlane32_swap(v, v, false, false);
                const unsigned pv_ = sw[0] ^ sw[1] ^ v;
                const f32x2p o = (f32x2p){__uint_as_float(v << 16), __uint_as_float(v & 0xffff0000u)}, q = (f32x2p){__uint_as_float(pv_ << 16), __uint_as_float(pv_ & 0xffff0000u)};
                f32x2p r = o * C1 + q * S1;
                if (hh >= 8) {
                    const f32x2p sq = o * o;
                    float rsum = row16_sum(sq.x + sq.y);
                    rsum += __builtin_bit_cast(float, __builtin_amdgcn_update_dpp(0, __builtin_bit_cast(int, rsum), 0x142, 0xa, 0xf, false));
                    rsum += __builtin_bit_cast(float, __builtin_amdgcn_update_dpp(0, __builtin_bit_cast(int, rsum), 0x143, 0xc, 0xf, false));
                    const float tot = __int_as_float(__builtin_amdgcn_readlane(__float_as_int(rsum), 63));
                    r = r * rsqrtf(tot * (1.f / 128.f) + EPS);
                } else if (hh >= 4) r = r * 0.08838834764831845f;
                *(unsigned*)(row + col + 2 * lane) = pg8::cvt_pk_bf16(r.x, r.y);
            }
            const f32x2p C2 = (f32x2p){cb[t].x, cb[t].z}, S2 = up16 ? (f32x2p){cb[t].y, cb[t].w} : (f32x2p){-cb[t].y, -cb[t].w};
#pragma unroll
            for (int hp = 0; hp < 8; ++hp) {
                const int col = hp < 4 ? C_DQ + hp * 128 : C_DK + (hp - 4) * 128;
                const unsigned v = ya[t][hp];
                const auto sw = __builtin_amdgcn_permlane16_swap(v, v, false, false);
                const unsigned pv_ = sw[0] ^ sw[1] ^ v;
                const f32x2p o = (f32x2p){__uint_as_float(v << 16), __uint_as_float(v & 0xffff0000u)}, q = (f32x2p){__uint_as_float(pv_ << 16), __uint_as_float(pv_ & 0xffff0000u)};
                const f32x2p sq = o * o;
                float rsum = row16_sum(sq.x + sq.y);
                rsum += __builtin_bit_cast(float, __builtin_amdgcn_update_dpp(0, __builtin_bit_cast(int, rsum), 0x142, 0xa, 0xf, false));
                const float h0 = __int_as_float(__builtin_amdgcn_readlane(__float_as_int(rsum), 31)), h1 = __int_as_float(__builtin_amdgcn_readlane(__float_as_int(rsum), 63));
                const float mul = rsqrtf((up32 ? h1 : h0) * (1.f / 64.f) + EPS);
                const f32x2p r = (o * C2 + q * S2) * mul;
                *(unsigned*)(row + col + 2 * lane) = pg8::cvt_pk_bf16(r.x, r.y);
            }
        }
    }
}

__device__ __forceinline__ void diff_unit(const Params& p, unsigned char* lds, int unit, float lam, float lam_init, unsigned* qctr, volatile int* nslot) {
    const int tid = opaque_tid(), lane = tid & 63, wave = __builtin_amdgcn_readfirstlane(tid >> 6);
    const int qb = 15 - (unit & 15), bh = unit >> 4, h = bh & 3, b = bh >> 2;
    const int comp = wave >> 2, qsub = wave & 3, q0 = qb * 128 + qsub * 32;
    att::WaveCtx w; att::ctx_init(w, lane, 8 * comp);
    const int tq = q0 + w.r32;
    const bf16_t* base = (const bf16_t*)(p.ws + WS_PROJ) + (size_t)b * SEQ * PP;
    bf16x8 qf[4];
#pragma unroll
    for (int ks = 0; ks < 4; ++ks) qf[ks] = *(const bf16x8*)(base + (size_t)tq * PP + C_DQ + h * 128 + comp * 64 + 16 * ks + 8 * w.hi);
    att::f32x16 o[4];
#pragma unroll
    for (int c = 0; c < 4; ++c)
#pragma unroll
        for (int r = 0; r < 16; ++r) o[c][r] = 0.f;
    float m = att::NEG, l = 0.f;
    const float csc = 0.125f * 1.4426950408889634f;
    const bf16_t* Kg = base + C_DK + h * 128; const bf16_t* Vg = base + C_DV + h * 128;
    const int nt = 2 * qb + 2;
    att::ldsp L3 = (att::ldsp)lds;
    ATT_DMA_WAIT();
#pragma unroll
    for (int ks = 0; ks < 4; ++ks) asm volatile("" : "+v"(qf[ks]));
    int issued = 0;
    for (; issued < nt && issued < att::NRING - 1; ++issued) att::stage_dma(Kg, PP, Vg, PP, issued * 64, SEQ - 1, L3 + issued * att::BUFB, tid);
    for (int kt = 0; kt < nt; ++kt) {
        att::ring_wait(issued - 1 - kt);
        __syncthreads();
        if (issued < nt) { att::stage_dma(Kg, PP, Vg, PP, issued * 64, SEQ - 1, L3 + (issued & (att::NRING - 1)) * att::BUFB, tid); ++issued; }
        const int cur = kt & (att::NRING - 1);
        const int key0 = kt * 64;
        if (key0 <= q0 + 31)
            att::tile_softmax<4>((att::ldscp)(L3 + cur * att::BUFB), (att::ldscp)(L3 + cur * att::BUFB + att::TILE), w, qf, o, m, l, csc, key0 + 63 > q0, 0, tq - key0);
    }
    __syncthreads();
    if (tid == 0) *nslot = (int)atomicAdd(qctr, 1u);
    const float linv = 1.f / half_sum(l);
    float* cb = (float*)lds;
    if (comp == 1) {
#pragma unroll
        for (int c = 0; c < 4; ++c)
#pragma unroll
            for (int r = 0; r < 16; ++r) cb[(qsub * 128 + 32 * c + att::crow(r, w.hi)) * 32 + w.r32] = o[c][r] * linv * lam;
    }
    __syncthreads();
    if (comp == 0) {
        float ss = 0.f;
#pragma unroll
        for (int c = 0; c < 4; ++c)
#pragma unroll
            for (int r = 0; r < 16; ++r) { const float v = o[c][r] * linv - cb[(qsub * 128 + 32 * c + att::crow(r, w.hi)) * 32 + w.r32]; o[c][r] = v; ss += v * v; }
        ss = half_sum(ss);
        const float sc = rsqrtf(ss * (1.f / 128.f) + EPS) * (1.f - lam_init);
        bf16_t* orow = (bf16_t*)(p.ws + WS_MIXED) + ((size_t)b * SEQ + tq) * DM + 1536 + h * 128;
#pragma unroll
        for (int c = 0; c < 4; ++c)
#pragma unroll
            for (int g = 0; g < 4; ++g) {
                u32x2 v; v.x = pg8::cvt_pk_bf16(o[c][4 * g] * sc, o[c][4 * g + 1] * sc); v.y = pg8::cvt_pk_bf16(o[c][4 * g + 2] * sc, o[c][4 * g + 3] * sc);
                *(u32x2*)(orow + 32 * c + 8 * g + 4 * w.hi) = v;
            }
    }
    __syncthreads();
}
__device__ void phase_diff_mfma(const Params& p, unsigned char* lds, int L) {
    const int lane = opaque_tid() & 63;
    const float lam_init = 0.8f - 0.6f * expf(-0.3f * (float)L);
    const float a = p.in[17][L * 64 + lane] * p.in[18][L * 64 + lane];
    const float c = p.in[19][L * 64 + lane] * p.in[20][L * 64 + lane];
    const float lam = expf(wave_sum(a, lane)) - expf(wave_sum(c, lane)) + lam_init;
    for (int unit = blockIdx.x; unit < NB * 4 * 16; unit += gridDim.x) diff_unit(p, lds, unit, lam, lam_init, nullptr, nullptr);
}

template <int NKS>
__device__ __forceinline__ void tile_decay(att::ldscp Kt, att::ldscp Vt, const att::WaveCtx& w, const bf16x8 (&qf)[NKS], att::f32x16 (&o)[4], float log2g, int dq, bool need_mask) {
    att::f32x16 p0, p1;
    att::qk<NKS>(Kt, w, qf, p0, p1);
    const float fA = att::ex2(log2g * (float)(dq - 4 * w.hi));
    const float a1 = att::ex2(-log2g), a2 = a1 * a1, a3 = a2 * a1, b1 = att::ex2(-8.f * log2g), b2 = b1 * b1, b3 = b2 * b1, c32 = att::ex2(-32.f * log2g);
#pragma unroll
    for (int r = 0; r < 16; ++r) {
        const int d0 = dq - att::crow(r, w.hi), d1 = d0 - 32;
        const float fb = (r >> 2) == 0 ? fA : ((r >> 2) == 1 ? fA * b1 : ((r >> 2) == 2 ? fA * b2 : fA * b3));
        const float f0 = (r & 3) == 0 ? fb : ((r & 3) == 1 ? fb * a1 : ((r & 3) == 2 ? fb * a2 : fb * a3)), f1 = f0 * c32;
        p0[r] = (need_mask && d0 < 0) ? 0.f : p0[r] * f0;
        p1[r] = (need_mask && d1 < 0) ? 0.f : p1[r] * f1;
    }
    bf16x8 pf[2][2];
    att::pack_p(p0, p1, pf);
    att::pv(Vt, w, pf, o);
}
__device__ __forceinline__ void ret_unit(const Params& p, unsigned char* lds, int unit, unsigned* qctr, volatile int* nslot) {
    const int tid = opaque_tid(), lane = tid & 63, wave = __builtin_amdgcn_readfirstlane(tid >> 6);
    const int qb = 7 - (unit & 7), bh = unit >> 3, h = bh & 3, b = bh >> 2;
    const int q0 = qb * 256 + wave * 32;
    att::WaveCtx w; att::ctx_init(w, lane, 0);
    const int tq = q0 + w.r32;
    const bf16_t* base = (const bf16_t*)(p.ws + WS_PROJ) + (size_t)b * SEQ * PP;
    bf16x8 qf[8];
#pragma unroll
    for (int ks = 0; ks < 8; ++ks) qf[ks] = *(const bf16x8*)(base + (size_t)tq * PP + C_RQ + h * 128 + 16 * ks + 8 * w.hi);
    att::f32x16 o[4];
#pragma unroll
    for (int c = 0; c < 4; ++c)
#pragma unroll
        for (int r = 0; r < 16; ++r) o[c][r] = 0.f;
    const float log2g = log2f(1.0f - exp2f(-5.0f - (float)h));
    const bf16_t* Kg = base + C_RK + h * 128; const bf16_t* Vg = base + C_RV + h * 128;
    const int nt = 4 * qb + 4;
    att::ldsp L3 = (att::ldsp)lds;
    ATT_DMA_WAIT();
#pragma unroll
    for (int ks = 0; ks < 8; ++ks) asm volatile("" : "+v"(qf[ks]));
    int issued = 0;
    for (; issued < nt && issued < att::NRING - 1; ++issued) att::stage_dma(Kg, PP, Vg, PP, issued * 64, SEQ - 1, L3 + issued * att::BUFB, tid);
    for (int kt = 0; kt < nt; ++kt) {
        att::ring_wait(issued - 1 - kt);
        __syncthreads();
        if (issued < nt) { att::stage_dma(Kg, PP, Vg, PP, issued * 64, SEQ - 1, L3 + (issued & (att::NRING - 1)) * att::BUFB, tid); ++issued; }
        const int cur = kt & (att::NRING - 1);
        const int key0 = kt * 64;
        if (key0 <= q0 + 31)
            tile_decay<8>((att::ldscp)(L3 + cur * att::BUFB), (att::ldscp)(L3 + cur * att::BUFB + att::TILE), w, qf, o, log2g, tq - key0, key0 + 63 > q0);
    }
    __syncthreads();
    if (tid == 0) *nslot = (int)atomicAdd(qctr, 1u);
    float s1 = 0.f;
#pragma unroll
    for (int c = 0; c < 4; ++c)
#pragma unroll
        for (int r = 0; r < 16; ++r) s1 += o[c][r];
    s1 = half_sum(s1);
    const float mu = s1 * (1.f / 128.f);
    float s2 = 0.f;
#pragma unroll
    for (int c = 0; c < 4; ++c)
#pragma unroll
        for (int r = 0; r < 16; ++r) { const float d = o[c][r] - mu; o[c][r] = d; s2 += d * d; }
    s2 = half_sum(s2);
    const float rs = rsqrtf(s2 * (1.f / 128.f) + EPS);
    const size_t mrow = (size_t)b * SEQ + tq;
    const bf16_t* grow = (const bf16_t*)(p.ws + WS_PROJ) + mrow * PP + C_RG + h * 128;
    bf16_t* orow = (bf16_t*)(p.ws + WS_MIXED) + mrow * DM + 512 + h * 128;
#pragma unroll
    for (int c = 0; c < 4; ++c)
#pragma unroll
        for (int g = 0; g < 4; ++g) {
            const int e0 = 32 * c + 8 * g + 4 * w.hi;
            const u32x2 gv = *(const u32x2*)(grow + e0);
            const float g0 = __uint_as_float(gv.x << 16), g1 = __uint_as_float(gv.x & 0xffff0000u), g2 = __uint_as_float(gv.y << 16), g3 = __uint_as_float(gv.y & 0xffff0000u);
            u32x2 v;
            v.x = pg8::cvt_pk_bf16(g0 * __builtin_amdgcn_rcpf(1.f + __expf(-g0)) * o[c][4 * g] * rs, g1 * __builtin_amdgcn_rcpf(1.f + __expf(-g1)) * o[c][4 * g + 1] * rs);
            v.y = pg8::cvt_pk_bf16(g2 * __builtin_amdgcn_rcpf(1.f + __expf(-g2)) * o[c][4 * g + 2] * rs, g3 * __builtin_amdgcn_rcpf(1.f + __expf(-g3)) * o[c][4 * g + 3] * rs);
            *(u32x2*)(orow + e0) = v;
        }
    __syncthreads();
}
__device__ void phase_ret_mfma(const Params& p, unsigned char* lds) {
    for (int unit = (blockIdx.x + gridDim.x / 2) % gridDim.x; unit < NB * 4 * 8; unit += gridDim.x) ret_unit(p, lds, unit, nullptr, nullptr);
}

__device__ __forceinline__ void nsa_unit(const Params& p, unsigned char* lds, int unit, unsigned* qctr, volatile int* nslot) {
    const int tid = opaque_tid(), lane = tid & 63, wave = __builtin_amdgcn_readfirstlane(tid >> 6);
    const int tb = 31 - (unit & 31), b = unit >> 5;
    const int head = wave >> 1, thalf = wave & 1, t0w = tb * 64 + thalf * 32;
    att::WaveCtx w; att::ctx_init(w, lane, 0);
    const int tq = t0w + w.r32, tloc = thalf * 32 + w.r32;
    const bf16_t* base = (const bf16_t*)(p.ws + WS_PROJ) + (size_t)b * SEQ * PP;
    bf16x8 qf[8];
#pragma unroll
    for (int ks = 0; ks < 8; ++ks) qf[ks] = *(const bf16x8*)(base + (size_t)tq * PP + C_NQ + head * 128 + 16 * ks + 8 * w.hi);
    const bf16_t* gatep = base + (size_t)tq * PP + C_GATE + head * 3;
    const bf16_t graw0 = gatep[0], graw1 = gatep[1], graw2 = gatep[2];
#define NSA_GATE(br) (1.f / (1.f + __expf(-bf2f((br) == 0 ? graw0 : ((br) == 1 ? graw1 : graw2)))))
    const float csc = 0.08838834764831845f * 1.4426950408889634f;
    float* impQ = (float*)(lds + 65536);
    float* impE = (float*)(lds + 65536 + 32768);
    float* scb = (float*)lds;
    unsigned* selm = (unsigned*)(lds + 8704);
    att::ldsp L3 = (att::ldsp)lds;
    att::f32x16 o[4];
#pragma unroll
    for (int c = 0; c < 4; ++c)
#pragma unroll
        for (int r = 0; r < 16; ++r) o[c][r] = 0.f;
    {
        const bf16_t* Kc = (const bf16_t*)(p.ws + WS_KVCMPB) + (size_t)b * 128 * 128; const bf16_t* Vc = Kc + 4 * 128 * 128;
        att::stage_dma(Kc, 128, Vc, 128, 0, 127, L3, tid);
        att::stage_dma(Kc, 128, Vc, 128, 64, 127, L3 + att::BUFB, tid);
        ATT_DMA_WAIT();
        __syncthreads();
        const int jmax = tq >= 31 ? ((tq - 31) >> 4) : -1;
        att::f32x16 pa0, pa1, pb0, pb1;
        att::qk<8>((att::ldscp)L3, w, qf, pa0, pa1);
        att::apply_bounds(pa0, pa1, 0, jmax, w.hi);
        att::qk<8>((att::ldscp)(L3 + att::BUFB), w, qf, pb0, pb1);
        att::apply_bounds(pb0, pb1, 0, jmax - 64, w.hi);
        float mx = fmaxf(fmaxf(pa0[0], pa1[0]), fmaxf(pb0[0], pb1[0]));
#pragma unroll
        for (int r = 1; r < 16; ++r) mx = fmaxf(mx, fmaxf(fmaxf(pa0[r], pa1[r]), fmaxf(pb0[r], pb1[r])));
        mx = half_max(mx);
        const float m = fmaxf(att::NEG, mx * csc);
        float ls = 0.f;
#pragma unroll
        for (int r = 0; r < 16; ++r) {
            pa0[r] = att::ex2(fmaf(pa0[r], csc, -m)); pa1[r] = att::ex2(fmaf(pa1[r], csc, -m));
            pb0[r] = att::ex2(fmaf(pb0[r], csc, -m)); pb1[r] = att::ex2(fmaf(pb1[r], csc, -m));
            ls += (pa0[r] + pa1[r]) + (pb0[r] + pb1[r]);
        }
        const float l = half_sum(ls);
        const float inv = (jmax >= 0) ? 1.f / l : 0.f;
#define NSA_CMP_TILE(P0, P1, kt) do { \
            _Pragma("unroll") for (int r = 0; r < 16; ++r) { P0[r] *= inv; P1[r] *= inv; } \
            _Pragma("unroll") for (int g = 0; g < 4; ++g) {     \
                const int ia = ((head * 32 + 16 * (kt) + 2 * g + w.hi) * 64) + tloc, ib = ia + 8 * 64; \
                impQ[ia] = (P0[4 * g] + P0[4 * g + 1]) + (P0[4 * g + 2] + P0[4 * g + 3]); impE[ia] = P0[4 * g + 3]; \
                impQ[ib] = (P1[4 * g] + P1[4 * g + 1]) + (P1[4 * g + 2] + P1[4 * g + 3]); impE[ib] = P1[4 * g + 3]; \
            } \
            bf16x8 pf[2][2]; \
            att::pack_p(P0, P1, pf); \
            att::pv((att::ldscp)(L3 + (kt) * att::BUFB + att::TILE), w, pf, o); } while (0)
        NSA_CMP_TILE(pa0, pa1, 0);
        NSA_CMP_TILE(pb0, pb1, 1);
#undef NSA_CMP_TILE
    }
    __syncthreads();
    unsigned mymask, tmask;
    {
        const int token = tid >> 3, js0 = (tid & 7) * 4;
        if (tid < 65) selm[tid] = 0u;
#pragma unroll
        for (int i = 0; i < 4; ++i) {
            const int js = js0 + i;
            float s = 0.f;
#pragma unroll
            for (int h = 0; h < 4; ++h) { s += impQ[(h * 32 + js) * 64 + token]; if (js > 0) s += impE[(h * 32 + js - 1) * 64 + token]; }
            const bool valid = js <= tb, forced = (js == 0) || (js == tb) || (js == tb - 1);
            scb[token * 33 + js] = valid ? s + (forced ? 1e4f : 0.f) : -1e30f;
        }
        __syncthreads();
        unsigned mine = 0u;
        {
            float sj[32];
#pragma unroll
            for (int jj = 0; jj < 32; ++jj) sj[jj] = scb[token * 33 + jj];
#pragma unroll
            for (int i = 0; i < 4; ++i) {
                const int js = js0 + i;
                const float my = scb[token * 33 + js];
                int rank = 0;
#pragma unroll
                for (int jj = 0; jj < 32; ++jj) rank += (sj[jj] > my || (sj[jj] == my && jj < js)) ? 1 : 0;
                if (js <= tb && rank < 8) mine |= 1u << js;
            }
        }
        {
            const int ln_ = tid & 63;
#define NSA_ORX(v, o) v |= (unsigned)__builtin_amdgcn_ds_bpermute((ln_ ^ (o)) << 2, (int)(v))
            NSA_ORX(mine, 1); NSA_ORX(mine, 2); NSA_ORX(mine, 4);
            unsigned wor = mine;
            NSA_ORX(wor, 8); NSA_ORX(wor, 16); NSA_ORX(wor, 32);
#undef NSA_ORX
            if ((tid & 7) == 0) selm[token] = mine;
            if (ln_ == 0 && wor) atomicOr(&selm[64], wor);
        }
        __syncthreads();
        mymask = selm[tloc]; tmask = selm[64];
        __syncthreads();
    }
    bf16_t* orow = (bf16_t*)(p.ws + WS_MIXED) + ((size_t)b * SEQ + tq) * DM + 1024 + head * 128 + 4 * w.hi;
    {
        const float g0 = NSA_GATE(0);
#pragma unroll
        for (int c = 0; c < 4; ++c)
#pragma unroll
            for (int g = 0; g < 4; ++g) {
                u32x2 v; v.x = pg8::cvt_pk_bf16(g0 * o[c][4 * g], g0 * o[c][4 * g + 1]); v.y = pg8::cvt_pk_bf16(g0 * o[c][4 * g + 2], g0 * o[c][4 * g + 3]);
                *(u32x2*)(orow + 32 * c + 8 * g) = v;
                o[c][4 * g] = 0.f; o[c][4 * g + 1] = 0.f; o[c][4 * g + 2] = 0.f; o[c][4 * g + 3] = 0.f;
            }
    }
#define NSA_ACCUM(f) do { u32x2 uu_[16];     \
        _Pragma("unroll") for (int i_ = 0; i_ < 16; ++i_) uu_[i_] = *(const u32x2*)(orow + 32 * (i_ >> 2) + 8 * (i_ & 3)); \
        _Pragma("unroll") for (int c = 0; c < 4; ++c) _Pragma("unroll") for (int g = 0; g < 4; ++g) { \
        const u32x2 u = uu_[4 * c + g]; u32x2 v; \
        v.x = pg8::cvt_pk_bf16(__uint_as_float(u.x << 16) + (f) * o[c][4 * g], __uint_as_float(u.x & 0xffff0000u) + (f) * o[c][4 * g + 1]); \
        v.y = pg8::cvt_pk_bf16(__uint_as_float(u.y << 16) + (f) * o[c][4 * g + 2], __uint_as_float(u.y & 0xffff0000u) + (f) * o[c][4 * g + 3]); \
        *(u32x2*)(orow + 32 * c + 8 * g) = v; \
        o[c][4 * g] = 0.f; o[c][4 * g + 1] = 0.f; o[c][4 * g + 2] = 0.f; o[c][4 * g + 3] = 0.f; } } while (0)
    {
        const bf16_t* Kg = base + C_NKS; const bf16_t* Vg = base + C_NVS;
        float m = att::NEG, l = 0.f;
        const unsigned tm = (unsigned)__builtin_amdgcn_readfirstlane((int)tmask);
        const int nt = __builtin_popcount(tm);
        unsigned mi = tm, mc = tm;
        ATT_DMA_WAIT();
#pragma unroll
        for (int ks = 0; ks < 8; ++ks) asm volatile("" : "+v"(qf[ks]));
        int issued = 0;
        for (; issued < nt && issued < att::NRING; ++issued) { const int j = __builtin_ctz(mi); mi &= mi - 1; att::stage_dma(Kg, PP, Vg, PP, j * 64, SEQ - 1, L3 + issued * att::BUFB, tid); }
        for (int i = 0; i < nt; i += 2) {
            const int last = (i + 1 < nt) ? i + 1 : i;
            att::ring_wait(issued - 1 - last);
            __syncthreads();
            if (i >= 2) {
#pragma unroll 1
                for (int r = 0; r < 2 && issued < nt; ++r) { const int j = __builtin_ctz(mi); mi &= mi - 1; att::stage_dma(Kg, PP, Vg, PP, j * 64, SEQ - 1, L3 + (issued & (att::NRING - 1)) * att::BUFB, tid); ++issued; }
            }
#pragma unroll 1
            for (int t = i; t <= last; ++t) {
                const int cur = t & (att::NRING - 1);
                const int curj = __builtin_ctz(mc); mc &= mc - 1;
                const bool allowed = (mymask >> curj) & 1u;
                if (__any(allowed))
                    att::tile_softmax<8>((att::ldscp)(L3 + cur * att::BUFB), (att::ldscp)(L3 + cur * att::BUFB + att::TILE), w, qf, o, m, l, csc, curj == tb, 0, allowed ? tq - curj * 64 : -1, (curj != tb) && __any(!allowed), allowed);
            }
        }
        __syncthreads();
        l = half_sum(l);
        const float f = NSA_GATE(1) / l;
        NSA_ACCUM(f);
    }
    {
        const bf16_t* Kg = base + C_NKW; const bf16_t* Vg = base + C_NVW;
        float m = att::NEG, l = 0.f;
        const int kt0 = tb >= 4 ? tb - 4 : 0, nt = tb - kt0 + 1;
        ATT_DMA_WAIT();
        int issued = 0;
        for (; issued < nt && issued < att::NRING; ++issued) att::stage_dma(Kg, PP, Vg, PP, (kt0 + issued) * 64, SEQ - 1, L3 + issued * att::BUFB, tid);
        for (int i = 0; i < nt; i += 2) {
            const int last = (i + 1 < nt) ? i + 1 : i;
            att::ring_wait(issued - 1 - last);
            __syncthreads();
            if (i >= 2) {
#pragma unroll 1
                for (int r = 0; r < 2 && issued < nt; ++r) { att::stage_dma(Kg, PP, Vg, PP, (kt0 + issued) * 64, SEQ - 1, L3 + (issued & (att::NRING - 1)) * att::BUFB, tid); ++issued; }
            }
#pragma unroll 1
            for (int t = i; t <= last; ++t) {
                const int kt = kt0 + t, cur = t & (att::NRING - 1);
                const int key0 = kt * 64;
                att::tile_softmax<8>((att::ldscp)(L3 + cur * att::BUFB), (att::ldscp)(L3 + cur * att::BUFB + att::TILE), w, qf, o, m, l, csc, (kt == tb) || (kt == tb - 4), tq - 255 - key0, tq - key0);
            }
        }
        if (tid == 0) *nslot = (int)atomicAdd(qctr, 1u);
        l = half_sum(l);
        const float f = NSA_GATE(2) / l;
        NSA_ACCUM(f);
    }
    __syncthreads();
#undef NSA_ACCUM
#undef NSA_GATE
}
__device__ void phase_nsa_mfma(const Params& p, unsigned char* lds) {
    for (int unit = blockIdx.x; unit < NB * 32; unit += gridDim.x) nsa_unit(p, lds, unit, nullptr, nullptr);
}

__device__ void phase_cmp_mfma(const Params& p, unsigned char* lds, int L) {
    const int tid = opaque_tid(), lane = tid & 63, wave = __builtin_amdgcn_readfirstlane(tid >> 6);
    const int r32 = lane & 31, hi = lane >> 5;
    const bf16_t* proj = (const bf16_t*)(p.ws + WS_PROJ);
    const float2* r128 = (const float2*)(p.ws + WS_ROPE128);
    float* part = (float*)lds;
    float* slabs = (float*)(p.ws + WS_KPART);
    unsigned* cnt = (unsigned*)(p.ws + WS_CMPCNT) + L * 32;
    volatile int* slot = (volatile int*)(lds + 131072 + 56);
    for (int item = (blockIdx.x + gridDim.x / 2) % gridDim.x; item < NB * 2 * 4 * 4; item += gridDim.x) {
        const int lq = item & 3, jb = (item >> 2) & 3, kv = (item >> 4) & 1, b = item >> 5;
        const bf16_t* Wt = (const bf16_t*)(p.ws + WS_WCMP) + ((size_t)(L * 2 + kv)) * 128 * 4096;
        const float* pe = p.in[kv ? 14 : 13] + (size_t)L * 32 * 128;
        const int col = kv ? C_NVC : C_NKC;
        int j = jb * 32 + r32; if (j > 126) j = 126;
        att::f32x16 acc[4];
#pragma unroll
        for (int nb = 0; nb < 4; ++nb)
#pragma unroll
            for (int r = 0; r < 16; ++r) acc[nb][r] = 0.f;
        {
            const int l = lq * 8 + wave;
            const size_t m = (size_t)b * SEQ + 16 * j + l;
            const bf16_t* xrow = proj + m * PP + col;
#pragma unroll 4
            for (int ks = 0; ks < 8; ++ks) {
                const int d0 = 16 * ks + 8 * hi;
                const bf16x8 xv = *(const bf16x8*)(xrow + d0);
                float xf[8];
#pragma unroll
                for (int e = 0; e < 8; ++e) xf[e] = bf2f((bf16_t)xv[e]);
                if (!kv) {
                    const bf16x8 xp = *(const bf16x8*)(xrow + (d0 ^ 64));
                    const f32x4* cs4 = (const f32x4*)(r128 + m * 64 + (d0 & 63));
#pragma unroll
                    for (int e2 = 0; e2 < 4; ++e2) {
                        const f32x4 t = cs4[e2];
                        const float o0 = bf2f((bf16_t)xp[2 * e2]), o1 = bf2f((bf16_t)xp[2 * e2 + 1]);
                        xf[2 * e2] = (d0 < 64) ? xf[2 * e2] * t.x - o0 * t.y : xf[2 * e2] * t.x + o0 * t.y;
                        xf[2 * e2 + 1] = (d0 < 64) ? xf[2 * e2 + 1] * t.z - o1 * t.w : xf[2 * e2 + 1] * t.z + o1 * t.w;
                    }
                }
                const f32x4 pe0 = *(const f32x4*)(pe + l * 128 + d0), pe1 = *(const f32x4*)(pe + l * 128 + d0 + 4);
                u32x4 xa;
                xa.x = pg8::cvt_pk_bf16(xf[0] + pe0.x, xf[1] + pe0.y); xa.y = pg8::cvt_pk_bf16(xf[2] + pe0.z, xf[3] + pe0.w);
                xa.z = pg8::cvt_pk_bf16(xf[4] + pe1.x, xf[5] + pe1.y); xa.w = pg8::cvt_pk_bf16(xf[6] + pe1.z, xf[7] + pe1.w);
                const bf16x8 xfr = __builtin_bit_cast(bf16x8, xa);
#pragma unroll
                for (int nb = 0; nb < 4; ++nb) {
                    const bf16x8 wf = *(const bf16x8*)(Wt + (size_t)(nb * 32 + r32) * 4096 + l * 128 + d0);
                    acc[nb] = __builtin_amdgcn_mfma_f32_32x32x16_bf16(wf, xfr, acc[nb], 0, 0, 0);
                }
            }
        }
        __syncthreads();
#pragma unroll
        for (int nb = 0; nb < 4; ++nb)
#pragma unroll
            for (int r = 0; r < 16; ++r) part[(wave * 128 + nb * 32 + att::crow(r, hi)) * 32 + r32] = acc[nb][r];
        __syncthreads();
        const int jj = tid & 31, ng = tid >> 5;
        const int jrow = jb * 32 + jj;
        float v[8];
#pragma unroll
        for (int i = 0; i < 8; ++i) {
            float s = 0.f;
#pragma unroll
            for (int w8 = 0; w8 < 8; ++w8) s += part[(w8 * 128 + ng * 8 + i) * 32 + jj];
            v[i] = s;
        }
        {
            float* my = slabs + ((size_t)((lq * 2 + kv) * 4 + b) * 128 + jrow) * 128 + ng * 8;
            *(f32x4*)my = (f32x4){v[0], v[1], v[2], v[3]}; *(f32x4*)(my + 4) = (f32x4){v[4], v[5], v[6], v[7]};
        }
        asm volatile("s_waitcnt vmcnt(0)" ::: "memory");
        __syncthreads();
        if (tid == 0) {
            __builtin_amdgcn_fence(__ATOMIC_RELEASE, "agent");
            asm volatile("s_waitcnt vmcnt(0)" ::: "memory");
            *slot = (int)__hip_atomic_fetch_add(cnt + (item >> 2), 1u, __ATOMIC_RELAXED, __HIP_MEMORY_SCOPE_AGENT);
        }
        __syncthreads();
        const int ticket = *slot;
        if (ticket == 3) {
            if (tid == 0) { __builtin_amdgcn_fence(__ATOMIC_ACQUIRE, "agent"); asm volatile("s_waitcnt vmcnt(0)" ::: "memory"); }
            __syncthreads();
            float ss = 0.f;
#pragma unroll
            for (int i = 0; i < 8; ++i) v[i] = 0.f;
#pragma unroll
            for (int q4 = 0; q4 < 4; ++q4) {
                const float* sp = slabs + ((size_t)((q4 * 2 + kv) * 4 + b) * 128 + jrow) * 128 + ng * 8;
                const f32x4 a0 = *(const f32x4*)sp, a1 = *(const f32x4*)(sp + 4);
                v[0] += a0.x; v[1] += a0.y; v[2] += a0.z; v[3] += a0.w; v[4] += a1.x; v[5] += a1.y; v[6] += a1.z; v[7] += a1.w;
            }
#pragma unroll
            for (int i = 0; i < 8; ++i) ss += v[i] * v[i];
            float sc = 1.f;
            if (!kv) {
                part[ng * 32 + jj] = ss;
                __syncthreads();
                float tot = 0.f;
#pragma unroll
                for (int g2 = 0; g2 < 16; ++g2) tot += part[g2 * 32 + jj];
                sc = rsqrtf(tot * (1.f / 128.f) + EPS);
            }
            if (jrow > 126) sc = 0.f;
            u32x4 ov;
            ov.x = pg8::cvt_pk_bf16(v[0] * sc, v[1] * sc); ov.y = pg8::cvt_pk_bf16(v[2] * sc, v[3] * sc); ov.z = pg8::cvt_pk_bf16(v[4] * sc, v[5] * sc); ov.w = pg8::cvt_pk_bf16(v[6] * sc, v[7] * sc);
            *(u32x4*)((bf16_t*)(p.ws + WS_KVCMPB) + (size_t)kv * 4 * 128 * 128 + ((size_t)b * 128 + jrow) * 128 + ng * 8) = ov;
        }
        __syncthreads();
    }
    __syncthreads();
}

__device__ __forceinline__ float gelu_tanh(float x) {
    const float u = 0.7978845608028654f * (x + 0.044715f * x * x * x);
    const float e = __expf(2.f * u);
    const float th = 1.f - 2.f / (e + 1.f);
    return 0.5f * x * (1.f + th);
}
__device__ void phase_s5v2(const Params& p, unsigned char* lds, int L) {
    const int tid = opaque_tid(), lane = tid & 63, wave = __builtin_amdgcn_readfirstlane(tid >> 6);
    const int r32 = lane & 31, hi = lane >> 5, l15 = lane & 15, q4 = lane >> 4;
    float* bub = (float*)lds;
    unsigned char* s16 = lds + 65536;
    float2* xch = (float2*)(lds + 65536 + 2 * 17408);
    const bf16_t* proj = (const bf16_t*)(p.ws + WS_PROJ);
    bf16_t* s5y = (bf16_t*)(p.ws + WS_S5Y);
    const unsigned char* pre = p.ws + WS_S5PRE + L * S5PRE_LAYER;
    const float2* lbp = (const float2*)pre;
    const bf16_t* bb16 = (const bf16_t*)(pre + 16384);
    const bf16_t* cm16 = (const bf16_t*)(pre + 16384 + 131072);
    typedef float f32x2 __attribute__((ext_vector_type(2)));
#define S5_CMA(A_, X_, Y_) (((f32x2){-(A_).y, (A_).y}) * ((f32x2){(X_).y, (X_).x}) + (((f32x2){(A_).x, (A_).x}) * (X_) + (Y_)))
    for (int it = blockIdx.x; it < NB * 32; it += gridDim.x) {
        const int b = it >> 5, g = it & 31;
        const size_t m0 = (size_t)b * SEQ;
        f32x2 lam[8];
        { const float2 lb = lbp[g * 64 + lane]; lam[0] = (f32x2){lb.x, lb.y};
#pragma unroll
          for (int k = 1; k < 8; ++k) lam[k] = (f32x2){lam[k - 1].x * lam[0].x - lam[k - 1].y * lam[0].y, lam[k - 1].x * lam[0].y + lam[k - 1].y * lam[0].x}; }
        f32x2 S = (f32x2){0.f, 0.f};
        const int a_tb = wave & 1, a_pb = wave >> 1;
        const bf16x8 bfa = *(const bf16x8*)(bb16 + ((size_t)(g * 128 + 32 * a_pb + r32)) * 16 + 8 * hi);
        bf16x8 cm[4]; float dsk = 0.f;
        if (wave < 4) {
#pragma unroll
            for (int ks = 0; ks < 4; ++ks) cm[ks] = *(const bf16x8*)(cm16 + ((size_t)(g * 16 + l15)) * 128 + 32 * ks + 8 * q4);
            dsk = p.in[11][((size_t)L * 32 + g) * 16 + l15];
        }
        const bf16_t* urow = proj + (m0 + 32 * a_tb + r32) * PP + C_U + g * 16 + 8 * hi;
        const bf16_t* yrow = proj + (m0 + 16 * wave + 4 * q4) * PP + C_U + g * 16 + l15;
        bf16x8 af0 = *(const bf16x8*)(urow), af1 = *(const bf16x8*)(urow + (size_t)64 * PP);
        bf16_t uy0[4], uy1[4];
#pragma unroll
        for (int r = 0; r < 4; ++r) { uy0[r] = 0; uy1[r] = 0; }
        if (wave < 4) {
#pragma unroll
            for (int r = 0; r < 4; ++r) { uy0[r] = yrow[(size_t)r * PP]; uy1[r] = yrow[(size_t)(64 + r) * PP]; }
        }
        __syncthreads();
        f32x2 ccA[8], ccB[8];
#pragma unroll
        for (int k = 0; k < 8; ++k) { ccA[k] = (f32x2){0.f, 0.f}; ccB[k] = (f32x2){0.f, 0.f}; }
#pragma unroll 1
        for (int i = -1; i <= SEQ / 64 + 1; ++i) {
            if (i + 1 < SEQ / 64) {
                const int c1 = i + 1;
                float* bw = bub + (c1 & 1) * 8192;
                att::f32x16 d;
#pragma unroll
                for (int r = 0; r < 16; ++r) d[r] = 0.f;
                d = __builtin_amdgcn_mfma_f32_32x32x16_bf16(af0, bfa, d, 0, 0, 0);
#pragma unroll
                for (int r = 0; r < 16; ++r) bw[(32 * a_tb + att::crow(r, hi)) * 128 + 32 * a_pb + r32] = d[r];
                af0 = af1;
                if (c1 + 2 < SEQ / 64) af1 = *(const bf16x8*)(urow + (size_t)(64 * (c1 + 2)) * PP);
            }
#pragma unroll
            for (int k = 0; k < 8; ++k) ccB[k] = ccA[k];
            if (i >= 0 && i < SEQ / 64) {
                const f32x2* bc = (const f32x2*)(bub + (i & 1) * 8192) + (8 * wave) * 64 + lane;
                f32x2 bu[8];
#pragma unroll
                for (int k = 0; k < 8; ++k) bu[k] = bc[k * 64];
                ccA[0] = bu[0];
#pragma unroll
                for (int k = 1; k < 8; ++k) ccA[k] = S5_CMA(lam[0], ccA[k - 1], bu[k]);
                xch[((i & 1) * 8 + wave) * 64 + lane] = make_float2(ccA[7].x, ccA[7].y);
            }
            if (i >= 1 && i <= SEQ / 64) {
                const int c = i - 1;
                f32x2 Sin = S;
#pragma unroll
                for (int j = 0; j < 8; ++j) {
                    const float2 t = xch[((c & 1) * 8 + j) * 64 + lane];
                    if (j == wave) Sin = S;
                    S = S5_CMA(lam[7], S, ((f32x2){t.x, t.y}));
                }
                unsigned* sc = (unsigned*)(s16 + (c & 1) * 17408) + (8 * wave) * 68 + lane;
#pragma unroll
                for (int k = 0; k < 8; ++k) { const f32x2 s = S5_CMA(lam[k], Sin, ccB[k]); sc[k * 68] = pg8::cvt_pk_bf16(s.x, s.y); }
            }
            if (i >= 2 && wave < 4) {
                const int c0 = i - 2;
                const unsigned char* sb = s16 + (c0 & 1) * 17408;
                f32x4 acc = (f32x4){0.f, 0.f, 0.f, 0.f};
#pragma unroll
                for (int ks = 0; ks < 4; ++ks) {
                    const bf16x8 af = *(const bf16x8*)(sb + (16 * wave + l15) * 272 + 64 * ks + 16 * q4);
                    acc = __builtin_amdgcn_mfma_f32_16x16x32_bf16(af, cm[ks], acc, 0, 0, 0);
                }
#pragma unroll
                for (int r = 0; r < 4; ++r) {
                    const size_t m = m0 + 64 * c0 + 16 * wave + 4 * q4 + r;
                    s5y[m * 512 + g * 16 + l15] = (bf16_t)f2bf(gelu_tanh(acc[r] + dsk * bf2f(uy0[r])));
                }
#pragma unroll
                for (int r = 0; r < 4; ++r) { uy0[r] = uy1[r]; if (c0 + 2 < SEQ / 64) uy1[r] = yrow[(size_t)(64 * (c0 + 2) + r) * PP]; }
            }
            __syncthreads();
        }
    }
#undef S5_CMA
}

struct OneUnit {
    pg8::Unit u;
    __device__ __forceinline__ bool next(int i, pg8::Unit& o) const { if (i) return false; o = u; return true; }
    __device__ __forceinline__ void a_ready(const pg8::Unit&) const {}
    __device__ __forceinline__ void done(const pg8::Unit&) const {}
};
constexpr int P3_NSA = NB * 32, P3_DIFF = NB * 4 * 16, P3_RET = NB * 4 * 8, P3_GLU = (MTOK / 256) * 2, P3_ITEMS = P3_NSA + P3_DIFF + P3_RET + P3_GLU;
__host__ __device__ inline int p3_key(int e) {
    int c;
    if (e < P3_NSA) c = 4 * ((31 - (e & 31)) + 9);
    else if (e < P3_NSA + P3_DIFF) c = 3 * (2 * (15 - ((e - P3_NSA) & 15)) + 2);
    else if (e < P3_NSA + P3_DIFF + P3_RET) c = 4 * (4 * (7 - ((e - P3_NSA - P3_DIFF) & 7)) + 4);
    else c = 25;
    return c * 1024 + e;
}
__device__ void phase_p3(const Params& p, unsigned char* lds, int L) {
    const int tid = opaque_tid(), lane = tid & 63;
    unsigned short* order = (unsigned short*)(lds + 131072 + 64);
    volatile int* slot = (volatile int*)(lds + 131072 + 48);
    static_assert(P3_ITEMS == 576, "order table size");
    const float* lamw = (const float*)(p.ws + WS_LAM) + 2 * L;
    unsigned* qctr = (unsigned*)(p.ws + WS_QUEUE) + L * 64;
    if (tid == 0) slot[0] = (int)atomicAdd(qctr, 1u);
    __syncthreads();
    int q = slot[0];
    for (int n = 0; q < P3_ITEMS; ++n) {
        const int e = order[q];
        volatile int* nslot = slot + ((n + 1) & 1);
        if (e < P3_NSA) nsa_unit(p, lds, e, qctr, nslot);
        else if (e < P3_NSA + P3_DIFF) diff_unit(p, lds, e - P3_NSA, lamw[0], lamw[1], qctr, nslot);
        else if (e < P3_NSA + P3_DIFF + P3_RET) ret_unit(p, lds, e - P3_NSA - P3_DIFF, qctr, nslot);
        else {
            if (tid == 0) *nslot = (int)atomicAdd(qctr, 1u);
            const int g = e - P3_NSA - P3_DIFF - P3_RET;
            pg8::Gemm gm{(const bf16_t*)(p.ws + WS_S5Y), (const bf16_t*)(p.ws + WS_WGLU + (size_t)L * 512 * 512 * 2), MTOK, 512, 512};
            OneUnit S{pg8::Unit{g >> 1, g & 1}};
            EpiGlu E{(const bf16_t*)(p.ws + WS_S5Y), (bf16_t*)(p.ws + WS_MIXED)};
            pg8::gemm_phase<EpiGlu, OneUnit, true, true>((PG8_LAS unsigned char*)lds, gm, S, E);
        }
        __syncthreads();
        q = *nslot;
    }
    __syncthreads();
    conv_fill(p, lds, L);
}

#define LAS __attribute__((address_space(3)))
#define XB_TMO      128
#define XB_XCNT(j)  (256  + 64 * (j))
#define XB_XSUB(j)  (1280 + 64 * (j))
#define XB_XGEN(j)  (2304 + 64 * (j))
#define XB_TOP      3328
#define XB_TOPGEN   3392
#define XCD_BAR_WORDS 3456
#define XB_SPIN_CAP (1u << 18)

__device__ __forceinline__ unsigned xb_ld(unsigned* p)              { return __hip_atomic_load(p, __ATOMIC_RELAXED, __HIP_MEMORY_SCOPE_AGENT); }
__device__ __forceinline__ unsigned xb_add(unsigned* p, unsigned v) { return __hip_atomic_fetch_add(p, v, __ATOMIC_RELAXED, __HIP_MEMORY_SCOPE_AGENT); }
__device__ __forceinline__ unsigned xb_xcc_id() { return (unsigned)__builtin_amdgcn_s_getreg((3 << 11) | 20) & 0xFu; }
#define XB_SPIN(cond, bar) do { unsigned _sp = 0; while (cond) { __builtin_amdgcn_s_sleep(1); \
    if ((++_sp & 255u) == 0u) { if (xb_ld(&(bar)[XB_TMO])) break; if (_sp > XB_SPIN_CAP) { atomicAdd(&(bar)[XB_TMO], 1u); break; } } } } while (0)

struct XcdBarrier {
    unsigned* bar; unsigned x;
    volatile LAS unsigned* st;
};

__device__ __forceinline__ XcdBarrier xcd_barrier_post(unsigned* bar, volatile LAS unsigned* st) {
    XcdBarrier b; b.bar = bar; b.x = xb_xcc_id(); b.st = st;
    if (threadIdx.x == 0) (void)xb_add(&bar[XB_XCNT(b.x)], 1u);
    return b;
}
__device__ __forceinline__ void xcd_barrier_complete(unsigned* bar, unsigned x, unsigned& nloc, unsigned& nx) {
    const unsigned G = gridDim.x * gridDim.y * gridDim.z;
    unsigned sum, cnt, mine, sp = 0u;
    for (;;) {
        sum = 0u; cnt = 0u; mine = 0u;
#pragma unroll
        for (unsigned j = 0; j < 16; ++j) { const unsigned c = xb_ld(&bar[XB_XCNT(j)]); sum += c; cnt += (c > 0u) ? 1u : 0u; mine = (j == x) ? c : mine; }
        if (sum == G) break;
        __builtin_amdgcn_s_sleep(1);
        if ((++sp & 255u) == 0u) { if (xb_ld(&bar[XB_TMO])) break; if (sp > XB_SPIN_CAP) { atomicAdd(&bar[XB_TMO], 1u); break; } }
    }
    nloc = mine > 0u ? mine : 1u; nx = cnt > 0u ? cnt : 1u;
}

__device__ __forceinline__ void xcd_barrier(const XcdBarrier& b) {
    asm volatile("s_waitcnt vmcnt(0)" ::: "memory");
    __syncthreads();
    if (threadIdx.x == 0) {
        unsigned* bar = b.bar;
        __builtin_amdgcn_s_waitcnt(0);
        unsigned nloc = b.st[0], nx = b.st[1];
        if (nloc == 0u) { xcd_barrier_complete(bar, b.x, nloc, nx); b.st[0] = nloc; b.st[1] = nx; }
        const unsigned old = xb_add(&bar[XB_XSUB(b.x)], 1u);
        const unsigned gen = old / nloc;
        if (old + 1u == (gen + 1u) * nloc) {
            __builtin_amdgcn_fence(__ATOMIC_RELEASE, "agent");
            asm volatile("s_waitcnt vmcnt(0)" ::: "memory");
            const unsigned og = xb_add(&bar[XB_TOP], 1u);
            const unsigned tg = og / nx;
            if (og + 1u == (tg + 1u) * nx) xb_add(&bar[XB_TOPGEN], 1u);
            else XB_SPIN(xb_ld(&bar[XB_TOPGEN]) == tg, bar);
            __builtin_amdgcn_fence(__ATOMIC_ACQUIRE, "agent");
            xb_add(&bar[XB_XGEN(b.x)], 1u);
            asm volatile("s_waitcnt vmcnt(0)" ::: "memory");
        } else {
            XB_SPIN(xb_ld(&bar[XB_XGEN(b.x)]) == gen, bar);
            __builtin_amdgcn_fence(__ATOMIC_ACQUIRE, "agent");
            asm volatile("s_waitcnt vmcnt(0)" ::: "memory");
        }
    }
    __syncthreads();
}

__device__ __forceinline__ void sg_barrier(unsigned* bar, unsigned* sgw, unsigned target, volatile LAS unsigned* mcache) {
    asm volatile("s_waitcnt vmcnt(0)" ::: "memory");
    __syncthreads();
    if (threadIdx.x == 0) {
        __builtin_amdgcn_s_waitcnt(0);
        unsigned mask = *mcache;
        if (mask == 0u) { mask = xb_ld(&sgw[16]); *mcache = mask; }
        if (mask & (mask - 1u)) { __builtin_amdgcn_fence(__ATOMIC_RELEASE, "agent"); asm volatile("s_waitcnt vmcnt(0)" ::: "memory"); }
        if (xb_add(&sgw[0], 1u) + 1u < target) XB_SPIN(xb_ld(&sgw[0]) < target, bar);
        __builtin_amdgcn_fence(__ATOMIC_ACQUIRE, "agent");
        asm volatile("s_waitcnt vmcnt(0)" ::: "memory");
    }
    __syncthreads();
}

__global__ void __launch_bounds__(NTHREADS, 2) fwd_megakernel(Params p) {
    extern __shared__ __attribute__((aligned(16))) unsigned char lds[];
    unsigned char* ws = p.ws;
    bf16_t* xb = (bf16_t*)(ws + WS_XB);
    bf16_t* proj = (bf16_t*)(ws + WS_PROJ);
    bf16_t* mixed = (bf16_t*)(ws + WS_MIXED);
    bf16_t* hid = (bf16_t*)(ws + WS_HID);
    float* sumsq = (float*)(ws + WS_SUMSQ);

    volatile LAS unsigned* misc = (volatile LAS unsigned*)((LAS unsigned char*)lds + 131072);
    if (threadIdx.x < 16) misc[threadIdx.x] = 0u;
    { unsigned short* order = (unsigned short*)(lds + 131072 + 64); for (int e = (int)threadIdx.x; e < 576; e += NTHREADS) order[e] = p.order[e]; }
    __syncthreads();
    XcdBarrier bar = xcd_barrier_post((unsigned*)(ws + WS_BAR), misc + 8);
    unsigned* sgw = (unsigned*)(ws + WS_SGB) + (((blockIdx.x & 7u) << 2) | ((blockIdx.x >> 3) & 3u)) * 32u;
    const bool chain = (gridDim.x == 256u);
    if (threadIdx.x == 0) (void)__hip_atomic_fetch_or(&sgw[16], 1u << bar.x, __ATOMIC_RELAXED, __HIP_MEMORY_SCOPE_AGENT);
    phase_prologue(p, lds);
    PG8_LAS float* rstd_l = (PG8_LAS float*)((PG8_LAS unsigned char*)lds + 131072 + 4096);
#define RSTD_TO_LDS(ss) do { const int t_ = opaque_tid(); if (chain && t_ < 256) rstd_l[t_] = (ss)[(int)((((blockIdx.x & 7u) << 2) | ((blockIdx.x >> 3) & 3u)) << 8) + t_]; __syncthreads(); } while (0)
#pragma unroll 1
    for (int L = 0; L < DEPTH; ++L) {
        float* ss1 = sumsq + (2 * L) * MTOK;
        float* ss2 = sumsq + (2 * L + 1) * MTOK;
        float* ss3 = (L + 1 < DEPTH) ? sumsq + (2 * L + 2) * MTOK : nullptr;
        if (L == 0 || !chain) xcd_barrier(bar);
        else sg_barrier(bar.bar, sgw, 8u * (3u * L), misc + 11);
        RSTD_TO_LDS(ss1);
        run_gemm(lds, xb, (const bf16_t*)(ws + WS_WIN + L * WIN_LAYER), MTOK, NP, DM, EpiScale{proj, PP, 0, chain ? (const float*)rstd_l : ss1, chain ? 0 : -1});
        if (chain && blockIdx.x >= 192u) { if (L == 0) s5_precompute(p, (int)blockIdx.x - 192, 64); conv_fill(p, lds, L, 4); }
        xcd_barrier(bar);
        phase_prep(p);
        phase_cmp_mfma(p, lds, L);
        phase_s5v2(p, lds, L);
        xcd_barrier(bar);
        phase_p3(p, lds, L);
        xcd_barrier(bar);
        run_gemm(lds, mixed, (const bf16_t*)(ws + WS_WOUT + L * WOUT_LAYER), MTOK, DM, DM, EpiResid{xb, nullptr, 1, ss2});
        if (chain) sg_barrier(bar.bar, sgw, 8u * (3u * L + 1u), misc + 11); else xcd_barrier(bar);
        RSTD_TO_LDS(ss2);
        run_gemm(lds, xb, (const bf16_t*)(ws + WS_W1 + L * W1_LAYER), MTOK, DFF, DM, EpiScale{hid, DFF, 1, chain ? (const float*)rstd_l : ss2, chain ? 0 : -1});
        if (chain) sg_barrier(bar.bar, sgw, 8u * (3u * L + 2u), misc + 11); else xcd_barrier(bar);
        run_gemm(lds, hid, (const bf16_t*)(ws + WS_W2 + L * W2_LAYER), MTOK, DM, DFF, EpiResid{xb, (L + 1 < DEPTH) ? nullptr : p.out, (L + 1 < DEPTH) ? 1 : 0, ss3});
    }
    if (p.ws == nullptr) { p.out[0] = (float)*(const unsigned long long*)((const char*)__builtin_amdgcn_implicitarg_ptr() + 88); }
}

extern "C" void kernel_launch(void* const* d_in, const int* in_sizes, int n_in, void* d_out, int out_size, void* d_ws, size_t ws_size, hipStream_t stream) {
    static int grid = 0;
    if (grid == 0) {
        if (n_in != 25 || out_size != MTOK * DM || ws_size < WS_END) { fprintf(stderr, "kernel_launch: unexpected problem (n_in %d out %d ws %zu)\n", n_in, out_size, ws_size); grid = -1; return; }
        int dev = 0, cus = 0, per_cu = 0;
        (void)hipGetDevice(&dev);
        (void)hipDeviceGetAttribute(&cus, hipDeviceAttributeMultiprocessorCount, dev);
        (void)hipFuncSetAttribute((const void*)fwd_megakernel, hipFuncAttributeMaxDynamicSharedMemorySize, LDS_BYTES);
        (void)hipOccupancyMaxActiveBlocksPerMultiprocessor(&per_cu, (const void*)fwd_megakernel, NTHREADS, LDS_BYTES);
        if (per_cu < 1) { fprintf(stderr, "kernel_launch: occupancy query says %d blocks/CU\n", per_cu); grid = -1; return; }
        grid = cus;
    }
    if (grid < 0) return;
    (void)hipMemsetAsync((char*)d_ws + WS_CTL, 0, CTL_BYTES, stream);
    Params p{};
    for (int i = 0; i < 25; ++i) p.in[i] = (const float*)d_in[i];
    p.out = (float*)d_out; p.ws = (unsigned char*)d_ws;
    for (int j = 0; j < 64; ++j) p.inv128[j] = (float)pow(10000.0, -(double)(2 * j) / 128.0);
    for (int j = 0; j < 32; ++j) p.inv64[j] = (float)pow(10000.0, -(double)(2 * j) / 64.0);
    for (int e = 0; e < P3_ITEMS; ++e) { int rank = 0; for (int f = 0; f < P3_ITEMS; ++f) rank += p3_key(f) > p3_key(e) ? 1 : 0; p.order[rank] = (unsigned short)e; }
    void* args[] = {&p};
    hipError_t e = hipLaunchCooperativeKernel((const void*)fwd_megakernel, dim3(grid), dim3(NTHREADS), args, LDS_BYTES, stream);
    if (e != hipSuccess) fprintf(stderr, "cooperative launch failed: %s (grid %d)\n", hipGetErrorString(e), grid);
}
```
